# Optimizing an MI355X kernel written in HIP

```python
import math
import jax
import jax.numpy as jnp
from jax import lax
import numpy as np

D_MODEL = 2048
BATCH = 1
SEQ = 8192
DEPTH = 2

GRID_W = 64
CTX_LEN = 256
N_EVEN = (DEPTH + 1) // 2
N_ODD = DEPTH // 2
RMS_EPS = 1e-6
N_MOD = 6

HY_WIDTH = D_MODEL // 2
HY_ORDER = 2
HY_CONV_W = 3
HY_EMB = 33
HY_BANDS = (HY_EMB - 1) // 2
HY_FFN = 64
HY_N_FILT = 2 * HY_ORDER * HY_WIDTH
HY_DECAY_TARGET = 1e-2
HY_FAST_PCT = 0.3
HY_SLOW_PCT = 1.5
GM_WIDTH = D_MODEL // 2
GM_CHUNK = 128
GM_HEADS = 8
GM_HEAD_DIM = GM_WIDTH // GM_HEADS
EVEN_PROJ = (HY_ORDER + 1) * HY_WIDTH + 2 * GM_WIDTH
LRU_WIDTH = D_MODEL // 2
LRU_HEADS = 8
LRU_HEAD_DIM = LRU_WIDTH // LRU_HEADS
LRU_CONV_W = 4
LRU_C = 8.0
POOL_WIDTH = D_MODEL // 2
POOL_WINDOWS = (2, 4, 8, 16)
POOL_GROUP = POOL_WIDTH // len(POOL_WINDOWS)
ODD_PROJ = 2 * LRU_WIDTH + POOL_WIDTH
PEER_HEADS = 8
PEER_NKEYS = 128
PEER_N = PEER_NKEYS * PEER_NKEYS
PEER_DKEY = 256
PEER_TOPK = 16
PEER_BLOCK = 128

kernel_name = 'hyena_gmlp_rglru_pool_peer_flow_backbone'


def rmsnorm(x, g):
    x32 = x.astype(jnp.float32)
    y = x32 * lax.rsqrt(jnp.mean(x32 * x32, axis=-1, keepdims=True) + RMS_EPS)
    return y.astype(x.dtype) * g


def modulate(x, shift, scale):
    return x * (1 + scale) + shift


def dwconv_centred(x, w, b):
    width = w.shape[0]
    left = (width - 1) // 2
    L = x.shape[1]
    xp = jnp.pad(x, ((0, 0), (left, width - 1 - left), (0, 0)))
    y = b
    for k in range(width):
        y = y + w[k] * xp[:, k:k + L]
    return y


def hyena_filters(L, w1, b1, w2, b2, w3, freq, deltas):
    t = jnp.arange(L, dtype=jnp.float32)
    t_norm = t / max(L - 1, 1)
    bands = jnp.linspace(1e-4, HY_BANDS - 1, HY_BANDS, dtype=jnp.float32)
    ang = (2.0 * math.pi / L) * t[:, None] * bands[None, :]
    feats = jnp.concatenate([t_norm[:, None], jnp.cos(ang), -jnp.sin(ang)], axis=-1)
    h = jnp.sin(freq * (feats @ w1 + b1))
    h = jnp.sin(freq * (h @ w2 + b2))
    h = (h @ w3) * jnp.exp(-t_norm[:, None] * jnp.abs(deltas))
    h = h.astype(jnp.float32).reshape(L, 2, HY_ORDER, HY_WIDTH)
    return h / jnp.sum(jnp.abs(h), axis=(0, 1), keepdims=True)


def long_conv_bidir(u, h_fwd, h_bwd):
    L = u.shape[1]
    k = jnp.concatenate([h_fwd, h_bwd[::-1]], axis=0)
    U = jnp.fft.rfft(u.astype(jnp.float32), n=2 * L, axis=1)
    K = jnp.fft.rfft(k, n=2 * L, axis=0)
    y = jnp.fft.irfft(U * K[None], n=2 * L, axis=1)[:, :L]
    return y.astype(u.dtype)


def even_mixer(h, w_in, conv_w, conv_b, f_w1, f_b1, f_w2, f_b2, f_w3, f_freq, f_deltas, hy_bias,
               gm_norm, gm_ws, gm_bs, w_out):
    B, L, _ = h.shape
    proj = h @ w_in
    za = dwconv_centred(proj[..., :(HY_ORDER + 1) * HY_WIDTH], conv_w, conv_b)
    parts = jnp.split(za, HY_ORDER + 1, axis=-1)
    filt = hyena_filters(L, f_w1, f_b1, f_w2, f_b2, f_w3, f_freq, f_deltas)
    z = parts[0]
    for n in range(HY_ORDER):
        z = parts[n + 1] * (long_conv_bidir(z, filt[:, 0, n], filt[:, 1, n]) + hy_bias[n] * z)
    u, vg = jnp.split(jax.nn.gelu(proj[..., (HY_ORDER + 1) * HY_WIDTH:]), 2, axis=-1)
    vg = rmsnorm(vg, gm_norm).reshape(B, L // GM_CHUNK, GM_CHUNK, GM_HEADS, GM_HEAD_DIM)
    s = jnp.einsum('hpq,bnqhc->bnphc', gm_ws, vg) + gm_bs.T[:, :, None]
    yb = u * s.reshape(B, L, GM_WIDTH)
    return jnp.concatenate([z, yb], axis=-1) @ w_out


def linear_scan(a, b, h0, reverse):
    if reverse:
        b = b.at[:, -1].add(a[:, -1] * h0)
    else:
        b = b.at[:, 0].add(a[:, 0] * h0)

    def combine(e1, e2):
        a1, b1 = e1
        a2, b2 = e2
        return a1 * a2, a2 * b1 + b2

    _, hs = lax.associative_scan(combine, (a, b), reverse=reverse, axis=1)
    return hs


def rglru_direction(xr, w_a, b_a, w_x, b_x, lam, h0, reverse):
    B, L, _ = xr.shape
    x32 = xr.astype(jnp.float32)
    xh = x32.reshape(B, L, LRU_HEADS, LRU_HEAD_DIM)
    r = jax.nn.sigmoid(jnp.einsum('blhi,hij->blhj', xh, w_a).reshape(B, L, LRU_WIDTH) + b_a)
    i = jax.nn.sigmoid(jnp.einsum('blhi,hij->blhj', xh, w_x).reshape(B, L, LRU_WIDTH) + b_x)
    log_a = -LRU_C * r * jax.nn.softplus(-lam)
    a = jnp.exp(log_a)
    b = jnp.sqrt(-jnp.expm1(2.0 * log_a)) * (i * x32)
    return linear_scan(a, b, h0, reverse)


def multiscale_pool(xp, w, b, scale):
    B, L, _ = xp.shape
    t = jnp.arange(L)
    outs = []
    for g, win in enumerate(POOL_WINDOWS):
        xg = xp[..., g * POOL_GROUP:(g + 1) * POOL_GROUP].astype(jnp.float32)
        cs = jnp.concatenate([jnp.zeros((B, 1, POOL_GROUP), jnp.float32), jnp.cumsum(xg, axis=1)], axis=1)
        lo = jnp.clip(t - win // 2, 0, L)
        hi = jnp.clip(t + win // 2, 0, L)
        mean = (cs[:, hi] - cs[:, lo]) / (hi - lo).astype(jnp.float32)[None, :, None]
        outs.append((mean - xg).astype(xp.dtype) @ w[g] + b[g])
    return jnp.concatenate(outs, axis=-1) * scale


def odd_mixer(h, init_f, init_b, w_in, conv_w, conv_b, lru_wa, lru_ba, lru_wx, lru_bx, lru_lam,
              pool_w, pool_b, pool_scale, w_out, with_output):
    proj = h @ w_in
    xr = dwconv_centred(proj[..., LRU_WIDTH:2 * LRU_WIDTH], conv_w, conv_b)
    hf = rglru_direction(xr, lru_wa[0], lru_ba[0], lru_wx[0], lru_bx[0], lru_lam[0], init_f, False)
    hb = rglru_direction(xr, lru_wa[1], lru_ba[1], lru_wx[1], lru_bx[1], lru_lam[1], init_b, True)
    states = (hf[:, -1], hb[:, 0])
    if not with_output:
        return None, states
    yc = jax.nn.gelu(proj[..., :LRU_WIDTH]) * (hf + hb).astype(h.dtype)
    yd = multiscale_pool(proj[..., 2 * LRU_WIDTH:], pool_w, pool_b, pool_scale)
    return jnp.concatenate([yc, yd], axis=-1) @ w_out, states


def peer(h, q_w, sub_keys, u_tab, v_tab):
    B, L, D = h.shape
    T = B * L
    hf = h.reshape(T, D)
    q = (hf @ q_w).reshape(T, PEER_HEADS, 2, PEER_DKEY // 2).astype(jnp.float32)
    s = jnp.einsum('thsk,hsnk->thsn', q, sub_keys.astype(jnp.float32))
    s_top, i_top = lax.top_k(s, PEER_TOPK)
    cand = (s_top[:, :, 0, :, None] + s_top[:, :, 1, None, :]).reshape(T, PEER_HEADS, PEER_TOPK * PEER_TOPK)
    c_top, c_idx = lax.top_k(cand, PEER_TOPK)
    idx_a = jnp.take_along_axis(i_top[:, :, 0], c_idx // PEER_TOPK, axis=-1)
    idx_b = jnp.take_along_axis(i_top[:, :, 1], c_idx % PEER_TOPK, axis=-1)
    expert = idx_a * PEER_NKEYS + idx_b
    gate = jax.nn.softmax(c_top, axis=-1).astype(h.dtype)
    nb = T // PEER_BLOCK

    def block(args):
        xb, eb, gb = args
        act = jax.nn.gelu(jnp.einsum('td,thkd->thk', xb, u_tab[eb]))
        return jnp.einsum('thk,thkd->td', gb * act, v_tab[eb])

    out = lax.map(block, (hf.reshape(nb, PEER_BLOCK, D),
                          expert.reshape(nb, PEER_BLOCK, PEER_HEADS, PEER_TOPK),
                          gate.reshape(nb, PEER_BLOCK, PEER_HEADS, PEER_TOPK)))
    return out.reshape(B, L, D)


def setup_inputs(seed: int = 0) -> dict:
    key = jax.random.key(seed)
    ks = iter(jax.random.split(key, 64))
    D = D_MODEL

    def nrm(shape, scale):
        return scale * jax.random.normal(next(ks), shape, jnp.float32)

    min_decay = math.log(HY_DECAY_TARGET) / HY_SLOW_PCT
    max_decay = math.log(HY_DECAY_TARGET) / HY_FAST_PCT
    deltas = jnp.linspace(min_decay, max_decay, HY_N_FILT, dtype=jnp.float32)[None]
    hy_deltas = deltas * (1.0 + nrm((N_EVEN, HY_N_FILT), 0.05))
    a_pow = jax.random.uniform(next(ks), (N_ODD, 2, LRU_WIDTH), jnp.float32, 0.9, 0.999)
    s_lam = a_pow ** (1.0 / LRU_C)
    lru_lam = jnp.log(s_lam) - jnp.log1p(-s_lam)
    return {
        'x': nrm((BATCH, SEQ, D), 1.0),
        'c': nrm((BATCH, D), 1.0),
        'ctx': nrm((BATCH, CTX_LEN, D), 1.0),
        'c_ctx': nrm((D,), 1.0),
        'ada_w': nrm((DEPTH, D, N_MOD * D), 0.5 * D ** -0.5),
        'ada_b': nrm((DEPTH, N_MOD * D), 0.02),
        'norm_mix': 1.0 + nrm((DEPTH, D), 0.05),
        'norm_ffn': 1.0 + nrm((DEPTH, D), 0.05),
        'norm_final': 1.0 + nrm((D,), 0.05),
        'ev_w_in': nrm((N_EVEN, D, EVEN_PROJ), D ** -0.5),
        'ev_conv_w': nrm((N_EVEN, HY_CONV_W, (HY_ORDER + 1) * HY_WIDTH), HY_CONV_W ** -0.5),
        'ev_conv_b': nrm((N_EVEN, (HY_ORDER + 1) * HY_WIDTH), 0.02),
        'hy_w1': nrm((N_EVEN, HY_EMB, HY_FFN), HY_EMB ** -0.5),
        'hy_b1': nrm((N_EVEN, HY_FFN), 0.1),
        'hy_w2': nrm((N_EVEN, HY_FFN, HY_FFN), HY_FFN ** -0.5),
        'hy_b2': nrm((N_EVEN, HY_FFN), 0.1),
        'hy_w3': nrm((N_EVEN, HY_FFN, HY_N_FILT), HY_FFN ** -0.5),
        'hy_freq': 1.0 + nrm((N_EVEN, HY_FFN), 0.05),
        'hy_deltas': hy_deltas,
        'hy_bias': nrm((N_EVEN, HY_ORDER, HY_WIDTH), 0.5),
        'gm_norm': 1.0 + nrm((N_EVEN, GM_WIDTH), 0.05),
        'gm_ws': nrm((N_EVEN, GM_HEADS, GM_CHUNK, GM_CHUNK), GM_CHUNK ** -0.5),
        'gm_bs': 1.0 + nrm((N_EVEN, GM_HEADS, GM_CHUNK), 0.02),
        'ev_w_out': nrm((N_EVEN, D, D), D ** -0.5),
        'od_w_in': nrm((N_ODD, D, ODD_PROJ), D ** -0.5),
        'od_conv_w': nrm((N_ODD, LRU_CONV_W, LRU_WIDTH), LRU_CONV_W ** -0.5),
        'od_conv_b': nrm((N_ODD, LRU_WIDTH), 0.02),
        'lru_wa': nrm((N_ODD, 2, LRU_HEADS, LRU_HEAD_DIM, LRU_HEAD_DIM), LRU_HEAD_DIM ** -0.5),
        'lru_ba': nrm((N_ODD, 2, LRU_WIDTH), 0.02),
        'lru_wx': nrm((N_ODD, 2, LRU_HEADS, LRU_HEAD_DIM, LRU_HEAD_DIM), LRU_HEAD_DIM ** -0.5),
        'lru_bx': nrm((N_ODD, 2, LRU_WIDTH), 0.02),
        'lru_lam': lru_lam,
        'pool_w': nrm((N_ODD, len(POOL_WINDOWS), POOL_GROUP, POOL_GROUP), POOL_GROUP ** -0.5),
        'pool_b': nrm((N_ODD, len(POOL_WINDOWS), POOL_GROUP), 0.02),
        'pool_scale': 1.0 + nrm((N_ODD, POOL_WIDTH), 0.05),
        'od_w_out': nrm((N_ODD, D, D), D ** -0.5),
        'peer_q': nrm((DEPTH, D, PEER_HEADS * PEER_DKEY), D ** -0.5),
        'peer_keys': nrm((DEPTH, PEER_HEADS, 2, PEER_NKEYS, PEER_DKEY // 2), (PEER_DKEY // 2) ** -0.5),
        'peer_u': nrm((DEPTH, PEER_N, D), D ** -0.5),
        'peer_v': nrm((DEPTH, PEER_N, D), PEER_HEADS ** -0.5),
    }


def reference(x, c, ctx, c_ctx, ada_w, ada_b, norm_mix, norm_ffn, norm_final,
              ev_w_in, ev_conv_w, ev_conv_b, hy_w1, hy_b1, hy_w2, hy_b2, hy_w3, hy_freq, hy_deltas, hy_bias,
              gm_norm, gm_ws, gm_bs, ev_w_out,
              od_w_in, od_conv_w, od_conv_b, lru_wa, lru_ba, lru_wx, lru_bx, lru_lam,
              pool_w, pool_b, pool_scale, od_w_out,
              peer_q, peer_keys, peer_u, peer_v):
    xc = ctx
    for l in range(DEPTH):
        last = l == DEPTH - 1
        sh1, sc1, g1, sh2, sc2, g2 = jnp.split((jax.nn.silu(c) @ ada_w[l] + ada_b[l])[:, None, :], N_MOD, axis=-1)
        csh1, csc1, cg1, csh2, csc2, cg2 = jnp.split(jax.nn.silu(c_ctx) @ ada_w[l] + ada_b[l], N_MOD, axis=-1)
        hx = modulate(rmsnorm(x, norm_mix[l]), sh1, sc1)
        if l % 2 == 0:
            e = l // 2
            ev_args = (ev_w_in[e], ev_conv_w[e], ev_conv_b[e], hy_w1[e], hy_b1[e], hy_w2[e], hy_b2[e], hy_w3[e],
                       hy_freq[e], hy_deltas[e], hy_bias[e], gm_norm[e], gm_ws[e], gm_bs[e], ev_w_out[e])
            x = x + g1 * even_mixer(hx, *ev_args)
            if not last:
                hc = modulate(rmsnorm(xc, norm_mix[l]), csh1, csc1)
                xc = xc + cg1 * even_mixer(hc, *ev_args)
        else:
            o = l // 2
            od_args = (od_w_in[o], od_conv_w[o], od_conv_b[o], lru_wa[o], lru_ba[o], lru_wx[o], lru_bx[o],
                       lru_lam[o], pool_w[o], pool_b[o], pool_scale[o], od_w_out[o])
            hc = modulate(rmsnorm(xc, norm_mix[l]), csh1, csc1)
            zero_state = jnp.zeros((hc.shape[0], LRU_WIDTH), jnp.float32)
            yc, (st_f, st_b) = odd_mixer(hc, zero_state, zero_state, *od_args, with_output=not last)
            y, _ = odd_mixer(hx, st_f, st_b, *od_args, with_output=True)
            x = x + g1 * y
            if not last:
                xc = xc + cg1 * yc
        x = x + g2 * peer(modulate(rmsnorm(x, norm_ffn[l]), sh2, sc2), peer_q[l], peer_keys[l], peer_u[l], peer_v[l])
        if not last:
            xc = xc + cg2 * peer(modulate(rmsnorm(xc, norm_ffn[l]), csh2, csc2),
                                 peer_q[l], peer_keys[l], peer_u[l], peer_v[l])
    return rmsnorm(x, norm_final)
```

```cpp
#include <hip/hip_runtime.h>
#include <hip/hip_cooperative_groups.h>
#include <stdint.h>
#include <cstdio>
namespace cg = cooperative_groups;

#ifndef ONE_LAUNCH
#define ONE_LAUNCH 1
#endif

typedef unsigned short bf16_t;
using bf16x8 = __attribute__((ext_vector_type(8))) short;
using f32x4 = __attribute__((ext_vector_type(4))) float;
using u32x4 = __attribute__((ext_vector_type(4))) unsigned int;
using u32x2 = __attribute__((ext_vector_type(2))) unsigned int;
__device__ __forceinline__ u32x4 mk4(unsigned a, unsigned b, unsigned c, unsigned d) { u32x4 r; r.x = a; r.y = b; r.z = c; r.w = d; return r; }
__device__ __forceinline__ u32x2 mk2(unsigned a, unsigned b) { u32x2 r; r.x = a; r.y = b; return r; }

#define TS 8448
#define TX 8192
#define DM 2048
#define NPH 19
#ifndef ONLY_PH
#define ONLY_PH -1
#endif
#define PHON(k) (ONLY_PH < 0 || ONLY_PH == (k))
#ifndef REP_P0
#define REP_P0 1
#endif
#ifndef REP_GEMM
#define REP_GEMM 1
#endif
#ifndef REP_P3
#define REP_P3 1
#endif
#ifndef REP_P18
#define REP_P18 1
#endif
#ifndef REP_TOPK
#define REP_TOPK 1
#endif
#ifndef REP_L1S
#define REP_L1S 1
#endif

struct P {
  const float *x, *c, *ctx, *cctx, *ada_w, *ada_b, *norm_mix, *norm_ffn, *norm_final;
  const float *ev_w_in, *ev_conv_w, *ev_conv_b, *hy_w1, *hy_b1, *hy_w2, *hy_b2, *hy_w3, *hy_freq, *hy_deltas, *hy_bias;
  const float *gm_norm, *gm_ws, *gm_bs, *ev_w_out;
  const float *od_w_in, *od_conv_w, *od_conv_b, *lru_wa, *lru_ba, *lru_wx, *lru_bx, *lru_lam, *pool_w, *pool_b, *pool_scale, *od_w_out;
  const float *peer_q, *peer_keys, *peer_u, *peer_v;
  float* out;
  float* MOD;
  bf16_t* H2B;
  bf16_t* W3T;
  bf16_t* WT_EVIN;
  bf16_t* WT_EVOUT;
  bf16_t* WT_ODIN;
  bf16_t* WT_ODOUT;
  bf16_t* WT_PQ;
  bf16_t* WG;
  bf16_t* KEYB;
  bf16_t* GMWS;
  bf16_t* WTPOOL;
  unsigned char* UB;
  unsigned char* VB;
  float* SU;
  float* SV;
  bf16_t* ABUF0;
  bf16_t* ABUF1;
  float* PROJT;
  float* PROJ1;
  float* XR;
  bf16_t* XRB;
  bf16_t* PD;
  bf16_t* FILT;
  float* Z1;
  float* ABA;
  float* ABB;
  float* XA;
  bf16_t* QB;
  float* SC;
  float2* AGG;
  unsigned* BAR;
};

__device__ __forceinline__ bf16_t f2bf(float f) {
  uint32_t u = __float_as_uint(f);
  u += 0x7FFFu + ((u >> 16) & 1u);
  return (bf16_t)(u >> 16);
}
__device__ __forceinline__ float bf2f(bf16_t b) { return __uint_as_float(((uint32_t)b) << 16); }
__device__ __forceinline__ uint32_t pack2(float a, float b) { return (uint32_t)f2bf(a) | ((uint32_t)f2bf(b) << 16); }
__device__ __forceinline__ float bflo(uint32_t u) { return __uint_as_float(u << 16); }
__device__ __forceinline__ float bfhi(uint32_t u) { return __uint_as_float(u & 0xFFFF0000u); }
__device__ __forceinline__ float gelu_f(float x) {
  float u = 0.7978845608028654f * (x + 0.044715f * x * x * x);
  return x / (1.f + __expf(-2.f * u));
}
__device__ __forceinline__ float sigmoid_f(float x) { return 1.f / (1.f + __expf(-x)); }
__device__ __forceinline__ float wave_sum(float v) {
#pragma unroll
  for (int o = 32; o >= 1; o >>= 1) v += __shfl_xor(v, o);
  return v;
}
__device__ __forceinline__ uint32_t wave_max_u32(uint32_t v) {
#pragma unroll
  for (int o = 32; o >= 1; o >>= 1) { uint32_t t = (uint32_t)__shfl_xor((int)v, o); v = v > t ? v : t; }
  return v;
}
__device__ __forceinline__ uint32_t fkey(float f) { uint32_t u = __float_as_uint(f); return (u & 0x80000000u) ? ~u : (u | 0x80000000u); }
__device__ __forceinline__ float funkey(uint32_t k) { uint32_t u = (k & 0x80000000u) ? (k & 0x7FFFFFFFu) : ~k; return __uint_as_float(u); }

#define LDS_S 72
template <int NI>
__device__ __forceinline__ void gemm_core_t(f32x4 (&acc)[4][NI], const bf16_t* __restrict__ A, int lda,
                                            const bf16_t* __restrict__ Bt, int ldb, int K, bf16_t* sA, bf16_t* sB) {
  const int tid = threadIdx.x, lane = tid & 63, wid = tid >> 6, wr = wid >> 1, wc = wid & 1;
  const int lr = tid >> 3, lc = (tid & 7) * 8;
#pragma unroll
  for (int i = 0; i < 4; ++i)
#pragma unroll
    for (int j = 0; j < NI; ++j) acc[i][j] = (f32x4){0.f, 0.f, 0.f, 0.f};
  u32x4 ra[4], rb[NI];
#pragma unroll
  for (int i = 0; i < 4; ++i) ra[i] = *(const u32x4*)(A + (size_t)(lr + 32 * i) * lda + lc);
#pragma unroll
  for (int i = 0; i < NI; ++i) rb[i] = *(const u32x4*)(Bt + (size_t)(lr + 32 * i) * ldb + lc);
  const int nk = K >> 6;
  for (int kt = 0; kt < nk; ++kt) {
    __syncthreads();
#pragma unroll
    for (int i = 0; i < 4; ++i) *(u32x4*)(sA + (lr + 32 * i) * LDS_S + lc) = ra[i];
#pragma unroll
    for (int i = 0; i < NI; ++i) *(u32x4*)(sB + (lr + 32 * i) * LDS_S + lc) = rb[i];
    __syncthreads();
    if (kt + 1 < nk) {
      const int ko = (kt + 1) * 64;
#pragma unroll
      for (int i = 0; i < 4; ++i) ra[i] = *(const u32x4*)(A + (size_t)(lr + 32 * i) * lda + ko + lc);
#pragma unroll
      for (int i = 0; i < NI; ++i) rb[i] = *(const u32x4*)(Bt + (size_t)(lr + 32 * i) * ldb + ko + lc);
    }
    bf16x8 af[2][4], bfr[2][NI];
#pragma unroll
    for (int ks = 0; ks < 2; ++ks) {
#pragma unroll
      for (int mi = 0; mi < 4; ++mi)
        af[ks][mi] = *(const bf16x8*)(sA + (wr * 64 + mi * 16 + (lane & 15)) * LDS_S + ks * 32 + (lane >> 4) * 8);
#pragma unroll
      for (int ni = 0; ni < NI; ++ni)
        bfr[ks][ni] = *(const bf16x8*)(sB + (wc * 16 * NI + ni * 16 + (lane & 15)) * LDS_S + ks * 32 + (lane >> 4) * 8);
    }
#pragma unroll
    for (int ks = 0; ks < 2; ++ks)
#pragma unroll
      for (int mi = 0; mi < 4; ++mi)
#pragma unroll
        for (int ni = 0; ni < NI; ++ni)
          acc[mi][ni] = __builtin_amdgcn_mfma_f32_16x16x32_bf16(af[ks][mi], bfr[ks][ni], acc[mi][ni], 0, 0, 0);
  }
}
__device__ __forceinline__ void gemm_core(f32x4 (&acc)[4][4], const bf16_t* __restrict__ A, int lda,
                                          const bf16_t* __restrict__ Bt, int ldb, int K, bf16_t* sA, bf16_t* sB) {
  gemm_core_t<4>(acc, A, lda, Bt, ldb, K, sA, sB);
}

template <class Epi>
__device__ __forceinline__ void gemm_phase(const bf16_t* A, int lda, const bf16_t* Bt, int ldb, int M, int N, int K,
                                           char* smem, int bid, int nb, Epi epi) {
  const int numM = M >> 7, numN = N >> 7;
  bf16_t* sA = (bf16_t*)smem;
  bf16_t* sB = sA + 128 * LDS_S;
  const int lane = threadIdx.x & 63, wid = threadIdx.x >> 6, wr = wid >> 1, wc = wid & 1;
  const int total = numM * numN;
  const int full = (total / nb) * nb;
  const int vb = ((nb & 7) == 0) ? (bid & 7) * (nb >> 3) + (bid >> 3) : bid;
  auto tile_of = [&](int id, int& mt, int& nt) {
    const int gsz = 8 * numN, g = id / gsz, fm = g * 8;
    const int rows = (numM - fm) < 8 ? (numM - fm) : 8;
    const int r = id - g * gsz;
    mt = fm + r % rows; nt = r / rows;
  };
  for (int id = vb; id < full; id += nb) {
    int mt, nt;
    tile_of(id, mt, nt);
    f32x4 acc[4][4];
    gemm_core_t<4>(acc, A + (size_t)mt * 128 * lda, lda, Bt + (size_t)nt * 128 * ldb, ldb, K, sA, sB);
#pragma unroll
    for (int mi = 0; mi < 4; ++mi)
#pragma unroll
      for (int ni = 0; ni < 4; ++ni)
        epi(mt * 128 + wr * 64 + mi * 16 + (lane >> 4) * 4, nt * 128 + wc * 64 + ni * 16 + (lane & 15), acc[mi][ni]);
  }
  for (int u = vb; u < (total - full) * 4; u += nb) {
    const int id = full + (u >> 2), qd = u & 3;
    int mt, nt;
    tile_of(id, mt, nt);
    f32x4 acc[4][1];
    gemm_core_t<1>(acc, A + (size_t)mt * 128 * lda, lda, Bt + (size_t)(nt * 128 + qd * 32) * ldb, ldb, K, sA, sB);
#pragma unroll
    for (int mi = 0; mi < 4; ++mi)
      epi(mt * 128 + wr * 64 + mi * 16 + (lane >> 4) * 4, nt * 128 + qd * 32 + wc * 16 + (lane & 15), acc[mi][0]);
  }
}

__device__ __forceinline__ void ph_ada(const P& p, char* smem, int bid, int nb, int layer) {
  float* sc = (float*)smem;
  float* sx = sc + 2048;
  float* red = sx + 2048;
  const int tid = threadIdx.x;
  bool loaded = false;
  for (int item0 = bid; item0 < 384; item0 += nb) {
    const int item = item0 + layer * 384;
    if (!loaded) {
      for (int i = tid; i < 2048; i += 256) {
        float v = p.c[i]; sc[i] = v * sigmoid_f(v);
        float w = p.cctx[i]; sx[i] = w * sigmoid_f(w);
      }
      __syncthreads();
      loaded = true;
    }
    const int l = item / 384, cgp = item % 384;
    const int col = cgp * 32 + (tid & 31), kg = tid >> 5;
    const float* w = p.ada_w + (size_t)l * 2048 * 12288 + col;
    float a0 = 0.f, a1 = 0.f;
#pragma unroll 16
    for (int k = kg; k < 2048; k += 8) {
      float wv = w[(size_t)k * 12288];
      a0 += sc[k] * wv; a1 += sx[k] * wv;
    }
    red[(kg * 32 + (tid & 31)) * 2 + 0] = a0;
    red[(kg * 32 + (tid & 31)) * 2 + 1] = a1;
    __syncthreads();
    if (tid < 64) {
      const int cc = tid & 31, which = tid >> 5;
      float s = 0.f;
#pragma unroll
      for (int g = 0; g < 8; ++g) s += red[(g * 32 + cc) * 2 + which];
      const int colo = cgp * 32 + cc;
      p.MOD[(size_t)(l * 2 + which) * 12288 + colo] = s + p.ada_b[l * 12288 + colo];
    }
    __syncthreads();
  }
  __syncthreads();
}

__device__ __forceinline__ void ph_h2(const P& p, char* smem, int bid, int nb) {
  float* feats = (float*)smem;
  float* h1 = feats + 160;
  float* w1s = feats + 512;
  float* w2s = w1s + 33 * 64;
  const int tid = threadIdx.x, r = tid >> 6, j = tid & 63;
  if (bid < 2112) {
    for (int i = tid; i < 33 * 64; i += 256) w1s[i] = p.hy_w1[i];
    for (int i = tid; i < 64 * 64; i += 256) w2s[i] = p.hy_w2[i];
  }
  const float b1 = p.hy_b1[j], b2 = p.hy_b2[j], fr = p.hy_freq[j];
  __syncthreads();
  for (int item = bid; item < 2112; item += nb) {
    const int row = item * 4 + r;
    const int L = row < TX ? TX : 256;
    const int t = row < TX ? row : row - TX;
    if (j < 33) {
      const float tn = (float)t / (float)(L - 1);
      float f;
      if (j == 0) f = tn;
      else {
        const int bi = (j - 1) & 15;
        const float band = 1e-4f + (float)bi * ((15.f - 1e-4f) / 15.f);
        const float ang = (6.283185307179586f / (float)L) * (float)t * band;
        f = (j <= 16) ? cosf(ang) : -sinf(ang);
      }
      feats[r * 36 + j] = f;
    }
    __syncthreads();
    float a = b1;
#pragma unroll
    for (int i = 0; i < 33; ++i) a += feats[r * 36 + i] * w1s[i * 64 + j];
    h1[r * 64 + j] = sinf(fr * a);
    __syncthreads();
    float a2 = b2;
#pragma unroll 16
    for (int i = 0; i < 64; ++i) a2 += h1[r * 64 + i] * w2s[i * 64 + j];
    p.H2B[(size_t)row * 64 + j] = f2bf(sinf(fr * a2));
  }
  __syncthreads();
}

using f32x2 = __attribute__((ext_vector_type(2))) float;
#ifndef FP6_ORDER
#define FP6_ORDER 1
#endif
using v16f = __attribute__((ext_vector_type(16))) float;
using v32f = __attribute__((ext_vector_type(32))) float;
using v6u = __attribute__((ext_vector_type(6))) unsigned int;
#define ROWB 1536
__device__ __forceinline__ void ph_tables(const P& p, int bid, int nb) {
  const int lane = threadIdx.x & 63, w = threadIdx.x >> 6;
  for (int r = bid * 4 + w; r < 65536; r += nb * 4) {
    const int tb = r >> 15, row = r & 32767;
    const float* src = (tb ? p.peer_v : p.peer_u) + (size_t)row * 2048 + lane * 32;
    unsigned char* dst = (tb ? p.VB : p.UB) + (size_t)row * ROWB;
    f32x4 v[8];
    float amax = 0.f;
#pragma unroll
    for (int q = 0; q < 8; ++q) {
      v[q] = *(const f32x4*)(src + q * 4);
      amax = fmaxf(amax, fmaxf(fmaxf(fabsf(v[q].x), fabsf(v[q].y)), fmaxf(fabsf(v[q].z), fabsf(v[q].w))));
    }
#pragma unroll
    for (int o = 32; o >= 1; o >>= 1) amax = fmaxf(amax, __shfl_xor(amax, o));
    const float sc = (amax > 0.f) ? exp2f(floorf(log2f(7.5f / amax))) : 1.f;
    v16f a, b;
#pragma unroll
    for (int k = 0; k < 16; ++k) {
#if FP6_ORDER == 0
      const int ia = k, ib = 16 + k;
#else
      const int ia = 2 * k, ib = 2 * k + 1;
#endif
      a[k] = v[ia >> 2][ia & 3] * sc;
      b[k] = v[ib >> 2][ib & 3] * sc;
    }
    const v6u pk = __builtin_amdgcn_cvt_scalef32_2xpk16_fp6_f32(a, b, 1.0f);
#pragma unroll
    for (int jc = 0; jc < 3; ++jc) *(u32x2*)(dst + jc * 512 + lane * 8) = mk2(pk[2 * jc], pk[2 * jc + 1]);
    if (lane == 0) (tb ? p.SV : p.SU)[row] = 1.f / sc;
  }
}

__device__ __forceinline__ void transpose_job(const float* src, bf16_t* dst, int K, int N, int batch, char* smem, int bid, int nb) {
  float* s = (float*)smem;
  const int tid = threadIdx.x;
  const int tK = K >> 6, tN = N >> 6, per = tK * tN, total = batch * per;
  for (int item = bid; item < total; item += nb) {
    const int b = item / per, rem = item % per, tk = rem / tN, tn = rem % tN;
    const float* sp = src + (size_t)b * K * N + (size_t)(tk * 64) * N + tn * 64;
#pragma unroll
    for (int i = 0; i < 4; ++i) {
      const int row = (tid >> 4) + 16 * i, c4 = (tid & 15) * 4;
      float4 v = *(const float4*)(sp + (size_t)row * N + c4);
      s[row * 65 + c4 + 0] = v.x; s[row * 65 + c4 + 1] = v.y; s[row * 65 + c4 + 2] = v.z; s[row * 65 + c4 + 3] = v.w;
    }
    __syncthreads();
    const int n = tid >> 2, kq = tid & 3;
    uint32_t w[8];
#pragma unroll
    for (int e = 0; e < 8; ++e) w[e] = pack2(s[(kq * 16 + 2 * e) * 65 + n], s[(kq * 16 + 2 * e + 1) * 65 + n]);
    bf16_t* d = dst + (size_t)b * N * K + (size_t)(tn * 64 + n) * K + tk * 64 + kq * 16;
    *(u32x4*)d = mk4(w[0], w[1], w[2], w[3]);
    *(u32x4*)(d + 8) = mk4(w[4], w[5], w[6], w[7]);
    __syncthreads();
  }
}

__device__ __forceinline__ void ph_small_convert(const P& p, int bid, int nb) {
  const int gt = bid * 256 + threadIdx.x, gs = nb * 256;
  for (int i = gt; i < 2 * 16 * 128 * 128; i += gs) {
    const int k = i & 127, n = (i >> 7) & 127, hh = (i >> 14) & 15, dir = i >> 18;
    const int wc = n >> 6, ni = (n >> 4) & 3, l = n & 15;
    const int type = ni & 1, cl = (wc * 2 + (ni >> 1)) * 16 + l;
    const int h = hh >> 1, half = hh & 1, j = half * 64 + cl;
    const float* src = type ? p.lru_wx : p.lru_wa;
    p.WG[i] = f2bf(src[((size_t)(dir * 8 + h) * 128 + k) * 128 + j]);
  }
  for (int i = gt; i < 2 * 16 * 128 * 128; i += gs) p.KEYB[i] = f2bf(p.peer_keys[i]);
  for (int i = gt; i < 8 * 128 * 128; i += gs) p.GMWS[i] = f2bf(p.gm_ws[i]);
}

__device__ __forceinline__ void ph_norm(const float* srcx, const float* srcc, int nrows, const float* gnorm, const float* modx,
                        const float* modc, int shIdx, int scIdx, bf16_t* dst, int bid, int nb) {
  const int lane = threadIdx.x & 63, w = threadIdx.x >> 6;
  for (int row = bid * 4 + w; row < nrows; row += nb * 4) {
    const float* s = row < TX ? srcx + (size_t)row * DM : srcc + (size_t)(row - TX) * DM;
    const float* md = row < TX ? modx : modc;
    float4 v[8];
    float ss = 0.f;
#pragma unroll
    for (int i = 0; i < 8; ++i) {
      v[i] = ((const float4*)s)[i * 64 + lane];
      ss += v[i].x * v[i].x + v[i].y * v[i].y + v[i].z * v[i].z + v[i].w * v[i].w;
    }
    ss = wave_sum(ss);
    const float rstd = rsqrtf(ss * (1.f / DM) + 1e-6f);
#pragma unroll
    for (int i = 0; i < 8; ++i) {
      const int d = (i * 64 + lane) * 4;
      const float4 g = *(const float4*)(gnorm + d);
      const float4 sc = *(const float4*)(md + scIdx * DM + d);
      const float4 sh = *(const float4*)(md + shIdx * DM + d);
      const float y0 = v[i].x * rstd * g.x * (1.f + sc.x) + sh.x;
      const float y1 = v[i].y * rstd * g.y * (1.f + sc.y) + sh.y;
      const float y2 = v[i].z * rstd * g.z * (1.f + sc.z) + sh.z;
      const float y3 = v[i].w * rstd * g.w * (1.f + sc.w) + sh.w;
      *(u32x2*)(dst + (size_t)row * DM + d) = mk2(pack2(y0, y1), pack2(y2, y3));
    }
  }
}

__device__ __forceinline__ float conv3_at(const P& p, int part, int ch, int toff, int L, int s) {
  const int c = part * 1024 + ch;
  const float* row = p.PROJT + (size_t)c * TS + toff;
  float v = p.ev_conv_b[c] + p.ev_conv_w[3072 + c] * row[s];
  if (s > 0) v += p.ev_conv_w[c] * row[s - 1];
  if (s < L - 1) v += p.ev_conv_w[2 * 3072 + c] * row[s + 1];
  return v;
}

__device__ __forceinline__ float4 conv3_vec4(const P& p, int part, int ch, int toff, int L, int s0) {
  const int c = part * 1024 + ch;
  const float* row = p.PROJT + (size_t)c * TS + toff;
  const float4 m = *(const float4*)(row + s0);
  const float l = (s0 > 0) ? row[s0 - 1] : 0.f;
  const float r = (s0 + 4 < L) ? row[s0 + 4] : 0.f;
  const float b = p.ev_conv_b[c], w0 = p.ev_conv_w[c], w1 = p.ev_conv_w[3072 + c], w2 = p.ev_conv_w[2 * 3072 + c];
  float4 o;
  o.x = b + w0 * l + w1 * m.x + w2 * m.y;
  o.y = b + w0 * m.x + w1 * m.y + w2 * m.z;
  o.z = b + w0 * m.y + w1 * m.z + w2 * m.w;
  o.w = b + w0 * m.z + w1 * m.w + w2 * r;
  return o;
}

#define C3_LOAD(M, Lf, Rt, part, s0) { const float* row_ = p.PROJT + (size_t)((part) * 1024 + ch) * TS + toff; \
    M = *(const f32x4*)(row_ + (s0)); Lf = ((s0) > 0) ? row_[(s0) - 1] : 0.f; Rt = ((s0) + 4 < L) ? row_[(s0) + 4] : 0.f; }
__device__ __forceinline__ f32x4 c3_eval(f32x4 m, float l, float r, float b, float w0, float w1, float w2) {
  f32x4 o;
  o.x = b + w0 * l + w1 * m.x + w2 * m.y;
  o.y = b + w0 * m.x + w1 * m.y + w2 * m.z;
  o.z = b + w0 * m.y + w1 * m.z + w2 * m.w;
  o.w = b + w0 * m.z + w1 * m.w + w2 * r;
  return o;
}

template <int SEQ>
__device__ __forceinline__ void hyena_item(const P& p, char* smem, int ch) {
  constexpr int L = SEQ ? 256 : TX;
  constexpr int toff = SEQ ? TX : 0;
  constexpr int nB = L >> 7;
  constexpr int NT = SEQ ? 1 : 4;
  bf16_t* KK = (bf16_t*)smem;
  float* ybuf = (float*)smem;
  bf16_t* UP = (bf16_t*)(smem + 34816);
  bf16_t* CP = (bf16_t*)(smem + 51712);
  float* red = (float*)(smem + 59904);
  const int tid = threadIdx.x, lane = tid & 63, w = tid >> 6;
  for (int n = 0; n < 2; ++n) {
    const bf16_t* ff = p.FILT + (size_t)(n * 1024 + ch) * TS + toff;
    const bf16_t* fb = p.FILT + (size_t)(2048 + n * 1024 + ch) * TS + toff;
    float sabs = 0.f;
    {
      constexpr int NKK = ((2 * L) / 8 + 255) / 256;
      u32x4 kv[NKK];
#pragma unroll
      for (int k = 0; k < NKK; ++k) {
        const int idx = (tid + 256 * k) * 8;
        kv[k] = mk4(0u, 0u, 0u, 0u);
        if (idx < 2 * L) kv[k] = (idx >= L) ? *(const u32x4*)(ff + (idx - L)) : *(const u32x4*)(fb + (L - 8 - idx));
      }
#pragma unroll
      for (int k = 0; k < NKK; ++k) {
        const int idx = (tid + 256 * k) * 8;
        if (idx < 2 * L) {
          u32x4 v = kv[k];
          if (idx < L) {
            const u32x4 r = v;
            v.x = (r.w >> 16) | (r.w << 16); v.y = (r.z >> 16) | (r.z << 16); v.z = (r.y >> 16) | (r.y << 16); v.w = (r.x >> 16) | (r.x << 16);
          }
          sabs += fabsf(bflo(v.x)) + fabsf(bfhi(v.x)) + fabsf(bflo(v.y)) + fabsf(bfhi(v.y)) + fabsf(bflo(v.z)) + fabsf(bfhi(v.z)) + fabsf(bflo(v.w)) + fabsf(bfhi(v.w));
          *(u32x4*)(KK + (idx >> 7) * 136 + (idx & 127)) = v;
        }
      }
    }
    sabs = wave_sum(sabs);
    if (lane == 0) red[w] = sabs;
    const float cb0 = p.ev_conv_b[ch], cw00 = p.ev_conv_w[ch], cw01 = p.ev_conv_w[3072 + ch], cw02 = p.ev_conv_w[2 * 3072 + ch];
    {
      constexpr int NUP = ((L + 256) / 4 + 255) / 256;
      if (n == 0) {
        constexpr int CH = SEQ ? 1 : 3;
#pragma unroll 1
        for (int k0 = 0; k0 < NUP; k0 += CH) {
          f32x4 cm[CH]; float cl[CH], cr[CH];
#pragma unroll
          for (int k = 0; k < CH; ++k) {
            const int s0 = (tid + 256 * (k0 + k)) * 4 - 128;
            cm[k] = (f32x4){0.f, 0.f, 0.f, 0.f}; cl[k] = 0.f; cr[k] = 0.f;
            if (s0 >= 0 && s0 < L) C3_LOAD(cm[k], cl[k], cr[k], 0, s0)
          }
#pragma unroll
          for (int k = 0; k < CH; ++k) {
            const int iv = tid + 256 * (k0 + k), s0 = iv * 4 - 128;
            if (iv < (L + 256) / 4) {
              f32x4 u = (f32x4){0.f, 0.f, 0.f, 0.f};
              if (s0 >= 0 && s0 < L) u = c3_eval(cm[k], cl[k], cr[k], cb0, cw00, cw01, cw02);
              *(u32x2*)(UP + iv * 4) = mk2(pack2(u.x, u.y), pack2(u.z, u.w));
            }
          }
        }
      } else {
        f32x4 zv[NUP];
#pragma unroll
        for (int k = 0; k < NUP; ++k) {
          const int s0 = (tid + 256 * k) * 4 - 128;
          zv[k] = (f32x4){0.f, 0.f, 0.f, 0.f};
          if (s0 >= 0 && s0 < L) zv[k] = *(const f32x4*)(p.Z1 + (size_t)ch * TS + toff + s0);
        }
#pragma unroll
        for (int k = 0; k < NUP; ++k) {
          const int iv = tid + 256 * k;
          if (iv < (L + 256) / 4) *(u32x2*)(UP + iv * 4) = mk2(pack2(zv[k].x, zv[k].y), pack2(zv[k].z, zv[k].w));
        }
      }
    }
    __syncthreads();
    const float invS = 1.f / (red[0] + red[1] + red[2] + red[3]);

    f32x4 acc[2][NT];
#pragma unroll
    for (int a = 0; a < 2; ++a)
#pragma unroll
      for (int b = 0; b < NT; ++b) acc[a][b] = (f32x4){0.f, 0.f, 0.f, 0.f};

    auto build_window = [&](int c, int buf) {
      const int sg = tid >> 5, y0 = (tid & 31) * 8;
      uint32_t wv[4] = {0u, 0u, 0u, 0u};
      if (y0 < 248) {
        const int base = (c + 1) * 128 - 1 - y0 - sg + 128;
#pragma unroll
        for (int e = 0; e < 4; ++e) wv[e] = (uint32_t)UP[base - 2 * e] | ((uint32_t)UP[base - 2 * e - 1] << 16);
      }
      *(u32x4*)(CP + buf * 2048 + sg * 256 + y0) = mk4(wv[0], wv[1], wv[2], wv[3]);
    };
    build_window(0, 0);
    __syncthreads();
    for (int c = 0; c <= nB; ++c) {
      const int buf = c & 1;
      if (c < nB) build_window(c + 1, buf ^ 1);
      const bf16_t* cp = CP + buf * 2048;
      bf16x8 aF[2][2], bF[2][NT];
      const bf16_t* kbase[NT];
#pragma unroll
      for (int nt = 0; nt < NT; ++nt) {
        int e = nt * 16 + (lane & 15);
        if (e > nB - 1) e = nB - 1;
        kbase[nt] = KK + (e - c + nB) * 136 + 8 * (lane >> 4);
      }
      const bf16_t* abase = cp + 120 + 8 * (lane >> 4) - 8 * (lane & 15);
#pragma unroll
      for (int mi = 0; mi < 2; ++mi) aF[0][mi] = *(const bf16x8*)(abase + (7 - (2 * w + mi)) * 256);
#pragma unroll
      for (int nt = 0; nt < NT; ++nt) bF[0][nt] = *(const bf16x8*)(kbase[nt]);
#pragma unroll
      for (int js = 0; js < 4; ++js) {
        if (js < 3) {
#pragma unroll
          for (int mi = 0; mi < 2; ++mi) aF[(js + 1) & 1][mi] = *(const bf16x8*)(abase + (7 - (2 * w + mi)) * 256 + 32 * (js + 1));
#pragma unroll
          for (int nt = 0; nt < NT; ++nt) bF[(js + 1) & 1][nt] = *(const bf16x8*)(kbase[nt] + 32 * (js + 1));
        }
#pragma unroll
        for (int nt = 0; nt < NT; ++nt)
#pragma unroll
          for (int mi = 0; mi < 2; ++mi)
            acc[mi][nt] = __builtin_amdgcn_mfma_f32_16x16x32_bf16(aF[js & 1][mi], bF[js & 1][nt], acc[mi][nt], 0, 0, 0);
      }
      __syncthreads();
    }
#pragma unroll
    for (int mi = 0; mi < 2; ++mi)
#pragma unroll
      for (int nt = 0; nt < NT; ++nt) {
        const int e = nt * 16 + (lane & 15);
        if (e < nB) {
#pragma unroll
          for (int j = 0; j < 4; ++j) {
            const int rho = (lane >> 4) * 4 + j;
            const int tau = (2 * w + mi) + 8 * rho;
            ybuf[e * 128 + tau] = acc[mi][nt][j] * invS;
          }
        }
      }
    __syncthreads();
    const float bias = p.hy_bias[n * 1024 + ch];
    {
      constexpr int NE = (L / 4 + 255) / 256;
      const int pa = (n == 0) ? 1 : 2;
      const float pb = p.ev_conv_b[pa * 1024 + ch], pw0 = p.ev_conv_w[pa * 1024 + ch], pw1 = p.ev_conv_w[3072 + pa * 1024 + ch], pw2 = p.ev_conv_w[2 * 3072 + pa * 1024 + ch];
      constexpr int CE = SEQ ? 1 : 4;
#pragma unroll 1
      for (int k0 = 0; k0 < NE; k0 += CE) {
        f32x4 am[CE], bm[CE];
        float al[CE], ar[CE], bl[CE], br[CE];
#pragma unroll
        for (int k = 0; k < CE; ++k) {
          const int t0 = (tid + 256 * (k0 + k)) * 4;
          am[k] = (f32x4){0.f, 0.f, 0.f, 0.f}; bm[k] = am[k]; al[k] = 0.f; ar[k] = 0.f; bl[k] = 0.f; br[k] = 0.f;
          if (t0 < L) {
            C3_LOAD(am[k], al[k], ar[k], pa, t0)
            if (n == 0) C3_LOAD(bm[k], bl[k], br[k], 0, t0)
            else bm[k] = *(const f32x4*)(p.Z1 + (size_t)ch * TS + toff + t0);
          }
        }
#pragma unroll
        for (int k = 0; k < CE; ++k) {
          const int t0 = (tid + 256 * (k0 + k)) * 4;
          if (t0 < L) {
            const f32x4 y = *(const f32x4*)(ybuf + t0);
            const f32x4 xm = c3_eval(am[k], al[k], ar[k], pb, pw0, pw1, pw2);
            if (n == 0) {
              const f32x4 v = c3_eval(bm[k], bl[k], br[k], cb0, cw00, cw01, cw02);
              f32x4 z;
              z.x = xm.x * (y.x + bias * v.x); z.y = xm.y * (y.y + bias * v.y); z.z = xm.z * (y.z + bias * v.z); z.w = xm.w * (y.w + bias * v.w);
              *(f32x4*)(p.Z1 + (size_t)ch * TS + toff + t0) = z;
            } else {
              const f32x4 z1 = bm[k];
              bf16_t* o = p.ABUF1 + (size_t)(toff + t0) * DM + ch;
              o[0] = f2bf(xm.x * (y.x + bias * z1.x));
              o[DM] = f2bf(xm.y * (y.y + bias * z1.y));
              o[2 * DM] = f2bf(xm.z * (y.z + bias * z1.z));
              o[3 * DM] = f2bf(xm.w * (y.w + bias * z1.w));
            }
          }
        }
      }
    }
    __threadfence_block();
    __syncthreads();
  }
}

__device__ __forceinline__ void gmlp_item(const P& p, char* smem, int n, int h) {
  bf16_t* Bt = (bf16_t*)smem;
  float* rs = (float*)(smem + 34816);
  const int tid = threadIdx.x, lane = tid & 63, w = tid >> 6;
  const float* VG = p.PROJT + (size_t)4096 * TS + n * 128;
  {
    const int c8 = tid >> 5, q4 = (tid & 31) * 4;
    float4 s4 = make_float4(0.f, 0.f, 0.f, 0.f);
#pragma unroll 16
    for (int c = c8; c < 1024; c += 8) {
      const float4 v = *(const float4*)(VG + (size_t)c * TS + q4);
      s4.x += v.x * v.x; s4.y += v.y * v.y; s4.z += v.z * v.z; s4.w += v.w * v.w;
    }
    float* rs8 = rs + 128;
    *(float4*)(rs8 + c8 * 128 + q4) = s4;
  }
  __syncthreads();
  if (tid < 128) {
    float a = 0.f;
#pragma unroll
    for (int g = 0; g < 8; ++g) a += rs[128 + g * 128 + tid];
    rs[tid] = rsqrtf(a * (1.f / 1024.f) + 1e-6f);
  }
  __syncthreads();
  {
    const int c = tid >> 1, q0 = (tid & 1) * 64;
    const float g = p.gm_norm[h * 128 + c];
    const float* src = VG + (size_t)(h * 128 + c) * TS + q0;
#pragma unroll 4
    for (int i = 0; i < 16; ++i) {
      const float4 v = *(const float4*)(src + 4 * i);
      const int q = q0 + 4 * i;
      *(u32x2*)(Bt + c * 136 + q) = mk2(pack2(v.x * rs[q] * g, v.y * rs[q + 1] * g), pack2(v.z * rs[q + 2] * g, v.w * rs[q + 3] * g));
    }
  }
  __syncthreads();
  f32x4 acc[2][8];
#pragma unroll
  for (int a = 0; a < 2; ++a)
#pragma unroll
    for (int b = 0; b < 8; ++b) acc[a][b] = (f32x4){0.f, 0.f, 0.f, 0.f};
  const bf16_t* Aw = p.GMWS + (size_t)h * 128 * 128;
  bf16x8 afA[4][2];
#pragma unroll
  for (int ks = 0; ks < 4; ++ks)
#pragma unroll
    for (int mi = 0; mi < 2; ++mi)
      afA[ks][mi] = *(const bf16x8*)(Aw + (32 * w + 16 * mi + (lane & 15)) * 128 + ks * 32 + (lane >> 4) * 8);
#pragma unroll
  for (int ks = 0; ks < 4; ++ks) {
    bf16x8 bB[8];
#pragma unroll
    for (int ni = 0; ni < 8; ++ni) bB[ni] = *(const bf16x8*)(Bt + (ni * 16 + (lane & 15)) * 136 + ks * 32 + (lane >> 4) * 8);
#pragma unroll
    for (int ni = 0; ni < 8; ++ni)
#pragma unroll
      for (int mi = 0; mi < 2; ++mi)
        acc[mi][ni] = __builtin_amdgcn_mfma_f32_16x16x32_bf16(afA[ks][mi], bB[ni], acc[mi][ni], 0, 0, 0);
  }
#pragma unroll
  for (int mi = 0; mi < 2; ++mi)
#pragma unroll
    for (int ni = 0; ni < 8; ++ni) {
      const int c = ni * 16 + (lane & 15);
      const int p0 = 32 * w + 16 * mi + (lane >> 4) * 4;
      const float4 u = *(const float4*)(p.PROJT + (size_t)(3072 + h * 128 + c) * TS + n * 128 + p0);
      const float uu[4] = {u.x, u.y, u.z, u.w};
#pragma unroll
      for (int j = 0; j < 4; ++j) {
        const int pp = p0 + j;
        const float s = acc[mi][ni][j] + p.gm_bs[h * 128 + pp];
        p.ABUF1[(size_t)(n * 128 + pp) * DM + 1024 + h * 128 + c] = f2bf(uu[j] * s);
      }
    }
  __syncthreads();
}

#define BF8(dst, o, q) dst[o + 0] = bflo(q.x); dst[o + 1] = bfhi(q.x); dst[o + 2] = bflo(q.y); dst[o + 3] = bfhi(q.y); \
                       dst[o + 4] = bflo(q.z); dst[o + 5] = bfhi(q.z); dst[o + 6] = bflo(q.w); dst[o + 7] = bfhi(q.w);
template <int LAST>
__device__ __forceinline__ void ph_peer(const P& p, int layer, int ntok, char* smem, int bid, int nb) {
  const int tid = threadIdx.x, lane = tid & 63, w = tid >> 6;
  int* sExp = (int*)smem + w * 32;
  float* sGate = (float*)(smem + 512) + w * 32;
  uint32_t* LL = (uint32_t*)(smem + 1024) + w * 128;
  float* sPart = (float*)(smem + 4096);
  float* sRed = (float*)(smem + 4096 + 32768);
  const unsigned char* UBl = p.UB + (size_t)layer * 16384 * ROWB;
  const unsigned char* VBl = p.VB + (size_t)layer * 16384 * ROWB;
  const float* SUl = p.SU + layer * 16384;
  const float* SVl = p.SV + layer * 16384;
  const bf16_t* HP = LAST ? p.ABUF1 : p.ABUF0;
  float scv[8];
  if (bid < ntok) {
    const float* sp = p.SC + (size_t)bid * DM + w * 512 + lane;
#pragma unroll
    for (int k = 0; k < 8; ++k) scv[k] = sp[k * 64];
  }
  for (int t = bid; t < ntok; t += nb) {
    for (int rep_ = 0; rep_ < REP_TOPK; ++rep_) {
      uint32_t key[4][2], prefix[4];
      int need[4];
#pragma unroll
      for (int g = 0; g < 4; ++g) {
        key[g][0] = (((fkey(scv[g * 2 + 0]) + 0x2000u) >> 14) << 7) | (uint32_t)lane;
        key[g][1] = (((fkey(scv[g * 2 + 1]) + 0x2000u) >> 14) << 7) | (uint32_t)(lane + 64);
        prefix[g] = 0u; need[g] = 16;
      }
#pragma unroll 4
      for (int bit = 24; bit >= 0; --bit) {
        const uint32_t mh = ~((1u << bit) - 1u);
#pragma unroll
        for (int g = 0; g < 4; ++g) {
          const uint32_t cand = prefix[g] | (1u << bit);
          const int c = __popcll(__ballot((key[g][0] & mh) == cand)) + __popcll(__ballot((key[g][1] & mh) == cand));
          const bool ge_ = c >= need[g];
          prefix[g] = ge_ ? cand : prefix[g];
          need[g] = ge_ ? need[g] : need[g] - c;
        }
      }
#pragma unroll
      for (int g = 0; g < 4; ++g) {
        const bool q0 = key[g][0] >= prefix[g], q1 = key[g][1] >= prefix[g];
        const unsigned long long b0 = __ballot(q0), b1 = __ballot(q1);
        const int r0 = __builtin_amdgcn_mbcnt_hi((unsigned)(b0 >> 32), __builtin_amdgcn_mbcnt_lo((unsigned)b0, 0u));
        const int r1 = __popcll(b0) + __builtin_amdgcn_mbcnt_hi((unsigned)(b1 >> 32), __builtin_amdgcn_mbcnt_lo((unsigned)b1, 0u));
        uint32_t* Ls = LL + (g >> 1) * 48 + (g & 1) * 16;
        if (q0) Ls[r0 & 15] = key[g][0];
        if (q1) Ls[r1 & 15] = key[g][1];
      }
      const int ci_ = lane >> 2, jb = (lane & 3) * 4;
      uint32_t pk[2][4], cpre[2];
      int cneed[2];
#pragma unroll
      for (int hh = 0; hh < 2; ++hh) {
        const float s0 = funkey((LL[hh * 48 + ci_] >> 7) << 14);
#pragma unroll
        for (int jj = 0; jj < 4; ++jj) {
          const float s1 = funkey((LL[hh * 48 + 16 + jb + jj] >> 7) << 14);
          pk[hh][jj] = (((fkey(s0 + s1) + 0x2000u) >> 14) << 8) | (uint32_t)(ci_ * 16 + jb + jj);
        }
        cpre[hh] = 0u; cneed[hh] = 16;
      }
#pragma unroll 4
      for (int bit = 25; bit >= 0; --bit) {
        const uint32_t mh = ~((1u << bit) - 1u);
#pragma unroll
        for (int hh = 0; hh < 2; ++hh) {
          const uint32_t cand = cpre[hh] | (1u << bit);
          const int c = __popcll(__ballot((pk[hh][0] & mh) == cand)) + __popcll(__ballot((pk[hh][1] & mh) == cand)) +
                        __popcll(__ballot((pk[hh][2] & mh) == cand)) + __popcll(__ballot((pk[hh][3] & mh) == cand));
          const bool ge_ = c >= cneed[hh];
          cpre[hh] = ge_ ? cand : cpre[hh];
          cneed[hh] = ge_ ? cneed[hh] : cneed[hh] - c;
        }
      }
#pragma unroll
      for (int hh = 0; hh < 2; ++hh) {
        uint32_t* L0 = LL + hh * 48;
        uint32_t* L1 = L0 + 16;
        uint32_t* L2 = L0 + 32;
        int basec = 0;
#pragma unroll
        for (int jj = 0; jj < 4; ++jj) {
          const bool q = pk[hh][jj] >= cpre[hh];
          const unsigned long long bq = __ballot(q);
          const int r = basec + __builtin_amdgcn_mbcnt_hi((unsigned)(bq >> 32), __builtin_amdgcn_mbcnt_lo((unsigned)bq, 0u));
          if (q) L2[r & 15] = pk[hh][jj];
          basec += __popcll(bq);
        }
        const uint32_t mine = L2[lane & 15];
        const int cidx = (int)(mine & 255u);
        const float cv = funkey((mine >> 8) << 14);
        const int ia = (int)(L0[(cidx >> 4) & 15] & 127u);
        const int ib = (int)(L1[cidx & 15] & 127u);
        float mx = cv;
#pragma unroll
        for (int o = 8; o >= 1; o >>= 1) mx = fmaxf(mx, __shfl_xor(mx, o));
        const float ev = __expf(cv - mx);
        float sum = ev;
#pragma unroll
        for (int o = 8; o >= 1; o >>= 1) sum += __shfl_xor(sum, o);
        if (lane < 16) {
          sExp[hh * 16 + lane] = ia * 128 + ib;
          sGate[hh * 16 + lane] = ev / sum;
        }
      }
    }
    if (t + nb < ntok) {
      const float* sp = p.SC + (size_t)(t + nb) * DM + w * 512 + lane;
#pragma unroll
      for (int k = 0; k < 8; ++k) scv[k] = sp[k * 64];
    }
    u32x4 xq[4];
    {
      const u32x4* xr = (const u32x4*)(HP + (size_t)t * DM) + lane * 4;
#pragma unroll
      for (int q = 0; q < 4; ++q) xq[q] = xr[q];
    }
    float acc[32];
#pragma unroll
    for (int i = 0; i < 32; ++i) acc[i] = 0.f;
    u32x2 ub[2][3], vb[2][3];
    int ex[2], exn[2];
#pragma unroll
    for (int e = 0; e < 2; ++e) {
      exn[e] = __builtin_amdgcn_readfirstlane(sExp[e]);
      const u32x2* ur = (const u32x2*)(UBl + (size_t)exn[e] * ROWB) + lane;
#pragma unroll
      for (int jc = 0; jc < 3; ++jc) ub[e][jc] = ur[jc * 64];
    }
#pragma unroll 1
    for (int eb = 0; eb < 32; eb += 2) {
      float d[2];
#pragma unroll
      for (int e = 0; e < 2; ++e) {
        ex[e] = exn[e];
        v6u pk;
        pk[0] = ub[e][0].x; pk[1] = ub[e][0].y; pk[2] = ub[e][1].x; pk[3] = ub[e][1].y; pk[4] = ub[e][2].x; pk[5] = ub[e][2].y;
        const v32f uu = __builtin_amdgcn_cvt_scalef32_pk32_f32_fp6(pk, 1.0f);
        float sdot = 0.f;
#pragma unroll
        for (int q = 0; q < 4; ++q) {
          sdot += bflo(xq[q].x) * uu[q * 8 + 0] + bfhi(xq[q].x) * uu[q * 8 + 1] + bflo(xq[q].y) * uu[q * 8 + 2] + bfhi(xq[q].y) * uu[q * 8 + 3] +
                  bflo(xq[q].z) * uu[q * 8 + 4] + bfhi(xq[q].z) * uu[q * 8 + 5] + bflo(xq[q].w) * uu[q * 8 + 6] + bfhi(xq[q].w) * uu[q * 8 + 7];
        }
        d[e] = sdot;
        __builtin_amdgcn_sched_barrier(0);
      }
#pragma unroll
      for (int e = 0; e < 2; ++e) {
        const u32x2* vr = (const u32x2*)(VBl + (size_t)ex[e] * ROWB) + lane;
#pragma unroll
        for (int jc = 0; jc < 3; ++jc) vb[e][jc] = vr[jc * 64];
      }
      if (eb + 2 < 32) {
#pragma unroll
        for (int e = 0; e < 2; ++e) {
          exn[e] = __builtin_amdgcn_readfirstlane(sExp[eb + 2 + e]);
          const u32x2* ur = (const u32x2*)(UBl + (size_t)exn[e] * ROWB) + lane;
#pragma unroll
          for (int jc = 0; jc < 3; ++jc) ub[e][jc] = ur[jc * 64];
        }
      }
#pragma unroll
      for (int o = 32; o >= 1; o >>= 1) {
#pragma unroll
        for (int e = 0; e < 2; ++e) d[e] += __shfl_xor(d[e], o);
      }
#pragma unroll
      for (int e = 0; e < 2; ++e) {
        const float wg = sGate[eb + e] * gelu_f(d[e] * SUl[ex[e]]) * SVl[ex[e]];
        v6u pk;
        pk[0] = vb[e][0].x; pk[1] = vb[e][0].y; pk[2] = vb[e][1].x; pk[3] = vb[e][1].y; pk[4] = vb[e][2].x; pk[5] = vb[e][2].y;
        const v32f vv = __builtin_amdgcn_cvt_scalef32_pk32_f32_fp6(pk, 1.0f);
#pragma unroll
        for (int k = 0; k < 32; ++k) acc[k] += wg * vv[k];
        __builtin_amdgcn_sched_barrier(0);
      }
    }
    {
      float* dst = sPart + w * 2048 + lane * 32;
#pragma unroll
      for (int q = 0; q < 8; ++q) *(float4*)(dst + q * 4) = make_float4(acc[q * 4 + 0], acc[q * 4 + 1], acc[q * 4 + 2], acc[q * 4 + 3]);
    }
    __syncthreads();
    const int d0 = tid * 8;
    float r[8];
    {
      float4 a = *(const float4*)(sPart + d0), b = *(const float4*)(sPart + d0 + 4);
#pragma unroll
      for (int ww = 1; ww < 4; ++ww) {
        const float4 a2 = *(const float4*)(sPart + ww * 2048 + d0), b2 = *(const float4*)(sPart + ww * 2048 + d0 + 4);
        a.x += a2.x; a.y += a2.y; a.z += a2.z; a.w += a2.w; b.x += b2.x; b.y += b2.y; b.z += b2.z; b.w += b2.w;
      }
      r[0] = a.x; r[1] = a.y; r[2] = a.z; r[3] = a.w; r[4] = b.x; r[5] = b.y; r[6] = b.z; r[7] = b.w;
    }
    const int which = (t < TX) ? 0 : 1;
    const float* md = p.MOD + (size_t)(layer * 2 + which) * 12288;
    float* xrow = p.XA + (size_t)t * DM;
    float ss = 0.f;
#pragma unroll
    for (int hq = 0; hq < 2; ++hq) {
      const float4 xv = *(const float4*)(xrow + d0 + hq * 4);
      const float4 g2 = *(const float4*)(md + 5 * DM + d0 + hq * 4);
      float4 o;
      o.x = xv.x + g2.x * r[hq * 4 + 0]; o.y = xv.y + g2.y * r[hq * 4 + 1];
      o.z = xv.z + g2.z * r[hq * 4 + 2]; o.w = xv.w + g2.w * r[hq * 4 + 3];
      r[hq * 4 + 0] = o.x; r[hq * 4 + 1] = o.y; r[hq * 4 + 2] = o.z; r[hq * 4 + 3] = o.w;
      ss += o.x * o.x + o.y * o.y + o.z * o.z + o.w * o.w;
      if (!LAST) *(float4*)(xrow + d0 + hq * 4) = o;
    }
    ss = wave_sum(ss);
    if (lane == 0) sRed[w] = ss;
    __syncthreads();
    const float rstd = rsqrtf((sRed[0] + sRed[1] + sRed[2] + sRed[3]) * (1.f / DM) + 1e-6f);
    if (LAST) {
      float* orow = p.out + (size_t)t * DM;
#pragma unroll
      for (int hq = 0; hq < 2; ++hq) {
        const float4 g = *(const float4*)(p.norm_final + d0 + hq * 4);
        float4 o;
        o.x = r[hq * 4 + 0] * rstd * g.x; o.y = r[hq * 4 + 1] * rstd * g.y; o.z = r[hq * 4 + 2] * rstd * g.z; o.w = r[hq * 4 + 3] * rstd * g.w;
        *(float4*)(orow + d0 + hq * 4) = o;
      }
    } else {
      const float* md1 = p.MOD + (size_t)(2 + which) * 12288;
      const float* gn = p.norm_mix + DM;
      uint32_t o[4];
#pragma unroll
      for (int hq = 0; hq < 2; ++hq) {
        const float4 g = *(const float4*)(gn + d0 + hq * 4);
        const float4 sh = *(const float4*)(md1 + 0 * DM + d0 + hq * 4);
        const float4 sc = *(const float4*)(md1 + 1 * DM + d0 + hq * 4);
        const float y0 = r[hq * 4 + 0] * rstd * g.x * (1.f + sc.x) + sh.x;
        const float y1 = r[hq * 4 + 1] * rstd * g.y * (1.f + sc.y) + sh.y;
        const float y2 = r[hq * 4 + 2] * rstd * g.z * (1.f + sc.z) + sh.z;
        const float y3 = r[hq * 4 + 3] * rstd * g.w * (1.f + sc.w) + sh.w;
        o[hq * 2 + 0] = pack2(y0, y1); o[hq * 2 + 1] = pack2(y2, y3);
      }
      *(u32x4*)(p.ABUF1 + (size_t)t * DM + d0) = mk4(o[0], o[1], o[2], o[3]);
    }
    __syncthreads();
  }
}

__device__ __forceinline__ void ph_scores(const P& p, int ph, char* smem, int bid, int nb) {
  const int tid = threadIdx.x, lane = tid & 63, wid = tid >> 6, wr = wid >> 1, wc = wid & 1;
        const int layer = (ph == 7) ? 0 : 1;
        const int numM = (ph == 7) ? 66 : 64;
        bf16_t* sA = (bf16_t*)smem;
        bf16_t* sB = sA + 128 * LDS_S;
        for (int id = bid; id < numM * 16; id += nb) {
          const int mt = id % numM, hs = id / numM;
          f32x4 acc[4][4];
          gemm_core(acc, p.QB + (size_t)mt * 128 * DM + hs * 128, DM, p.KEYB + (size_t)(layer * 16 + hs) * 128 * 128, 128, 128, sA, sB);
#pragma unroll
          for (int mi = 0; mi < 4; ++mi)
#pragma unroll
            for (int ni = 0; ni < 4; ++ni)
#pragma unroll
              for (int j = 0; j < 4; ++j) {
                const int row = mt * 128 + wr * 64 + mi * 16 + (lane >> 4) * 4 + j;
                const int col = wc * 64 + ni * 16 + (lane & 15);
                p.SC[(size_t)row * DM + hs * 128 + col] = acc[mi][ni][j];
              }
        }
}

#define XB_TMO      128
#define XB_XCNT(j)  (256  + 64 * (j))
#define XB_XSUB(j)  (1280 + 64 * (j))
#define XB_XGEN(j)  (2304 + 64 * (j))
#define XB_TOP      3328
#define XB_TOPGEN   3392
#define XCD_BAR_WORDS 3456
#define XB_SPIN_CAP (1u << 22)
#define LAS __attribute__((address_space(3)))
__device__ __forceinline__ unsigned xb_ld(unsigned* p)              { return __hip_atomic_load(p, __ATOMIC_RELAXED, __HIP_MEMORY_SCOPE_AGENT); }
__device__ __forceinline__ unsigned xb_add(unsigned* p, unsigned v) { return __hip_atomic_fetch_add(p, v, __ATOMIC_RELAXED, __HIP_MEMORY_SCOPE_AGENT); }
__device__ __forceinline__ unsigned xb_xcc_id() { return (unsigned)__builtin_amdgcn_s_getreg((3 << 11) | 20) & 0xFu; }
#define XB_SPIN(cond, bar) do { unsigned _sp = 0; while (cond) { __builtin_amdgcn_s_sleep(1); \
    if ((++_sp & 255u) == 0u) { if (xb_ld(&(bar)[XB_TMO])) break; if (_sp > XB_SPIN_CAP) { atomicAdd(&(bar)[XB_TMO], 1u); break; } } } } while (0)
struct XcdBarrier { unsigned* bar; unsigned x; volatile LAS unsigned* st; };
__device__ __forceinline__ XcdBarrier xcd_barrier_post(unsigned* bar, volatile LAS unsigned* st) {
  XcdBarrier b; b.bar = bar; b.x = xb_xcc_id(); b.st = st;
  if (threadIdx.x == 0) (void)xb_add(&bar[XB_XCNT(b.x)], 1u);
  return b;
}
__device__ __forceinline__ void xcd_barrier_complete(unsigned* bar, unsigned x, unsigned& nloc, unsigned& nx, unsigned G) {
  unsigned sum, cnt, mine, sp = 0u;
  for (;;) {
    sum = 0u; cnt = 0u; mine = 0u;
#pragma unroll
    for (unsigned j = 0; j < 16; ++j) { const unsigned c = xb_ld(&bar[XB_XCNT(j)]); sum += c; cnt += (c > 0u) ? 1u : 0u; mine = (j == x) ? c : mine; }
    if (sum == G) break;
    __builtin_amdgcn_s_sleep(1);
    if ((++sp & 255u) == 0u) { if (xb_ld(&bar[XB_TMO])) break; if (sp > XB_SPIN_CAP) { atomicAdd(&bar[XB_TMO], 1u); break; } }
  }
  nloc = mine > 0u ? mine : 1u; nx = cnt > 0u ? cnt : 1u;
}
__device__ __forceinline__ void xcd_barrier_impl(unsigned* bar, unsigned x, volatile LAS unsigned* st, int tid_, unsigned G_) {
  asm volatile("s_waitcnt vmcnt(0)" ::: "memory");
  __syncthreads();
  if (tid_ == 0) {
    __builtin_amdgcn_s_waitcnt(0);
    const unsigned nloc = st[0], nx = st[1];
    const unsigned old = xb_add(&bar[XB_XSUB(x)], 1u);
    const unsigned gen = old / nloc;
    if (old + 1u == (gen + 1u) * nloc) {
      __builtin_amdgcn_fence(__ATOMIC_RELEASE, "agent");
      asm volatile("s_waitcnt vmcnt(0)" ::: "memory");
      const unsigned og = xb_add(&bar[XB_TOP], 1u);
      const unsigned tg = og / nx;
      if (og + 1u == (tg + 1u) * nx) xb_add(&bar[XB_TOPGEN], 1u);
      else XB_SPIN(xb_ld(&bar[XB_TOPGEN]) == tg, bar);
      __builtin_amdgcn_fence(__ATOMIC_ACQUIRE, "agent");
      xb_add(&bar[XB_XGEN(x)], 1u);
      asm volatile("s_waitcnt vmcnt(0)" ::: "memory");
    } else {
      XB_SPIN(xb_ld(&bar[XB_XGEN(x)]) == gen, bar);
      __builtin_amdgcn_fence(__ATOMIC_ACQUIRE, "agent");
      asm volatile("s_waitcnt vmcnt(0)" ::: "memory");
    }
  }
  __syncthreads();
}

template <bool COOP>
__global__ void __launch_bounds__(256, 2) mega(P p, int ph_lo, int ph_hi) {
  __shared__ __attribute__((aligned(16))) char smem[61424];
  const int bid = blockIdx.x, nb = gridDim.x;
  const int tid = threadIdx.x, lane = tid & 63, wid = tid >> 6;
  const int wr = wid >> 1, wc = wid & 1;
  (void)wr; (void)wc; (void)lane;
  if constexpr (COOP) { if (ph_hi < 0) cg::this_grid().sync(); }
  __shared__ uint4 xb_words;
  XcdBarrier xb;
  xb.bar = p.BAR; xb.x = 0u; xb.st = (volatile LAS unsigned*)&xb_words;
  if constexpr (COOP) {
    if (tid == 0) { xb.st[0] = 0u; xb.st[1] = 0u; }
    __syncthreads();
    xb = xcd_barrier_post(p.BAR, (volatile LAS unsigned*)&xb_words);
    if (tid == 0) {
      unsigned nloc = 1u, nx = 1u;
      xcd_barrier_complete(p.BAR, xb.x, nloc, nx, (unsigned)nb);
      xb.st[0] = nloc; xb.st[1] = nx;
    }
    __syncthreads();
  }
  {
    {
      if (PHON(0) && ph_lo <= 0 && 0 < ph_hi) { const int ph = 0; (void)ph;
        for (int rep_ = 0; rep_ < REP_P0; ++rep_) {
        ph_ada(p, smem, bid, nb, 0);
        ph_h2(p, smem, bid, nb);
        transpose_job(p.hy_w3, p.W3T, 64, 4096, 1, smem, bid, nb);
        transpose_job(p.ev_w_in, p.WT_EVIN, 2048, 5120, 1, smem, bid, nb);
        transpose_job(p.ev_w_out, p.WT_EVOUT, 2048, 2048, 1, smem, bid, nb);
        transpose_job(p.peer_q, p.WT_PQ, 2048, 2048, 1, smem, bid, nb);
        ph_small_convert(p, bid, nb);
        }
        if constexpr (COOP) if (ph + 1 < ph_hi) xcd_barrier_impl(xb.bar, xb.x, xb.st, tid, (unsigned)nb);
      }
      if (PHON(1) && ph_lo <= 1 && 1 < ph_hi) { const int ph = 1; (void)ph;
        for (int rep_ = 0; rep_ < REP_GEMM; ++rep_) {
        ph_norm(p.x, p.ctx, TS, p.norm_mix, p.MOD, p.MOD + 12288, 0, 1, p.ABUF0, bid, nb);
        gemm_phase(p.H2B, 64, p.W3T, 64, TS, 4096, 64, smem, bid, nb, [&](int row0, int col, f32x4 v) {
          const float ad = fabsf(p.hy_deltas[col]);
          float o[4];
#pragma unroll
          for (int j = 0; j < 4; ++j) {
            const int row = row0 + j;
            const float tn = row < TX ? (float)row * (1.f / 8191.f) : (float)(row - TX) * (1.f / 255.f);
            o[j] = v[j] * __expf(-tn * ad);
          }
          *(u32x2*)(p.FILT + (size_t)col * TS + row0) = mk2(pack2(o[0], o[1]), pack2(o[2], o[3]));
        });
        }
        if constexpr (COOP) if (ph + 1 < ph_hi) xcd_barrier_impl(xb.bar, xb.x, xb.st, tid, (unsigned)nb);
      }
      if (PHON(2) && ph_lo <= 2 && 2 < ph_hi) { const int ph = 2; (void)ph;
        for (int rep_ = 0; rep_ < REP_GEMM; ++rep_) {
        gemm_phase(p.ABUF0, DM, p.WT_EVIN, DM, TS, 5120, DM, smem, bid, nb, [&](int row0, int col, f32x4 v) {
          float4 o;
          if (col < 3072) { o.x = v[0]; o.y = v[1]; o.z = v[2]; o.w = v[3]; }
          else { o.x = gelu_f(v[0]); o.y = gelu_f(v[1]); o.z = gelu_f(v[2]); o.w = gelu_f(v[3]); }
          *(float4*)(p.PROJT + (size_t)col * TS + row0) = o;
        });
        }
        if constexpr (COOP) if (ph + 1 < ph_hi) xcd_barrier_impl(xb.bar, xb.x, xb.st, tid, (unsigned)nb);
      }
      if (PHON(3) && ph_lo <= 3 && 3 < ph_hi) { const int ph = 3; (void)ph;
        for (int rep_ = 0; rep_ < REP_P3; ++rep_) {
        const bool conv_first = ((bid / (nb >> 1)) & 1) != 0;
#define LATE_PREP() { ph_tables(p, bid, nb); __syncthreads(); ph_ada(p, smem, bid, nb, 1); \
          transpose_job(p.od_w_in, p.WT_ODIN, 2048, 3072, 1, smem, bid, nb); \
          transpose_job(p.od_w_out, p.WT_ODOUT, 2048, 2048, 1, smem, bid, nb); \
          transpose_job(p.peer_q + (size_t)DM * DM, p.WT_PQ + (size_t)DM * DM, 2048, 2048, 1, smem, bid, nb); \
          transpose_job(p.pool_w, p.WTPOOL, 256, 256, 4, smem, bid, nb); __syncthreads(); }
        if (conv_first) LATE_PREP()
        for (int item = bid; item < 2048 + 528; item += nb) {
          if (item < 1024) hyena_item<0>(p, smem, item);
          else if (item < 2048) hyena_item<1>(p, smem, item - 1024);
          else gmlp_item(p, smem, (item - 2048) >> 3, (item - 2048) & 7);
        }
        if (!conv_first) LATE_PREP()
        }
        if constexpr (COOP) if (ph + 1 < ph_hi) xcd_barrier_impl(xb.bar, xb.x, xb.st, tid, (unsigned)nb);
      }
      if (PHON(4) && ph_lo <= 4 && 4 < ph_hi) { const int ph = 4; (void)ph;
        for (int rep_ = 0; rep_ < REP_GEMM; ++rep_) {
        gemm_phase(p.ABUF1, DM, p.WT_EVOUT, DM, TS, DM, DM, smem, bid, nb, [&](int row0, int col, f32x4 v) {
#pragma unroll
          for (int j = 0; j < 4; ++j) {
            const int row = row0 + j;
            const float base = row < TX ? p.x[(size_t)row * DM + col] : p.ctx[(size_t)(row - TX) * DM + col];
            const float g = p.MOD[(size_t)(row < TX ? 0 : 1) * 12288 + 2 * DM + col];
            p.XA[(size_t)row * DM + col] = base + g * v[j];
          }
        });
        }
        if constexpr (COOP) if (ph + 1 < ph_hi) xcd_barrier_impl(xb.bar, xb.x, xb.st, tid, (unsigned)nb);
      }
      if (PHON(5) && ph_lo <= 5 && 5 < ph_hi) { const int ph = 5; (void)ph;
        ph_norm(p.XA, p.XA + (size_t)TX * DM, TS, p.norm_ffn, p.MOD, p.MOD + 12288, 3, 4, p.ABUF0, bid, nb);
        if constexpr (COOP) if (ph + 1 < ph_hi) xcd_barrier_impl(xb.bar, xb.x, xb.st, tid, (unsigned)nb);
      }
      if (PHON(6) && ph_lo <= 6 && 6 < ph_hi) { const int ph = 6; (void)ph;
        for (int rep_ = 0; rep_ < REP_GEMM; ++rep_) {
        gemm_phase(p.ABUF0, DM, p.WT_PQ, DM, TS, DM, DM, smem, bid, nb, [&](int row0, int col, f32x4 v) {
#pragma unroll
          for (int j = 0; j < 4; ++j) p.QB[(size_t)(row0 + j) * DM + col] = f2bf(v[j]);
        });
        }
        if constexpr (COOP) if (ph + 1 < ph_hi) xcd_barrier_impl(xb.bar, xb.x, xb.st, tid, (unsigned)nb);
      }
      if (PHON(7) && ph_lo <= 7 && 7 < ph_hi) { const int ph = 7; ph_scores(p, 7, smem, bid, nb);
        if constexpr (COOP) if (ph + 1 < ph_hi) xcd_barrier_impl(xb.bar, xb.x, xb.st, tid, (unsigned)nb);
      }
      if (PHON(8) && ph_lo <= 8 && 8 < ph_hi) { const int ph = 8; (void)ph;
        ph_peer<0>(p, 0, TS, smem, bid, nb);
        if constexpr (COOP) if (ph + 1 < ph_hi) xcd_barrier_impl(xb.bar, xb.x, xb.st, tid, (unsigned)nb);
      }
      if (PHON(9) && ph_lo <= 9 && 9 < ph_hi) { const int ph = 9; (void)ph;
        for (int rep_ = 0; rep_ < REP_GEMM; ++rep_) {
        gemm_phase(p.ABUF1, DM, p.WT_ODIN, DM, TS, 3072, DM, smem, bid, nb, [&](int row0, int col, f32x4 v) {
#pragma unroll
          for (int j = 0; j < 4; ++j) p.PROJ1[(size_t)(row0 + j) * 3072 + col] = (col < 1024) ? gelu_f(v[j]) : v[j];
        });
        }
        if constexpr (COOP) if (ph + 1 < ph_hi) xcd_barrier_impl(xb.bar, xb.x, xb.st, tid, (unsigned)nb);
      }
      if (PHON(10) && ph_lo <= 10 && 10 < ph_hi) { const int ph = 10; (void)ph;
        for (int rep_ = 0; rep_ < REP_L1S; ++rep_) {
        for (int idx = bid * 256 + tid; idx < TS * 256; idx += nb * 256) {
          const int t = idx >> 8, c4 = (idx & 255) * 4;
          const int lo = t < TX ? 0 : TX, hi = t < TX ? TX : TS;
          float4 a = *(const float4*)(p.od_conv_b + c4);
#pragma unroll
          for (int k = 0; k < 4; ++k) {
            const int tt = t + k - 1;
            if (tt >= lo && tt < hi) {
              const float4 xv = *(const float4*)(p.PROJ1 + (size_t)tt * 3072 + 1024 + c4);
              const float4 wv = *(const float4*)(p.od_conv_w + k * 1024 + c4);
              a.x += wv.x * xv.x; a.y += wv.y * xv.y; a.z += wv.z * xv.z; a.w += wv.w * xv.w;
            }
          }
          *(float4*)(p.XR + (size_t)t * 1024 + c4) = a;
          *(u32x2*)(p.XRB + (size_t)t * 1024 + c4) = mk2(pack2(a.x, a.y), pack2(a.z, a.w));
        }
        for (int idx = bid * 256 + tid; idx < TX * 256; idx += nb * 256) {
          const int t = idx >> 8, c4 = (idx & 255) * 4;
          const int half = 1 << (c4 >> 8);
          const int lo = (t - half) < 0 ? 0 : (t - half);
          const int hi = (t + half) > TX ? TX : (t + half);
          float4 s = make_float4(0.f, 0.f, 0.f, 0.f);
          for (int q = lo; q < hi; ++q) {
            const float4 xv = *(const float4*)(p.PROJ1 + (size_t)q * 3072 + 2048 + c4);
            s.x += xv.x; s.y += xv.y; s.z += xv.z; s.w += xv.w;
          }
          const float inv = 1.f / (float)(hi - lo);
          const float4 x0 = *(const float4*)(p.PROJ1 + (size_t)t * 3072 + 2048 + c4);
          *(u32x2*)(p.PD + (size_t)t * 1024 + c4) = mk2(pack2(s.x * inv - x0.x, s.y * inv - x0.y), pack2(s.z * inv - x0.z, s.w * inv - x0.w));
        }
        }
        if constexpr (COOP) if (ph + 1 < ph_hi) xcd_barrier_impl(xb.bar, xb.x, xb.st, tid, (unsigned)nb);
      }
      if (PHON(11) && ph_lo <= 11 && 11 < ph_hi) { const int ph = 11; (void)ph;
        for (int rep_ = 0; rep_ < REP_L1S; ++rep_) {
        bf16_t* sA = (bf16_t*)smem;
        bf16_t* sB = sA + 128 * LDS_S;
        for (int id = bid; id < 2112 + 512; id += nb) {
          f32x4 acc[4][4];
          if (id < 2112) {
            const int mt = id % 66, g = id / 66, dir = g >> 4, hh = g & 15, h = hh >> 1, half = hh & 1;
            gemm_core(acc, p.XRB + (size_t)mt * 128 * 1024 + h * 128, 1024, p.WG + (size_t)(dir * 16 + hh) * 128 * 128, 128, 128, sA, sB);
#pragma unroll
            for (int gq = 0; gq < 2; ++gq) {
              const int c = h * 128 + half * 64 + (wc * 2 + gq) * 16 + (lane & 15);
              const float ba = p.lru_ba[dir * 1024 + c], bx = p.lru_bx[dir * 1024 + c];
              const float sp = log1pf(expf(-p.lru_lam[dir * 1024 + c]));
#pragma unroll
              for (int mi = 0; mi < 4; ++mi)
#pragma unroll
                for (int j = 0; j < 4; ++j) {
                  const int t = mt * 128 + wr * 64 + mi * 16 + (lane >> 4) * 4 + j;
                  const float r = sigmoid_f(acc[mi][2 * gq][j] + ba);
                  const float ii = sigmoid_f(acc[mi][2 * gq + 1][j] + bx);
                  const float la = -8.f * r * sp;
                  const float a = expf(la);
                  const float b = sqrtf(-expm1f(2.f * la)) * ii * p.XR[(size_t)t * 1024 + c];
                  p.ABA[((size_t)dir * TS + t) * 1024 + c] = a;
                  p.ABB[((size_t)dir * TS + t) * 1024 + c] = b;
                }
            }
          } else {
            const int id2 = id - 2112, mt = id2 & 63, rest = id2 >> 6, g = rest >> 1, nh = rest & 1;
            gemm_core(acc, p.PD + (size_t)mt * 128 * 1024 + g * 256, 1024, p.WTPOOL + (size_t)g * 256 * 256 + (size_t)nh * 128 * 256, 256, 256, sA, sB);
#pragma unroll
            for (int mi = 0; mi < 4; ++mi)
#pragma unroll
              for (int ni = 0; ni < 4; ++ni) {
                const int cc = g * 256 + nh * 128 + wc * 64 + ni * 16 + (lane & 15);
                const float pb = p.pool_b[cc], ps = p.pool_scale[cc];
#pragma unroll
                for (int j = 0; j < 4; ++j) {
                  const int t = mt * 128 + wr * 64 + mi * 16 + (lane >> 4) * 4 + j;
                  p.ABUF0[(size_t)t * DM + 1024 + cc] = f2bf((acc[mi][ni][j] + pb) * ps);
                }
              }
          }
        }
        }
        if constexpr (COOP) if (ph + 1 < ph_hi) xcd_barrier_impl(xb.bar, xb.x, xb.st, tid, (unsigned)nb);
      }
      if (PHON(12) && ph_lo <= 12 && 12 < ph_hi) { const int ph = 12; (void)ph;
        for (int rep_ = 0; rep_ < REP_L1S; ++rep_) {
        for (int item = bid; item < 2 * 132 * 4; item += nb) {
          const int dir = item / 528, rem = item % 528, k = rem >> 2, c = (rem & 3) * 256 + tid;
          const float* pa = p.ABA + (size_t)dir * TS * 1024 + c;
          const float* pb = p.ABB + (size_t)dir * TS * 1024 + c;
          float Pp = 1.f, H = 0.f;
#pragma unroll 8
          for (int s = 0; s < 64; ++s) {
            const int t = dir ? (k * 64 + 63 - s) : (k * 64 + s);
            const float a = pa[(size_t)t * 1024], b = pb[(size_t)t * 1024];
            H = a * H + b; Pp *= a;
          }
          p.AGG[(size_t)(dir * 132 + k) * 1024 + c] = make_float2(Pp, H);
        }
        }
        if constexpr (COOP) if (ph + 1 < ph_hi) xcd_barrier_impl(xb.bar, xb.x, xb.st, tid, (unsigned)nb);
      }
      if (PHON(13) && ph_lo <= 13 && 13 < ph_hi) { const int ph = 13; (void)ph;
        for (int rep_ = 0; rep_ < REP_L1S; ++rep_) {
        float* hf = (float*)smem;
        for (int item = bid; item < 1024; item += nb) {
          const int k = item >> 3, cb = item & 7, cl = tid & 127, c = cb * 128 + cl, dir = tid >> 7;
          const float2* ag = p.AGG + (size_t)dir * 132 * 1024 + c;
          const int npre = 4 + (dir ? (127 - k) : k);
          float h = 0.f;
#pragma unroll 8
          for (int v = 0; v < npre; ++v) {
            const int q = dir ? (v < 4 ? 131 - v : 131 - v) : (v < 4 ? 128 + v : v - 4);
            const float2 g = ag[(size_t)q * 1024];
            h = g.x * h + g.y;
          }
          const float* pa = p.ABA + (size_t)dir * TS * 1024 + c;
          const float* pb = p.ABB + (size_t)dir * TS * 1024 + c;
          if (dir == 0) {
#pragma unroll 8
            for (int s = 0; s < 64; ++s) {
              const int t = k * 64 + s;
              h = pa[(size_t)t * 1024] * h + pb[(size_t)t * 1024];
              hf[s * 128 + cl] = h;
            }
          }
          __syncthreads();
          if (dir == 1) {
#pragma unroll 8
            for (int s = 63; s >= 0; --s) {
              const int t = k * 64 + s;
              h = pa[(size_t)t * 1024] * h + pb[(size_t)t * 1024];
              const float y = p.PROJ1[(size_t)t * 3072 + c] * (hf[s * 128 + cl] + h);
              p.ABUF0[(size_t)t * DM + c] = f2bf(y);
            }
          }
          __syncthreads();
        }
        }
        if constexpr (COOP) if (ph + 1 < ph_hi) xcd_barrier_impl(xb.bar, xb.x, xb.st, tid, (unsigned)nb);
      }
      if (PHON(14) && ph_lo <= 14 && 14 < ph_hi) { const int ph = 14; (void)ph;
        gemm_phase(p.ABUF0, DM, p.WT_ODOUT, DM, TX, DM, DM, smem, bid, nb, [&](int row0, int col, f32x4 v) {
          const float g = p.MOD[(size_t)2 * 12288 + 2 * DM + col];
#pragma unroll
          for (int j = 0; j < 4; ++j) {
            float* d = p.XA + (size_t)(row0 + j) * DM + col;
            *d = *d + g * v[j];
          }
        });
        if constexpr (COOP) if (ph + 1 < ph_hi) xcd_barrier_impl(xb.bar, xb.x, xb.st, tid, (unsigned)nb);
      }
      if (PHON(15) && ph_lo <= 15 && 15 < ph_hi) { const int ph = 15; (void)ph;
        ph_norm(p.XA, p.XA + (size_t)TX * DM, TX, p.norm_ffn + DM, p.MOD + 2 * 12288, p.MOD + 3 * 12288, 3, 4, p.ABUF1, bid, nb);
        if constexpr (COOP) if (ph + 1 < ph_hi) xcd_barrier_impl(xb.bar, xb.x, xb.st, tid, (unsigned)nb);
      }
      if (PHON(16) && ph_lo <= 16 && 16 < ph_hi) { const int ph = 16; (void)ph;
        for (int rep_ = 0; rep_ < REP_GEMM; ++rep_) {
        gemm_phase(p.ABUF1, DM, p.WT_PQ + (size_t)DM * DM, DM, TX, DM, DM, smem, bid, nb, [&](int row0, int col, f32x4 v) {
#pragma unroll
          for (int j = 0; j < 4; ++j) p.QB[(size_t)(row0 + j) * DM + col] = f2bf(v[j]);
        });
        }
        if constexpr (COOP) if (ph + 1 < ph_hi) xcd_barrier_impl(xb.bar, xb.x, xb.st, tid, (unsigned)nb);
      }
      if (PHON(7) && ph_lo <= 17 && 17 < ph_hi) { const int ph = 17; ph_scores(p, 17, smem, bid, nb);
        if constexpr (COOP) if (ph + 1 < ph_hi) xcd_barrier_impl(xb.bar, xb.x, xb.st, tid, (unsigned)nb);
      }
      if (PHON(18) && ph_lo <= 18 && 18 < ph_hi) { const int ph = 18; (void)ph;
        for (int rep_ = 0; rep_ < REP_P18; ++rep_) {
        ph_peer<1>(p, 1, TX, smem, bid, nb);
        }
        if constexpr (COOP) if (ph + 1 < ph_hi) xcd_barrier_impl(xb.bar, xb.x, xb.st, tid, (unsigned)nb);
      }
    }
  }
}

extern "C" void kernel_launch(void* const* d_in, const int* in_sizes, int n_in, void* d_out, int out_size, void* d_ws,
                              size_t ws_size, hipStream_t stream) {
  P p{};
  const float** pin = (const float**)&p;
  for (int i = 0; i < 40; ++i) pin[i] = (const float*)d_in[i];
  p.out = (float*)d_out;
  char* ws = (char*)d_ws;
  size_t off = 0;
  auto alloc = [&](size_t bytes) { char* r = ws + off; off += (bytes + 255) & ~(size_t)255; return r; };
  p.MOD = (float*)alloc(4 * 12288 * 4);
  p.H2B = (bf16_t*)alloc((size_t)TS * 64 * 2);
  p.W3T = (bf16_t*)alloc((size_t)4096 * 64 * 2);
  p.WT_EVIN = (bf16_t*)alloc((size_t)5120 * 2048 * 2);
  p.WT_EVOUT = (bf16_t*)alloc((size_t)2048 * 2048 * 2);
  p.WT_ODIN = (bf16_t*)alloc((size_t)3072 * 2048 * 2);
  p.WT_ODOUT = (bf16_t*)alloc((size_t)2048 * 2048 * 2);
  p.WT_PQ = (bf16_t*)alloc((size_t)2 * 2048 * 2048 * 2);
  p.WG = (bf16_t*)alloc((size_t)2 * 16 * 128 * 128 * 2);
  p.KEYB = (bf16_t*)alloc((size_t)2 * 16 * 128 * 128 * 2);
  p.GMWS = (bf16_t*)alloc((size_t)8 * 128 * 128 * 2);
  p.WTPOOL = (bf16_t*)alloc((size_t)4 * 256 * 256 * 2);
  p.UB = (unsigned char*)alloc((size_t)2 * 16384 * 2048);
  p.VB = (unsigned char*)alloc((size_t)2 * 16384 * 2048);
  p.SU = (float*)alloc((size_t)2 * 16384 * 4);
  p.SV = (float*)alloc((size_t)2 * 16384 * 4);
  p.ABUF0 = (bf16_t*)alloc((size_t)TS * DM * 2);
  p.ABUF1 = (bf16_t*)alloc((size_t)TS * DM * 2);
  {
    char* r1 = alloc((size_t)5120 * TS * 4);
    p.PROJT = (float*)r1;
    p.PROJ1 = (float*)r1;
    p.XR = (float*)(r1 + (size_t)TS * 3072 * 4);
    p.XRB = (bf16_t*)(r1 + (size_t)TS * 3072 * 4 + (size_t)TS * 1024 * 4);
    p.PD = (bf16_t*)(r1 + (size_t)TS * 3072 * 4 + (size_t)TS * 1024 * 4 + (size_t)TS * 1024 * 2);
  }
  {
    char* r2 = alloc((size_t)2 * 2 * TS * 1024 * 4);
    p.FILT = (bf16_t*)r2;
    p.Z1 = (float*)(r2 + (size_t)4096 * TS * 2);
    p.ABA = (float*)r2;
    p.ABB = (float*)(r2 + (size_t)2 * TS * 1024 * 4);
  }
  p.XA = (float*)alloc((size_t)TS * DM * 4);
  p.QB = (bf16_t*)alloc((size_t)TS * DM * 2);
  p.SC = (float*)alloc((size_t)TS * DM * 4);
  p.AGG = (float2*)alloc((size_t)2 * 132 * 1024 * 8);
  p.BAR = (unsigned*)alloc(XCD_BAR_WORDS * 4);
  if (off > ws_size) { fprintf(stderr, "workspace too small: need %zu have %zu\n", off, ws_size); return; }

#if ONE_LAUNCH
  static int grid_blocks = 0;
  if (!grid_blocks) {
    int dev = 0, cus = 0, per_cu = 0;
    hipGetDevice(&dev);
    hipDeviceGetAttribute(&cus, hipDeviceAttributeMultiprocessorCount, dev);
    hipOccupancyMaxActiveBlocksPerMultiprocessor(&per_cu, mega<true>, 256, 0);
    if (per_cu > 2) per_cu = 2;
    grid_blocks = cus * per_cu;
  }
  int lo = 0, hi = NPH;
  void* args[] = {&p, &lo, &hi};
  hipMemsetAsync(p.BAR, 0, XCD_BAR_WORDS * 4, stream);
  hipError_t e = hipLaunchCooperativeKernel((void*)mega<true>, dim3(grid_blocks), dim3(256), args, 0, stream);
  if (e != hipSuccess) fprintf(stderr, "cooperative launch failed: %s (grid %d)\n", hipGetErrorString(e), grid_blocks);
#else
  for (int ph = 0; ph < NPH; ++ph) mega<false><<<512, 256, 0, stream>>>(p, ph, ph + 1);
#endif
}
```

```cpp
#include <hip/hip_runtime.h>
#include <hip/hip_cooperative_groups.h>
#include <stdint.h>
#include <cstdio>
namespace cg = cooperative_groups;

#ifndef ONE_LAUNCH
#define ONE_LAUNCH 1
#endif

typedef unsigned short bf16_t;
using bf16x8 = __attribute__((ext_vector_type(8))) short;
using f32x4 = __attribute__((ext_vector_type(4))) float;
using u32x4 = __attribute__((ext_vector_type(4))) unsigned int;
using u32x2 = __attribute__((ext_vector_type(2))) unsigned int;
__device__ __forceinline__ u32x4 mk4(unsigned a, unsigned b, unsigned c, unsigned d) { u32x4 r; r.x = a; r.y = b; r.z = c; r.w = d; return r; }
__device__ __forceinline__ u32x2 mk2(unsigned a, unsigned b) { u32x2 r; r.x = a; r.y = b; return r; }

#define TS 8448
#define TX 8192
#define DM 2048
#define NPH 19
#ifndef ONLY_PH
#define ONLY_PH -1
#endif
#define PHON(k) (ONLY_PH < 0 || ONLY_PH == (k))
#ifndef REP_P0
#define REP_P0 1
#endif
#ifndef REP_GEMM
#define REP_GEMM 1
#endif
#ifndef REP_P3
#define REP_P3 1
#endif
#ifndef REP_P18
#define REP_P18 1
#endif
#ifndef REP_TOPK
#define REP_TOPK 1
#endif
#ifndef REP_L1S
#define REP_L1S 1
#endif

struct P {
  const float *x, *c, *ctx, *cctx, *ada_w, *ada_b, *norm_mix, *norm_ffn, *norm_final;
  const float *ev_w_in, *ev_conv_w, *ev_conv_b, *hy_w1, *hy_b1, *hy_w2, *hy_b2, *hy_w3, *hy_freq, *hy_deltas, *hy_bias;
  const float *gm_norm, *gm_ws, *gm_bs, *ev_w_out;
  const float *od_w_in, *od_conv_w, *od_conv_b, *lru_wa, *lru_ba, *lru_wx, *lru_bx, *lru_lam, *pool_w, *pool_b, *pool_scale, *od_w_out;
  const float *peer_q, *peer_keys, *peer_u, *peer_v;
  float* out;
  float* MOD;
  bf16_t* H2B;
  bf16_t* W3T;
  bf16_t* WT_EVIN;
  bf16_t* WT_EVOUT;
  bf16_t* WT_ODIN;
  bf16_t* WT_ODOUT;
  bf16_t* WT_PQ;
  bf16_t* WG;
  bf16_t* KEYB;
  bf16_t* GMWS;
  bf16_t* WTPOOL;
  unsigned char* UB;
  unsigned char* VB;
  float* SU;
  float* SV;
  bf16_t* ABUF0;
  bf16_t* ABUF1;
  float* PROJT;
  float* PROJ1;
  float* XR;
  bf16_t* XRB;
  bf16_t* PD;
  bf16_t* FILT;
  float* Z1;
  float* ABA;
  float* ABB;
  float* XA;
  bf16_t* QB;
  float* SC;
  float2* AGG;
  unsigned* BAR;
};

__device__ __forceinline__ int tid_local() { int t_ = (int)threadIdx.x; asm volatile("" : "+v"(t_)); return t_; }
__device__ __forceinline__ bf16_t f2bf(float f) {
  uint32_t u = __float_as_uint(f);
  u += 0x7FFFu + ((u >> 16) & 1u);
  return (bf16_t)(u >> 16);
}
__device__ __forceinline__ float bf2f(bf16_t b) { return __uint_as_float(((uint32_t)b) << 16); }
__device__ __forceinline__ uint32_t pack2(float a, float b) { return (uint32_t)f2bf(a) | ((uint32_t)f2bf(b) << 16); }
__device__ __forceinline__ float bflo(uint32_t u) { return __uint_as_float(u << 16); }
__device__ __forceinline__ float bfhi(uint32_t u) { return __uint_as_float(u & 0xFFFF0000u); }
__device__ __forceinline__ float gelu_f(float x) {
  float u = 0.7978845608028654f * (x + 0.044715f * x * x * x);
  return x / (1.f + __expf(-2.f * u));
}
__device__ __forceinline__ float sigmoid_f(float x) { return 1.f / (1.f + __expf(-x)); }
__device__ __forceinline__ float wave_sum(float v) {
#pragma unroll
  for (int o = 32; o >= 1; o >>= 1) v += __shfl_xor(v, o);
  return v;
}
__device__ __forceinline__ uint32_t wave_max_u32(uint32_t v) {
#pragma unroll
  for (int o = 32; o >= 1; o >>= 1) { uint32_t t = (uint32_t)__shfl_xor((int)v, o); v = v > t ? v : t; }
  return v;
}
__device__ __forceinline__ uint32_t fkey(float f) { uint32_t u = __float_as_uint(f); return (u & 0x80000000u) ? ~u : (u | 0x80000000u); }
__device__ __forceinline__ float funkey(uint32_t k) { uint32_t u = (k & 0x80000000u) ? (k & 0x7FFFFFFFu) : ~k; return __uint_as_float(u); }

#define LDS_S 72
template <int NI>
__device__ __forceinline__ void gemm_core_t(f32x4 (&acc)[4][NI], const bf16_t* __restrict__ A, int lda,
                                            const bf16_t* __restrict__ Bt, int ldb, int K, bf16_t* sA, bf16_t* sB) {
  const int tid = tid_local(), lane = tid & 63, wid = tid >> 6, wr = wid >> 1, wc = wid & 1;
  const int lr = tid >> 3, lc = (tid & 7) * 8;
#pragma unroll
  for (int i = 0; i < 4; ++i)
#pragma unroll
    for (int j = 0; j < NI; ++j) acc[i][j] = (f32x4){0.f, 0.f, 0.f, 0.f};
  u32x4 ra[4], rb[NI];
#pragma unroll
  for (int i = 0; i < 4; ++i) ra[i] = *(const u32x4*)(A + (size_t)(lr + 32 * i) * lda + lc);
#pragma unroll
  for (int i = 0; i < NI; ++i) rb[i] = *(const u32x4*)(Bt + (size_t)(lr + 32 * i) * ldb + lc);
  const int nk = K >> 6;
  for (int kt = 0; kt < nk; ++kt) {
    __syncthreads();
#pragma unroll
    for (int i = 0; i < 4; ++i) *(u32x4*)(sA + (lr + 32 * i) * LDS_S + lc) = ra[i];
#pragma unroll
    for (int i = 0; i < NI; ++i) *(u32x4*)(sB + (lr + 32 * i) * LDS_S + lc) = rb[i];
    __syncthreads();
    if (kt + 1 < nk) {
      const int ko = (kt + 1) * 64;
#pragma unroll
      for (int i = 0; i < 4; ++i) ra[i] = *(const u32x4*)(A + (size_t)(lr + 32 * i) * lda + ko + lc);
#pragma unroll
      for (int i = 0; i < NI; ++i) rb[i] = *(const u32x4*)(Bt + (size_t)(lr + 32 * i) * ldb + ko + lc);
    }
    bf16x8 af[2][4], bfr[2][NI];
#pragma unroll
    for (int ks = 0; ks < 2; ++ks) {
#pragma unroll
      for (int mi = 0; mi < 4; ++mi)
        af[ks][mi] = *(const bf16x8*)(sA + (wr * 64 + mi * 16 + (lane & 15)) * LDS_S + ks * 32 + (lane >> 4) * 8);
#pragma unroll
      for (int ni = 0; ni < NI; ++ni)
        bfr[ks][ni] = *(const bf16x8*)(sB + (wc * 16 * NI + ni * 16 + (lane & 15)) * LDS_S + ks * 32 + (lane >> 4) * 8);
    }
#pragma unroll
    for (int ks = 0; ks < 2; ++ks)
#pragma unroll
      for (int mi = 0; mi < 4; ++mi)
#pragma unroll
        for (int ni = 0; ni < NI; ++ni)
          acc[mi][ni] = __builtin_amdgcn_mfma_f32_16x16x32_bf16(af[ks][mi], bfr[ks][ni], acc[mi][ni], 0, 0, 0);
  }
}
__device__ __forceinline__ void gemm_core(f32x4 (&acc)[4][4], const bf16_t* __restrict__ A, int lda,
                                          const bf16_t* __restrict__ Bt, int ldb, int K, bf16_t* sA, bf16_t* sB) {
  gemm_core_t<4>(acc, A, lda, Bt, ldb, K, sA, sB);
}

template <class Epi>
__device__ __forceinline__ void gemm_phase(const bf16_t* A, int lda, const bf16_t* Bt, int ldb, int M, int N, int K,
                                           char* smem, int bid, int nb, Epi epi) {
  const int numM = M >> 7, numN = N >> 7;
  bf16_t* sA = (bf16_t*)smem;
  bf16_t* sB = sA + 128 * LDS_S;
  const int lane = tid_local() & 63, wid = tid_local() >> 6, wr = wid >> 1, wc = wid & 1;
  const int total = numM * numN;
  const int full = (total / nb) * nb;
  const int vb = ((nb & 7) == 0) ? (bid & 7) * (nb >> 3) + (bid >> 3) : bid;
  auto tile_of = [&](int id, int& mt, int& nt) {
    const int gsz = 8 * numN, g = id / gsz, fm = g * 8;
    const int rows = (numM - fm) < 8 ? (numM - fm) : 8;
    const int r = id - g * gsz;
    mt = fm + r % rows; nt = r / rows;
  };
  for (int id = vb; id < full; id += nb) {
    int mt, nt;
    tile_of(id, mt, nt);
    f32x4 acc[4][4];
    gemm_core_t<4>(acc, A + (size_t)mt * 128 * lda, lda, Bt + (size_t)nt * 128 * ldb, ldb, K, sA, sB);
#pragma unroll
    for (int mi = 0; mi < 4; ++mi)
#pragma unroll
      for (int ni = 0; ni < 4; ++ni)
        epi(mt * 128 + wr * 64 + mi * 16 + (lane >> 4) * 4, nt * 128 + wc * 64 + ni * 16 + (lane & 15), acc[mi][ni]);
  }
  for (int u = vb; u < (total - full) * 4; u += nb) {
    const int id = full + (u >> 2), qd = u & 3;
    int mt, nt;
    tile_of(id, mt, nt);
    f32x4 acc[4][1];
    gemm_core_t<1>(acc, A + (size_t)mt * 128 * lda, lda, Bt + (size_t)(nt * 128 + qd * 32) * ldb, ldb, K, sA, sB);
#pragma unroll
    for (int mi = 0; mi < 4; ++mi)
      epi(mt * 128 + wr * 64 + mi * 16 + (lane >> 4) * 4, nt * 128 + qd * 32 + wc * 16 + (lane & 15), acc[mi][0]);
  }
}

__device__ __forceinline__ void ph_ada(const P& p, char* smem, int bid, int nb, int layer) {
  float* sc = (float*)smem;
  float* sx = sc + 2048;
  float* red = sx + 2048;
  const int tid = tid_local();
  bool loaded = false;
  for (int item0 = bid; item0 < 384; item0 += nb) {
    const int item = item0 + layer * 384;
    if (!loaded) {
      for (int i = tid; i < 2048; i += 256) {
        float v = p.c[i]; sc[i] = v * sigmoid_f(v);
        float w = p.cctx[i]; sx[i] = w * sigmoid_f(w);
      }
      __syncthreads();
      loaded = true;
    }
    const int l = item / 384, cgp = item % 384;
    const int col = cgp * 32 + (tid & 31), kg = tid >> 5;
    const float* w = p.ada_w + (size_t)l * 2048 * 12288 + col;
    float a0 = 0.f, a1 = 0.f;
#pragma unroll 16
    for (int k = kg; k < 2048; k += 8) {
      float wv = w[(size_t)k * 12288];
      a0 += sc[k] * wv; a1 += sx[k] * wv;
    }
    red[(kg * 32 + (tid & 31)) * 2 + 0] = a0;
    red[(kg * 32 + (tid & 31)) * 2 + 1] = a1;
    __syncthreads();
    if (tid < 64) {
      const int cc = tid & 31, which = tid >> 5;
      float s = 0.f;
#pragma unroll
      for (int g = 0; g < 8; ++g) s += red[(g * 32 + cc) * 2 + which];
      const int colo = cgp * 32 + cc;
      p.MOD[(size_t)(l * 2 + which) * 12288 + colo] = s + p.ada_b[l * 12288 + colo];
    }
    __syncthreads();
  }
  __syncthreads();
}

__device__ __forceinline__ void ph_h2(const P& p, char* smem, int bid, int nb) {
  float* feats = (float*)smem;
  float* h1 = feats + 160;
  float* w1s = feats + 512;
  float* w2s = w1s + 33 * 64;
  const int tid = tid_local(), r = tid >> 6, j = tid & 63;
  if (bid < 2112) {
    for (int i = tid; i < 33 * 64; i += 256) w1s[i] = p.hy_w1[i];
    for (int i = tid; i < 64 * 64; i += 256) w2s[i] = p.hy_w2[i];
  }
  const float b1 = p.hy_b1[j], b2 = p.hy_b2[j], fr = p.hy_freq[j];
  __syncthreads();
  for (int item = bid; item < 2112; item += nb) {
    const int row = item * 4 + r;
    const int L = row < TX ? TX : 256;
    const int t = row < TX ? row : row - TX;
    if (j < 33) {
      const float tn = (float)t / (float)(L - 1);
      float f;
      if (j == 0) f = tn;
      else {
        const int bi = (j - 1) & 15;
        const float band = 1e-4f + (float)bi * ((15.f - 1e-4f) / 15.f);
        const float ang = (6.283185307179586f / (float)L) * (float)t * band;
        f = (j <= 16) ? cosf(ang) : -sinf(ang);
      }
      feats[r * 36 + j] = f;
    }
    __syncthreads();
    float a = b1;
#pragma unroll
    for (int i = 0; i < 33; ++i) a += feats[r * 36 + i] * w1s[i * 64 + j];
    h1[r * 64 + j] = sinf(fr * a);
    __syncthreads();
    float a2 = b2;
#pragma unroll 16
    for (int i = 0; i < 64; ++i) a2 += h1[r * 64 + i] * w2s[i * 64 + j];
    p.H2B[(size_t)row * 64 + j] = f2bf(sinf(fr * a2));
  }
  __syncthreads();
}

using f32x2 = __attribute__((ext_vector_type(2))) float;
#ifndef FP6_ORDER
#define FP6_ORDER 1
#endif
using v16f = __attribute__((ext_vector_type(16))) float;
using v32f = __attribute__((ext_vector_type(32))) float;
using v6u = __attribute__((ext_vector_type(6))) unsigned int;
#define ROWB 1536
__device__ __forceinline__ void ph_tables(const P& p, int bid, int nb) {
  const int lane = tid_local() & 63, w = tid_local() >> 6;
  for (int r = bid * 4 + w; r < 65536; r += nb * 4) {
    const int tb = r >> 15, row = r & 32767;
    const float* src = (tb ? p.peer_v : p.peer_u) + (size_t)row * 2048 + lane * 32;
    unsigned char* dst = (tb ? p.VB : p.UB) + (size_t)row * ROWB;
    f32x4 v[8];
    float amax = 0.f;
#pragma unroll
    for (int q = 0; q < 8; ++q) {
      v[q] = *(const f32x4*)(src + q * 4);
      amax = fmaxf(amax, fmaxf(fmaxf(fabsf(v[q].x), fabsf(v[q].y)), fmaxf(fabsf(v[q].z), fabsf(v[q].w))));
    }
#pragma unroll
    for (int o = 32; o >= 1; o >>= 1) amax = fmaxf(amax, __shfl_xor(amax, o));
    const float sc = (amax > 0.f) ? exp2f(floorf(log2f(7.5f / amax))) : 1.f;
    v16f a, b;
#pragma unroll
    for (int k = 0; k < 16; ++k) {
#if FP6_ORDER == 0
      const int ia = k, ib = 16 + k;
#else
      const int ia = 2 * k, ib = 2 * k + 1;
#endif
      a[k] = v[ia >> 2][ia & 3] * sc;
      b[k] = v[ib >> 2][ib & 3] * sc;
    }
    const v6u pk = __builtin_amdgcn_cvt_scalef32_2xpk16_fp6_f32(a, b, 1.0f);
#pragma unroll
    for (int jc = 0; jc < 3; ++jc) *(u32x2*)(dst + jc * 512 + lane * 8) = mk2(pk[2 * jc], pk[2 * jc + 1]);
    if (lane == 0) (tb ? p.SV : p.SU)[row] = 1.f / sc;
  }
}

__device__ __forceinline__ void transpose_job(const float* src, bf16_t* dst, int K, int N, int batch, char* smem, int bid, int nb) {
  float* s = (float*)smem;
  const int tid = tid_local();
  const int tK = K >> 6, tN = N >> 6, per = tK * tN, total = batch * per;
  for (int item = bid; item < total; item += nb) {
    const int b = item / per, rem = item % per, tk = rem / tN, tn = rem % tN;
    const float* sp = src + (size_t)b * K * N + (size_t)(tk * 64) * N + tn * 64;
#pragma unroll
    for (int i = 0; i < 4; ++i) {
      const int row = (tid >> 4) + 16 * i, c4 = (tid & 15) * 4;
      float4 v = *(const float4*)(sp + (size_t)row * N + c4);
      s[row * 65 + c4 + 0] = v.x; s[row * 65 + c4 + 1] = v.y; s[row * 65 + c4 + 2] = v.z; s[row * 65 + c4 + 3] = v.w;
    }
    __syncthreads();
    const int n = tid >> 2, kq = tid & 3;
    uint32_t w[8];
#pragma unroll
    for (int e = 0; e < 8; ++e) w[e] = pack2(s[(kq * 16 + 2 * e) * 65 + n], s[(kq * 16 + 2 * e + 1) * 65 + n]);
    bf16_t* d = dst + (size_t)b * N * K + (size_t)(tn * 64 + n) * K + tk * 64 + kq * 16;
    *(u32x4*)d = mk4(w[0], w[1], w[2], w[3]);
    *(u32x4*)(d + 8) = mk4(w[4], w[5], w[6], w[7]);
    __syncthreads();
  }
}

__device__ __forceinline__ void ph_small_convert(const P& p, int bid, int nb) {
  const int gt = bid * 256 + tid_local(), gs = nb * 256;
  for (int i = gt; i < 2 * 16 * 128 * 128; i += gs) {
    const int k = i & 127, n = (i >> 7) & 127, hh = (i >> 14) & 15, dir = i >> 18;
    const int wc = n >> 6, ni = (n >> 4) & 3, l = n & 15;
    const int type = ni & 1, cl = (wc * 2 + (ni >> 1)) * 16 + l;
    const int h = hh >> 1, half = hh & 1, j = half * 64 + cl;
    const float* src = type ? p.lru_wx : p.lru_wa;
    p.WG[i] = f2bf(src[((size_t)(dir * 8 + h) * 128 + k) * 128 + j]);
  }
  for (int i = gt; i < 2 * 16 * 128 * 128; i += gs) p.KEYB[i] = f2bf(p.peer_keys[i]);
  for (int i = gt; i < 8 * 128 * 128; i += gs) p.GMWS[i] = f2bf(p.gm_ws[i]);
}

__device__ __forceinline__ void ph_norm(const float* srcx, const float* srcc, int nrows, const float* gnorm, const float* modx,
                        const float* modc, int shIdx, int scIdx, bf16_t* dst, int bid, int nb) {
  const int lane = tid_local() & 63, w = tid_local() >> 6;
  for (int row = bid * 4 + w; row < nrows; row += nb * 4) {
    const float* s = row < TX ? srcx + (size_t)row * DM : srcc + (size_t)(row - TX) * DM;
    const float* md = row < TX ? modx : modc;
    float4 v[8];
    float ss = 0.f;
#pragma unroll
    for (int i = 0; i < 8; ++i) {
      v[i] = ((const float4*)s)[i * 64 + lane];
      ss += v[i].x * v[i].x + v[i].y * v[i].y + v[i].z * v[i].z + v[i].w * v[i].w;
    }
    ss = wave_sum(ss);
    const float rstd = rsqrtf(ss * (1.f / DM) + 1e-6f);
#pragma unroll
    for (int i = 0; i < 8; ++i) {
      const int d = (i * 64 + lane) * 4;
      const float4 g = *(const float4*)(gnorm + d);
      const float4 sc = *(const float4*)(md + scIdx * DM + d);
      const float4 sh = *(const float4*)(md + shIdx * DM + d);
      const float y0 = v[i].x * rstd * g.x * (1.f + sc.x) + sh.x;
      const float y1 = v[i].y * rstd * g.y * (1.f + sc.y) + sh.y;
      const float y2 = v[i].z * rstd * g.z * (1.f + sc.z) + sh.z;
      const float y3 = v[i].w * rstd * g.w * (1.f + sc.w) + sh.w;
      *(u32x2*)(dst + (size_t)row * DM + d) = mk2(pack2(y0, y1), pack2(y2, y3));
    }
  }
}

__device__ __forceinline__ float conv3_at(const P& p, int part, int ch, int toff, int L, int s) {
  const int c = part * 1024 + ch;
  const float* row = p.PROJT + (size_t)c * TS + toff;
  float v = p.ev_conv_b[c] + p.ev_conv_w[3072 + c] * row[s];
  if (s > 0) v += p.ev_conv_w[c] * row[s - 1];
  if (s < L - 1) v += p.ev_conv_w[2 * 3072 + c] * row[s + 1];
  return v;
}

__device__ __forceinline__ float4 conv3_vec4(const P& p, int part, int ch, int toff, int L, int s0) {
  const int c = part * 1024 + ch;
  const float* row = p.PROJT + (size_t)c * TS + toff;
  const float4 m = *(const float4*)(row + s0);
  const float l = (s0 > 0) ? row[s0 - 1] : 0.f;
  const float r = (s0 + 4 < L) ? row[s0 + 4] : 0.f;
  const float b = p.ev_conv_b[c], w0 = p.ev_conv_w[c], w1 = p.ev_conv_w[3072 + c], w2 = p.ev_conv_w[2 * 3072 + c];
  float4 o;
  o.x = b + w0 * l + w1 * m.x + w2 * m.y;
  o.y = b + w0 * m.x + w1 * m.y + w2 * m.z;
  o.z = b + w0 * m.y + w1 * m.z + w2 * m.w;
  o.w = b + w0 * m.z + w1 * m.w + w2 * r;
  return o;
}

#define C3_LOAD(M, Lf, Rt, part, s0) { const float* row_ = p.PROJT + (size_t)((part) * 1024 + ch) * TS + toff; \
    M = *(const f32x4*)(row_ + (s0)); Lf = ((s0) > 0) ? row_[(s0) - 1] : 0.f; Rt = ((s0) + 4 < L) ? row_[(s0) + 4] : 0.f; }
__device__ __forceinline__ f32x4 c3_eval(f32x4 m, float l, float r, float b, float w0, float w1, float w2) {
  f32x4 o;
  o.x = b + w0 * l + w1 * m.x + w2 * m.y;
  o.y = b + w0 * m.x + w1 * m.y + w2 * m.z;
  o.z = b + w0 * m.y + w1 * m.z + w2 * m.w;
  o.w = b + w0 * m.z + w1 * m.w + w2 * r;
  return o;
}

template <int SEQ>
__device__ __forceinline__ void hyena_item(const P& p, char* smem, int ch) {
  constexpr int L = SEQ ? 256 : TX;
  constexpr int toff = SEQ ? TX : 0;
  constexpr int nB = L >> 7;
  constexpr int NT = SEQ ? 1 : 4;
  bf16_t* KK = (bf16_t*)smem;
  float* ybuf = (float*)smem;
  bf16_t* UP = (bf16_t*)(smem + 34816);
  bf16_t* CP = (bf16_t*)(smem + 51712);
  float* red = (float*)(smem + 59904);
  const int tid = tid_local(), lane = tid & 63, w = tid >> 6;
  for (int n = 0; n < 2; ++n) {
    const bf16_t* ff = p.FILT + (size_t)(n * 1024 + ch) * TS + toff;
    const bf16_t* fb = p.FILT + (size_t)(2048 + n * 1024 + ch) * TS + toff;
    float sabs = 0.f;
    {
      constexpr int NKK = ((2 * L) / 8 + 255) / 256;
      u32x4 kv[NKK];
#pragma unroll
      for (int k = 0; k < NKK; ++k) {
        const int idx = (tid + 256 * k) * 8;
        kv[k] = mk4(0u, 0u, 0u, 0u);
        if (idx < 2 * L) kv[k] = (idx >= L) ? *(const u32x4*)(ff + (idx - L)) : *(const u32x4*)(fb + (L - 8 - idx));
      }
#pragma unroll
      for (int k = 0; k < NKK; ++k) {
        const int idx = (tid + 256 * k) * 8;
        if (idx < 2 * L) {
          u32x4 v = kv[k];
          if (idx < L) {
            const u32x4 r = v;
            v.x = (r.w >> 16) | (r.w << 16); v.y = (r.z >> 16) | (r.z << 16); v.z = (r.y >> 16) | (r.y << 16); v.w = (r.x >> 16) | (r.x << 16);
          }
          sabs += fabsf(bflo(v.x)) + fabsf(bfhi(v.x)) + fabsf(bflo(v.y)) + fabsf(bfhi(v.y)) + fabsf(bflo(v.z)) + fabsf(bfhi(v.z)) + fabsf(bflo(v.w)) + fabsf(bfhi(v.w));
          *(u32x4*)(KK + (idx >> 7) * 136 + (idx & 127)) = v;
        }
      }
    }
    sabs = wave_sum(sabs);
    if (lane == 0) red[w] = sabs;
    const float cb0 = p.ev_conv_b[ch], cw00 = p.ev_conv_w[ch], cw01 = p.ev_conv_w[3072 + ch], cw02 = p.ev_conv_w[2 * 3072 + ch];
    {
      constexpr int NUP = ((L + 256) / 4 + 255) / 256;
      if (n == 0) {
        constexpr int CH = SEQ ? 1 : 3;
#pragma unroll 1
        for (int k0 = 0; k0 < NUP; k0 += CH) {
          f32x4 cm[CH]; float cl[CH], cr[CH];
#pragma unroll
          for (int k = 0; k < CH; ++k) {
            const int s0 = (tid + 256 * (k0 + k)) * 4 - 128;
            cm[k] = (f32x4){0.f, 0.f, 0.f, 0.f}; cl[k] = 0.f; cr[k] = 0.f;
            if (s0 >= 0 && s0 < L) C3_LOAD(cm[k], cl[k], cr[k], 0, s0)
          }
#pragma unroll
          for (int k = 0; k < CH; ++k) {
            const int iv = tid + 256 * (k0 + k), s0 = iv * 4 - 128;
            if (iv < (L + 256) / 4) {
              f32x4 u = (f32x4){0.f, 0.f, 0.f, 0.f};
              if (s0 >= 0 && s0 < L) u = c3_eval(cm[k], cl[k], cr[k], cb0, cw00, cw01, cw02);
              *(u32x2*)(UP + iv * 4) = mk2(pack2(u.x, u.y), pack2(u.z, u.w));
            }
          }
        }
      } else {
        f32x4 zv[NUP];
#pragma unroll
        for (int k = 0; k < NUP; ++k) {
          const int s0 = (tid + 256 * k) * 4 - 128;
          zv[k] = (f32x4){0.f, 0.f, 0.f, 0.f};
          if (s0 >= 0 && s0 < L) zv[k] = *(const f32x4*)(p.Z1 + (size_t)ch * TS + toff + s0);
        }
#pragma unroll
        for (int k = 0; k < NUP; ++k) {
          const int iv = tid + 256 * k;
          if (iv < (L + 256) / 4) *(u32x2*)(UP + iv * 4) = mk2(pack2(zv[k].x, zv[k].y), pack2(zv[k].z, zv[k].w));
        }
      }
    }
    __syncthreads();
    const float invS = 1.f / (red[0] + red[1] + red[2] + red[3]);

    f32x4 acc[2][NT];
#pragma unroll
    for (int a = 0; a < 2; ++a)
#pragma unroll
      for (int b = 0; b < NT; ++b) acc[a][b] = (f32x4){0.f, 0.f, 0.f, 0.f};

    auto build_window = [&](int c, int buf) {
      const int sg = tid >> 5, y0 = (tid & 31) * 8;
      uint32_t wv[4] = {0u, 0u, 0u, 0u};
      if (y0 < 248) {
        const int base = (c + 1) * 128 - 1 - y0 - sg + 128;
#pragma unroll
        for (int e = 0; e < 4; ++e) wv[e] = (uint32_t)UP[base - 2 * e] | ((uint32_t)UP[base - 2 * e - 1] << 16);
      }
      *(u32x4*)(CP + buf * 2048 + sg * 256 + y0) = mk4(wv[0], wv[1], wv[2], wv[3]);
    };
    build_window(0, 0);
    __syncthreads();
    for (int c = 0; c <= nB; ++c) {
      const int buf = c & 1;
      if (c < nB) build_window(c + 1, buf ^ 1);
      const bf16_t* cp = CP + buf * 2048;
      bf16x8 aF[2][2], bF[2][NT];
      const bf16_t* kbase[NT];
#pragma unroll
      for (int nt = 0; nt < NT; ++nt) {
        int e = nt * 16 + (lane & 15);
        if (e > nB - 1) e = nB - 1;
        kbase[nt] = KK + (e - c + nB) * 136 + 8 * (lane >> 4);
      }
      const bf16_t* abase = cp + 120 + 8 * (lane >> 4) - 8 * (lane & 15);
#pragma unroll
      for (int mi = 0; mi < 2; ++mi) aF[0][mi] = *(const bf16x8*)(abase + (7 - (2 * w + mi)) * 256);
#pragma unroll
      for (int nt = 0; nt < NT; ++nt) bF[0][nt] = *(const bf16x8*)(kbase[nt]);
#pragma unroll
      for (int js = 0; js < 4; ++js) {
        if (js < 3) {
#pragma unroll
          for (int mi = 0; mi < 2; ++mi) aF[(js + 1) & 1][mi] = *(const bf16x8*)(abase + (7 - (2 * w + mi)) * 256 + 32 * (js + 1));
#pragma unroll
          for (int nt = 0; nt < NT; ++nt) bF[(js + 1) & 1][nt] = *(const bf16x8*)(kbase[nt] + 32 * (js + 1));
        }
#pragma unroll
        for (int nt = 0; nt < NT; ++nt)
#pragma unroll
          for (int mi = 0; mi < 2; ++mi)
            acc[mi][nt] = __builtin_amdgcn_mfma_f32_16x16x32_bf16(aF[js & 1][mi], bF[js & 1][nt], acc[mi][nt], 0, 0, 0);
      }
      __syncthreads();
    }
#pragma unroll
    for (int mi = 0; mi < 2; ++mi)
#pragma unroll
      for (int nt = 0; nt < NT; ++nt) {
        const int e = nt * 16 + (lane & 15);
        if (e < nB) {
#pragma unroll
          for (int j = 0; j < 4; ++j) {
            const int rho = (lane >> 4) * 4 + j;
            const int tau = (2 * w + mi) + 8 * rho;
            ybuf[e * 128 + tau] = acc[mi][nt][j] * invS;
          }
        }
      }
    __syncthreads();
    const float bias = p.hy_bias[n * 1024 + ch];
    {
      constexpr int NE = (L / 4 + 255) / 256;
      const int pa = (n == 0) ? 1 : 2;
      const float pb = p.ev_conv_b[pa * 1024 + ch], pw0 = p.ev_conv_w[pa * 1024 + ch], pw1 = p.ev_conv_w[3072 + pa * 1024 + ch], pw2 = p.ev_conv_w[2 * 3072 + pa * 1024 + ch];
      constexpr int CE = SEQ ? 1 : 4;
#pragma unroll 1
      for (int k0 = 0; k0 < NE; k0 += CE) {
        f32x4 am[CE], bm[CE];
        float al[CE], ar[CE], bl[CE], br[CE];
#pragma unroll
        for (int k = 0; k < CE; ++k) {
          const int t0 = (tid + 256 * (k0 + k)) * 4;
          am[k] = (f32x4){0.f, 0.f, 0.f, 0.f}; bm[k] = am[k]; al[k] = 0.f; ar[k] = 0.f; bl[k] = 0.f; br[k] = 0.f;
          if (t0 < L) {
            C3_LOAD(am[k], al[k], ar[k], pa, t0)
            if (n == 0) C3_LOAD(bm[k], bl[k], br[k], 0, t0)
            else bm[k] = *(const f32x4*)(p.Z1 + (size_t)ch * TS + toff + t0);
          }
        }
#pragma unroll
        for (int k = 0; k < CE; ++k) {
          const int t0 = (tid + 256 * (k0 + k)) * 4;
          if (t0 < L) {
            const f32x4 y = *(const f32x4*)(ybuf + t0);
            const f32x4 xm = c3_eval(am[k], al[k], ar[k], pb, pw0, pw1, pw2);
            if (n == 0) {
              const f32x4 v = c3_eval(bm[k], bl[k], br[k], cb0, cw00, cw01, cw02);
              f32x4 z;
              z.x = xm.x * (y.x + bias * v.x); z.y = xm.y * (y.y + bias * v.y); z.z = xm.z * (y.z + bias * v.z); z.w = xm.w * (y.w + bias * v.w);
              *(f32x4*)(p.Z1 + (size_t)ch * TS + toff + t0) = z;
            } else {
              const f32x4 z1 = bm[k];
              bf16_t* o = p.ABUF1 + (size_t)(toff + t0) * DM + ch;
              o[0] = f2bf(xm.x * (y.x + bias * z1.x));
              o[DM] = f2bf(xm.y * (y.y + bias * z1.y));
              o[2 * DM] = f2bf(xm.z * (y.z + bias * z1.z));
              o[3 * DM] = f2bf(xm.w * (y.w + bias * z1.w));
            }
          }
        }
      }
    }
    __threadfence_block();
    __syncthreads();
  }
}

__device__ __forceinline__ void gmlp_item(const P& p, char* smem, int n, int h) {
  bf16_t* Bt = (bf16_t*)smem;
  float* rs = (float*)(smem + 34816);
  const int tid = tid_local(), lane = tid & 63, w = tid >> 6;
  const float* VG = p.PROJT + (size_t)4096 * TS + n * 128;
  {
    const int c8 = tid >> 5, q4 = (tid & 31) * 4;
    float4 s4 = make_float4(0.f, 0.f, 0.f, 0.f);
#pragma unroll 16
    for (int c = c8; c < 1024; c += 8) {
      const float4 v = *(const float4*)(VG + (size_t)c * TS + q4);
      s4.x += v.x * v.x; s4.y += v.y * v.y; s4.z += v.z * v.z; s4.w += v.w * v.w;
    }
    float* rs8 = rs + 128;
    *(float4*)(rs8 + c8 * 128 + q4) = s4;
  }
  __syncthreads();
  if (tid < 128) {
    float a = 0.f;
#pragma unroll
    for (int g = 0; g < 8; ++g) a += rs[128 + g * 128 + tid];
    rs[tid] = rsqrtf(a * (1.f / 1024.f) + 1e-6f);
  }
  __syncthreads();
  {
    const int c = tid >> 1, q0 = (tid & 1) * 64;
    const float g = p.gm_norm[h * 128 + c];
    const float* src = VG + (size_t)(h * 128 + c) * TS + q0;
#pragma unroll 4
    for (int i = 0; i < 16; ++i) {
      const float4 v = *(const float4*)(src + 4 * i);
      const int q = q0 + 4 * i;
      *(u32x2*)(Bt + c * 136 + q) = mk2(pack2(v.x * rs[q] * g, v.y * rs[q + 1] * g), pack2(v.z * rs[q + 2] * g, v.w * rs[q + 3] * g));
    }
  }
  __syncthreads();
  f32x4 acc[2][8];
#pragma unroll
  for (int a = 0; a < 2; ++a)
#pragma unroll
    for (int b = 0; b < 8; ++b) acc[a][b] = (f32x4){0.f, 0.f, 0.f, 0.f};
  const bf16_t* Aw = p.GMWS + (size_t)h * 128 * 128;
  bf16x8 afA[4][2];
#pragma unroll
  for (int ks = 0; ks < 4; ++ks)
#pragma unroll
    for (int mi = 0; mi < 2; ++mi)
      afA[ks][mi] = *(const bf16x8*)(Aw + (32 * w + 16 * mi + (lane & 15)) * 128 + ks * 32 + (lane >> 4) * 8);
#pragma unroll
  for (int ks = 0; ks < 4; ++ks) {
    bf16x8 bB[8];
#pragma unroll
    for (int ni = 0; ni < 8; ++ni) bB[ni] = *(const bf16x8*)(Bt + (ni * 16 + (lane & 15)) * 136 + ks * 32 + (lane >> 4) * 8);
#pragma unroll
    for (int ni = 0; ni < 8; ++ni)
#pragma unroll
      for (int mi = 0; mi < 2; ++mi)
        acc[mi][ni] = __builtin_amdgcn_mfma_f32_16x16x32_bf16(afA[ks][mi], bB[ni], acc[mi][ni], 0, 0, 0);
  }
#pragma unroll
  for (int mi = 0; mi < 2; ++mi)
#pragma unroll
    for (int ni = 0; ni < 8; ++ni) {
      const int c = ni * 16 + (lane & 15);
      const int p0 = 32 * w + 16 * mi + (lane >> 4) * 4;
      const float4 u = *(const float4*)(p.PROJT + (size_t)(3072 + h * 128 + c) * TS + n * 128 + p0);
      const float uu[4] = {u.x, u.y, u.z, u.w};
#pragma unroll
      for (int j = 0; j < 4; ++j) {
        const int pp = p0 + j;
        const float s = acc[mi][ni][j] + p.gm_bs[h * 128 + pp];
        p.ABUF1[(size_t)(n * 128 + pp) * DM + 1024 + h * 128 + c] = f2bf(uu[j] * s);
      }
    }
  __syncthreads();
}

#define BF8(dst, o, q) dst[o + 0] = bflo(q.x); dst[o + 1] = bfhi(q.x); dst[o + 2] = bflo(q.y); dst[o + 3] = bfhi(q.y); \
                       dst[o + 4] = bflo(q.z); dst[o + 5] = bfhi(q.z); dst[o + 6] = bflo(q.w); dst[o + 7] = bfhi(q.w);
template <int LAST>
__device__ __forceinline__ void ph_peer(const P& p, int layer, int ntok, char* smem, int bid, int nb) {
  const int tid = tid_local();
  const int lane = tid & 63, w = tid >> 6;
  int* sExp = (int*)smem + w * 32;
  float* sGate = (float*)(smem + 512) + w * 32;
  uint32_t* LL = (uint32_t*)(smem + 1024) + w * 128;
  float* sPart = (float*)(smem + 4096);
  float* sRed = (float*)(smem + 4096 + 32768);
  const unsigned char* UBl = p.UB + (size_t)layer * 16384 * ROWB;
  const unsigned char* VBl = p.VB + (size_t)layer * 16384 * ROWB;
  const float* SUl = p.SU + layer * 16384;
  const float* SVl = p.SV + layer * 16384;
  const bf16_t* HP = LAST ? p.ABUF1 : p.ABUF0;
  int pi_ = 0, pj_ = 0;
  {
    int rem = lane;
    bool found = false;
#pragma unroll
    for (int ii = 0; ii < 16; ++ii) {
      const int nn = 16 / (ii + 1);
      if (!found && rem < nn) { pi_ = ii; pj_ = rem; found = true; }
      if (!found) rem -= nn;
    }
  }
  const bool pvalid_ = lane < 50;
  float scv[8];
  if (bid < ntok) {
    const float* sp = p.SC + (size_t)bid * DM + w * 512 + lane;
#pragma unroll
    for (int k = 0; k < 8; ++k) scv[k] = sp[k * 64];
  }
  for (int t = bid; t < ntok; t += nb) {
    for (int rep_ = 0; rep_ < REP_TOPK; ++rep_) {
      uint32_t key[4][2], prefix[4];
      int need[4];
#pragma unroll
      for (int g = 0; g < 4; ++g) {
        key[g][0] = (((fkey(scv[g * 2 + 0]) + 0x2000u) >> 14) << 7) | (uint32_t)lane;
        key[g][1] = (((fkey(scv[g * 2 + 1]) + 0x2000u) >> 14) << 7) | (uint32_t)(lane + 64);
        prefix[g] = 0u; need[g] = 16;
      }
#pragma unroll 4
      for (int bit = 24; bit >= 0; --bit) {
        const uint32_t mh = ~((1u << bit) - 1u);
#pragma unroll
        for (int g = 0; g < 4; ++g) {
          const uint32_t cand = prefix[g] | (1u << bit);
          const int c = __popcll(__ballot((key[g][0] & mh) == cand)) + __popcll(__ballot((key[g][1] & mh) == cand));
          const bool ge_ = c >= need[g];
          prefix[g] = ge_ ? cand : prefix[g];
          need[g] = ge_ ? need[g] : need[g] - c;
        }
      }
#pragma unroll
      for (int g = 0; g < 4; ++g) {
        const bool q0 = key[g][0] >= prefix[g], q1 = key[g][1] >= prefix[g];
        const unsigned long long b0 = __ballot(q0), b1 = __ballot(q1);
        const int r0 = __builtin_amdgcn_mbcnt_hi((unsigned)(b0 >> 32), __builtin_amdgcn_mbcnt_lo((unsigned)b0, 0u));
        const int r1 = __popcll(b0) + __builtin_amdgcn_mbcnt_hi((unsigned)(b1 >> 32), __builtin_amdgcn_mbcnt_lo((unsigned)b1, 0u));
        uint32_t* Ls = LL + (g >> 1) * 48 + (g & 1) * 16;
        if (q0) Ls[r0 & 15] = key[g][0];
        if (q1) Ls[r1 & 15] = key[g][1];
      }
      {
        uint32_t* Lg = LL + (lane >> 5) * 48 + ((lane >> 4) & 1) * 16;
        const uint32_t my = Lg[lane & 15];
        int rk = 0;
#pragma unroll
        for (int k = 0; k < 16; ++k) rk += (Lg[k] > my) ? 1 : 0;
        Lg[rk] = my;
      }
      uint32_t pk[2], cpre[2];
      int cneed[2];
#pragma unroll
      for (int hh = 0; hh < 2; ++hh) {
        const float s0 = funkey((LL[hh * 48 + pi_] >> 7) << 14);
        const float s1 = funkey((LL[hh * 48 + 16 + pj_] >> 7) << 14);
        pk[hh] = pvalid_ ? ((((fkey(s0 + s1) + 0x2000u) >> 14) << 8) | (uint32_t)(pi_ * 16 + pj_)) : 0u;
        cpre[hh] = 0u; cneed[hh] = 16;
      }
#pragma unroll 4
      for (int bit = 25; bit >= 0; --bit) {
        const uint32_t mh = ~((1u << bit) - 1u);
#pragma unroll
        for (int hh = 0; hh < 2; ++hh) {
          const uint32_t cand = cpre[hh] | (1u << bit);
          const int c = __popcll(__ballot((pk[hh] & mh) == cand));
          const bool ge_ = c >= cneed[hh];
          cpre[hh] = ge_ ? cand : cpre[hh];
          cneed[hh] = ge_ ? cneed[hh] : cneed[hh] - c;
        }
      }
#pragma unroll
      for (int hh = 0; hh < 2; ++hh) {
        uint32_t* L0 = LL + hh * 48;
        uint32_t* L1 = L0 + 16;
        uint32_t* L2 = L0 + 32;
        {
          const bool q = pk[hh] >= cpre[hh] && pk[hh] != 0u;
          const unsigned long long bq = __ballot(q);
          const int r = __builtin_amdgcn_mbcnt_hi((unsigned)(bq >> 32), __builtin_amdgcn_mbcnt_lo((unsigned)bq, 0u));
          if (q) L2[r & 15] = pk[hh];
        }
        const uint32_t mine = L2[lane & 15];
        const int cidx = (int)(mine & 255u);
        const float cv = funkey((mine >> 8) << 14);
        const int ia = (int)(L0[(cidx >> 4) & 15] & 127u);
        const int ib = (int)(L1[cidx & 15] & 127u);
        float mx = cv;
#pragma unroll
        for (int o = 8; o >= 1; o >>= 1) mx = fmaxf(mx, __shfl_xor(mx, o));
        const float ev = __expf(cv - mx);
        float sum = ev;
#pragma unroll
        for (int o = 8; o >= 1; o >>= 1) sum += __shfl_xor(sum, o);
        if (lane < 16) {
          sExp[hh * 16 + lane] = ia * 128 + ib;
          sGate[hh * 16 + lane] = ev / sum;
        }
      }
    }
    if (t + nb < ntok) {
      const float* sp = p.SC + (size_t)(t + nb) * DM + w * 512 + lane;
#pragma unroll
      for (int k = 0; k < 8; ++k) scv[k] = sp[k * 64];
    }
    u32x4 xq[4];
    {
      const u32x4* xr = (const u32x4*)(HP + (size_t)t * DM) + lane * 4;
#pragma unroll
      for (int q = 0; q < 4; ++q) xq[q] = xr[q];
    }
    float acc[32];
#pragma unroll
    for (int i = 0; i < 32; ++i) acc[i] = 0.f;
    u32x2 ub[2][3], vb[2][3];
    int ex[2], exn[2];
#pragma unroll
    for (int e = 0; e < 2; ++e) {
      exn[e] = __builtin_amdgcn_readfirstlane(sExp[e]);
      const u32x2* ur = (const u32x2*)(UBl + (size_t)exn[e] * ROWB) + lane;
#pragma unroll
      for (int jc = 0; jc < 3; ++jc) ub[e][jc] = ur[jc * 64];
    }
#pragma unroll 1
    for (int eb = 0; eb < 32; eb += 2) {
      float d[2];
#pragma unroll
      for (int e = 0; e < 2; ++e) {
        ex[e] = exn[e];
        v6u pk;
        pk[0] = ub[e][0].x; pk[1] = ub[e][0].y; pk[2] = ub[e][1].x; pk[3] = ub[e][1].y; pk[4] = ub[e][2].x; pk[5] = ub[e][2].y;
        const v32f uu = __builtin_amdgcn_cvt_scalef32_pk32_f32_fp6(pk, 1.0f);
        float sdot = 0.f;
#pragma unroll
        for (int q = 0; q < 4; ++q) {
          sdot += bflo(xq[q].x) * uu[q * 8 + 0] + bfhi(xq[q].x) * uu[q * 8 + 1] + bflo(xq[q].y) * uu[q * 8 + 2] + bfhi(xq[q].y) * uu[q * 8 + 3] +
                  bflo(xq[q].z) * uu[q * 8 + 4] + bfhi(xq[q].z) * uu[q * 8 + 5] + bflo(xq[q].w) * uu[q * 8 + 6] + bfhi(xq[q].w) * uu[q * 8 + 7];
        }
        d[e] = sdot;
        __builtin_amdgcn_sched_barrier(0);
      }
#pragma unroll
      for (int e = 0; e < 2; ++e) {
        const u32x2* vr = (const u32x2*)(VBl + (size_t)ex[e] * ROWB) + lane;
#pragma unroll
        for (int jc = 0; jc < 3; ++jc) vb[e][jc] = vr[jc * 64];
      }
      if (eb + 2 < 32) {
#pragma unroll
        for (int e = 0; e < 2; ++e) {
          exn[e] = __builtin_amdgcn_readfirstlane(sExp[eb + 2 + e]);
          const u32x2* ur = (const u32x2*)(UBl + (size_t)exn[e] * ROWB) + lane;
#pragma unroll
          for (int jc = 0; jc < 3; ++jc) ub[e][jc] = ur[jc * 64];
        }
      }
#pragma unroll
      for (int o = 32; o >= 1; o >>= 1) {
#pragma unroll
        for (int e = 0; e < 2; ++e) d[e] += __shfl_xor(d[e], o);
      }
#pragma unroll
      for (int e = 0; e < 2; ++e) {
        const float wg = sGate[eb + e] * gelu_f(d[e] * SUl[ex[e]]) * SVl[ex[e]];
        v6u pk;
        pk[0] = vb[e][0].x; pk[1] = vb[e][0].y; pk[2] = vb[e][1].x; pk[3] = vb[e][1].y; pk[4] = vb[e][2].x; pk[5] = vb[e][2].y;
        const v32f vv = __builtin_amdgcn_cvt_scalef32_pk32_f32_fp6(pk, 1.0f);
#pragma unroll
        for (int k = 0; k < 32; ++k) acc[k] += wg * vv[k];
        __builtin_amdgcn_sched_barrier(0);
      }
    }
    {
      float* dst = sPart + w * 2048 + lane * 32;
#pragma unroll
      for (int q = 0; q < 8; ++q) *(float4*)(dst + q * 4) = make_float4(acc[q * 4 + 0], acc[q * 4 + 1], acc[q * 4 + 2], acc[q * 4 + 3]);
    }
    __syncthreads();
    const int d0 = tid * 8;
    float r[8];
    {
      float4 a = *(const float4*)(sPart + d0), b = *(const float4*)(sPart + d0 + 4);
#pragma unroll
      for (int ww = 1; ww < 4; ++ww) {
        const float4 a2 = *(const float4*)(sPart + ww * 2048 + d0), b2 = *(const float4*)(sPart + ww * 2048 + d0 + 4);
        a.x += a2.x; a.y += a2.y; a.z += a2.z; a.w += a2.w; b.x += b2.x; b.y += b2.y; b.z += b2.z; b.w += b2.w;
      }
      r[0] = a.x; r[1] = a.y; r[2] = a.z; r[3] = a.w; r[4] = b.x; r[5] = b.y; r[6] = b.z; r[7] = b.w;
    }
    const int which = (t < TX) ? 0 : 1;
    const float* md = p.MOD + (size_t)(layer * 2 + which) * 12288;
    float* xrow = p.XA + (size_t)t * DM;
    float ss = 0.f;
#pragma unroll
    for (int hq = 0; hq < 2; ++hq) {
      const float4 xv = *(const float4*)(xrow + d0 + hq * 4);
      const float4 g2 = *(const float4*)(md + 5 * DM + d0 + hq * 4);
      float4 o;
      o.x = xv.x + g2.x * r[hq * 4 + 0]; o.y = xv.y + g2.y * r[hq * 4 + 1];
      o.z = xv.z + g2.z * r[hq * 4 + 2]; o.w = xv.w + g2.w * r[hq * 4 + 3];
      r[hq * 4 + 0] = o.x; r[hq * 4 + 1] = o.y; r[hq * 4 + 2] = o.z; r[hq * 4 + 3] = o.w;
      ss += o.x * o.x + o.y * o.y + o.z * o.z + o.w * o.w;
      if (!LAST) *(float4*)(xrow + d0 + hq * 4) = o;
    }
    ss = wave_sum(ss);
    if (lane == 0) sRed[w] = ss;
    __syncthreads();
    const float rstd = rsqrtf((sRed[0] + sRed[1] + sRed[2] + sRed[3]) * (1.f / DM) + 1e-6f);
    if (LAST) {
      float* orow = p.out + (size_t)t * DM;
#pragma unroll
      for (int hq = 0; hq < 2; ++hq) {
        const float4 g = *(const float4*)(p.norm_final + d0 + hq * 4);
        float4 o;
        o.x = r[hq * 4 + 0] * rstd * g.x; o.y = r[hq * 4 + 1] * rstd * g.y; o.z = r[hq * 4 + 2] * rstd * g.z; o.w = r[hq * 4 + 3] * rstd * g.w;
        *(float4*)(orow + d0 + hq * 4) = o;
      }
    } else {
      const float* md1 = p.MOD + (size_t)(2 + which) * 12288;
      const float* gn = p.norm_mix + DM;
      uint32_t o[4];
#pragma unroll
      for (int hq = 0; hq < 2; ++hq) {
        const float4 g = *(const float4*)(gn + d0 + hq * 4);
        const float4 sh = *(const float4*)(md1 + 0 * DM + d0 + hq * 4);
        const float4 sc = *(const float4*)(md1 + 1 * DM + d0 + hq * 4);
        const float y0 = r[hq * 4 + 0] * rstd * g.x * (1.f + sc.x) + sh.x;
        const float y1 = r[hq * 4 + 1] * rstd * g.y * (1.f + sc.y) + sh.y;
        const float y2 = r[hq * 4 + 2] * rstd * g.z * (1.f + sc.z) + sh.z;
        const float y3 = r[hq * 4 + 3] * rstd * g.w * (1.f + sc.w) + sh.w;
        o[hq * 2 + 0] = pack2(y0, y1); o[hq * 2 + 1] = pack2(y2, y3);
      }
      *(u32x4*)(p.ABUF1 + (size_t)t * DM + d0) = mk4(o[0], o[1], o[2], o[3]);
    }
    __syncthreads();
  }
}

__device__ __forceinline__ void ph_scores(const P& p, int ph, char* smem, int bid, int nb) {
  const int tid = tid_local(), lane = tid & 63, wid = tid >> 6, wr = wid >> 1, wc = wid & 1;
        const int layer = (ph == 7) ? 0 : 1;
        const int numM = (ph == 7) ? 66 : 64;
        bf16_t* sA = (bf16_t*)smem;
        bf16_t* sB = sA + 128 * LDS_S;
        for (int id = bid; id < numM * 16; id += nb) {
          const int mt = id % numM, hs = id / numM;
          f32x4 acc[4][4];
          gemm_core(acc, p.QB + (size_t)mt * 128 * DM + hs * 128, DM, p.KEYB + (size_t)(layer * 16 + hs) * 128 * 128, 128, 128, sA, sB);
#pragma unroll
          for (int mi = 0; mi < 4; ++mi)
#pragma unroll
            for (int ni = 0; ni < 4; ++ni)
#pragma unroll
              for (int j = 0; j < 4; ++j) {
                const int row = mt * 128 + wr * 64 + mi * 16 + (lane >> 4) * 4 + j;
                const int col = wc * 64 + ni * 16 + (lane & 15);
                p.SC[(size_t)row * DM + hs * 128 + col] = acc[mi][ni][j];
              }
        }
}

#define XB_TMO      128
#define XB_XCNT(j)  (256  + 64 * (j))
#define XB_XSUB(j)  (1280 + 64 * (j))
#define XB_XGEN(j)  (2304 + 64 * (j))
#define XB_TOP      3328
#define XB_TOPGEN   3392
#define XCD_BAR_WORDS 3456
#define XB_SPIN_CAP (1u << 22)
#define LAS __attribute__((address_space(3)))
__device__ __forceinline__ unsigned xb_ld(unsigned* p)              { return __hip_atomic_load(p, __ATOMIC_RELAXED, __HIP_MEMORY_SCOPE_AGENT); }
__device__ __forceinline__ unsigned xb_add(unsigned* p, unsigned v) { return __hip_atomic_fetch_add(p, v, __ATOMIC_RELAXED, __HIP_MEMORY_SCOPE_AGENT); }
__device__ __forceinline__ unsigned xb_xcc_id() { return (unsigned)__builtin_amdgcn_s_getreg((3 << 11) | 20) & 0xFu; }
#define XB_SPIN(cond, bar) do { unsigned _sp = 0; while (cond) { __builtin_amdgcn_s_sleep(1); \
    if ((++_sp & 255u) == 0u) { if (xb_ld(&(bar)[XB_TMO])) break; if (_sp > XB_SPIN_CAP) { atomicAdd(&(bar)[XB_TMO], 1u); break; } } } } while (0)
struct XcdBarrier { unsigned* bar; unsigned x; volatile LAS unsigned* st; };
__device__ __forceinline__ XcdBarrier xcd_barrier_post(unsigned* bar, volatile LAS unsigned* st) {
  XcdBarrier b; b.bar = bar; b.x = xb_xcc_id(); b.st = st;
  if (tid_local() == 0) (void)xb_add(&bar[XB_XCNT(b.x)], 1u);
  return b;
}
__device__ __forceinline__ void xcd_barrier_complete(unsigned* bar, unsigned x, unsigned& nloc, unsigned& nx, unsigned G) {
  unsigned sum, cnt, mine, sp = 0u;
  for (;;) {
    sum = 0u; cnt = 0u; mine = 0u;
#pragma unroll
    for (unsigned j = 0; j < 16; ++j) { const unsigned c = xb_ld(&bar[XB_XCNT(j)]); sum += c; cnt += (c > 0u) ? 1u : 0u; mine = (j == x) ? c : mine; }
    if (sum == G) break;
    __builtin_amdgcn_s_sleep(1);
    if ((++sp & 255u) == 0u) { if (xb_ld(&bar[XB_TMO])) break; if (sp > XB_SPIN_CAP) { atomicAdd(&bar[XB_TMO], 1u); break; } }
  }
  nloc = mine > 0u ? mine : 1u; nx = cnt > 0u ? cnt : 1u;
}
__device__ __forceinline__ void xcd_barrier_impl(unsigned* bar, unsigned x, volatile LAS unsigned* st, int tid_, unsigned G_) {
  asm volatile("s_waitcnt vmcnt(0)" ::: "memory");
  __syncthreads();
  if (tid_ == 0) {
    __builtin_amdgcn_s_waitcnt(0);
    const unsigned nloc = st[0], nx = st[1];
    const unsigned old = xb_add(&bar[XB_XSUB(x)], 1u);
    const unsigned gen = old / nloc;
    if (old + 1u == (gen + 1u) * nloc) {
      __builtin_amdgcn_fence(__ATOMIC_RELEASE, "agent");
      asm volatile("s_waitcnt vmcnt(0)" ::: "memory");
      const unsigned og = xb_add(&bar[XB_TOP], 1u);
      const unsigned tg = og / nx;
      if (og + 1u == (tg + 1u) * nx) xb_add(&bar[XB_TOPGEN], 1u);
      else XB_SPIN(xb_ld(&bar[XB_TOPGEN]) == tg, bar);
      __builtin_amdgcn_fence(__ATOMIC_ACQUIRE, "agent");
      xb_add(&bar[XB_XGEN(x)], 1u);
      asm volatile("s_waitcnt vmcnt(0)" ::: "memory");
    } else {
      XB_SPIN(xb_ld(&bar[XB_XGEN(x)]) == gen, bar);
      __builtin_amdgcn_fence(__ATOMIC_ACQUIRE, "agent");
      asm volatile("s_waitcnt vmcnt(0)" ::: "memory");
    }
  }
  __syncthreads();
}

template <bool COOP>
__global__ void __launch_bounds__(256, 2) mega(P p, int ph_lo, int ph_hi) {
  __shared__ __attribute__((aligned(16))) char smem[61424];
  const int bid = blockIdx.x, nb = gridDim.x;
  const int tid0 = tid_local();
#define PH_IDS int tid = tid_local(); const int lane = tid & 63, wid = tid >> 6, wr = wid >> 1, wc = wid & 1; (void)lane; (void)wr; (void)wc;
  if constexpr (COOP) { if (ph_hi < 0) cg::this_grid().sync(); }
  __shared__ uint4 xb_words;
  XcdBarrier xb;
  xb.bar = p.BAR; xb.x = 0u; xb.st = (volatile LAS unsigned*)&xb_words;
  if constexpr (COOP) {
    if (tid0 == 0) { xb.st[0] = 0u; xb.st[1] = 0u; }
    __syncthreads();
    xb = xcd_barrier_post(p.BAR, (volatile LAS unsigned*)&xb_words);
    if (tid0 == 0) {
      unsigned nloc = 1u, nx = 1u;
      xcd_barrier_complete(p.BAR, xb.x, nloc, nx, (unsigned)nb);
      xb.st[0] = nloc; xb.st[1] = nx;
    }
    __syncthreads();
  }
  {
    {
      if (PHON(0) && ph_lo <= 0 && 0 < ph_hi) { const int ph = 0; (void)ph;
        PH_IDS
        for (int rep_ = 0; rep_ < REP_P0; ++rep_) {
        ph_ada(p, smem, bid, nb, 0);
        ph_h2(p, smem, bid, nb);
        transpose_job(p.hy_w3, p.W3T, 64, 4096, 1, smem, bid, nb);
        transpose_job(p.ev_w_in, p.WT_EVIN, 2048, 5120, 1, smem, bid, nb);
        transpose_job(p.ev_w_out, p.WT_EVOUT, 2048, 2048, 1, smem, bid, nb);
        transpose_job(p.peer_q, p.WT_PQ, 2048, 2048, 1, smem, bid, nb);
        ph_small_convert(p, bid, nb);
        }
        if constexpr (COOP) if (ph + 1 < ph_hi) xcd_barrier_impl(xb.bar, xb.x, xb.st, (int)tid_local(), (unsigned)nb);
      }
      if (PHON(1) && ph_lo <= 1 && 1 < ph_hi) { const int ph = 1; (void)ph;
        PH_IDS
        for (int rep_ = 0; rep_ < REP_GEMM; ++rep_) {
        ph_norm(p.x, p.ctx, TS, p.norm_mix, p.MOD, p.MOD + 12288, 0, 1, p.ABUF0, bid, nb);
        gemm_phase(p.H2B, 64, p.W3T, 64, TS, 4096, 64, smem, bid, nb, [&](int row0, int col, f32x4 v) {
          const float ad = fabsf(p.hy_deltas[col]);
          float o[4];
#pragma unroll
          for (int j = 0; j < 4; ++j) {
            const int row = row0 + j;
            const float tn = row < TX ? (float)row * (1.f / 8191.f) : (float)(row - TX) * (1.f / 255.f);
            o[j] = v[j] * __expf(-tn * ad);
          }
          *(u32x2*)(p.FILT + (size_t)col * TS + row0) = mk2(pack2(o[0], o[1]), pack2(o[2], o[3]));
        });
        }
        if constexpr (COOP) if (ph + 1 < ph_hi) xcd_barrier_impl(xb.bar, xb.x, xb.st, (int)tid_local(), (unsigned)nb);
      }
      if (PHON(2) && ph_lo <= 2 && 2 < ph_hi) { const int ph = 2; (void)ph;
        PH_IDS
        for (int rep_ = 0; rep_ < REP_GEMM; ++rep_) {
        gemm_phase(p.ABUF0, DM, p.WT_EVIN, DM, TS, 5120, DM, smem, bid, nb, [&](int row0, int col, f32x4 v) {
          float4 o;
          if (col < 3072) { o.x = v[0]; o.y = v[1]; o.z = v[2]; o.w = v[3]; }
          else { o.x = gelu_f(v[0]); o.y = gelu_f(v[1]); o.z = gelu_f(v[2]); o.w = gelu_f(v[3]); }
          *(float4*)(p.PROJT + (size_t)col * TS + row0) = o;
        });
        }
        if constexpr (COOP) if (ph + 1 < ph_hi) xcd_barrier_impl(xb.bar, xb.x, xb.st, (int)tid_local(), (unsigned)nb);
      }
      if (PHON(3) && ph_lo <= 3 && 3 < ph_hi) { const int ph = 3; (void)ph;
        PH_IDS
        for (int rep_ = 0; rep_ < REP_P3; ++rep_) {
        const bool conv_first = ((bid / (nb >> 1)) & 1) != 0;
#define LATE_PREP() { ph_tables(p, bid, nb); __syncthreads(); ph_ada(p, smem, bid, nb, 1); \
          transpose_job(p.od_w_in, p.WT_ODIN, 2048, 3072, 1, smem, bid, nb); \
          transpose_job(p.od_w_out, p.WT_ODOUT, 2048, 2048, 1, smem, bid, nb); \
          transpose_job(p.peer_q + (size_t)DM * DM, p.WT_PQ + (size_t)DM * DM, 2048, 2048, 1, smem, bid, nb); \
          transpose_job(p.pool_w, p.WTPOOL, 256, 256, 4, smem, bid, nb); __syncthreads(); }
        if (conv_first) LATE_PREP()
        for (int item = bid; item < 2048 + 528; item += nb) {
          if (item < 1024) hyena_item<0>(p, smem, item);
          else if (item < 2048) hyena_item<1>(p, smem, item - 1024);
          else gmlp_item(p, smem, (item - 2048) >> 3, (item - 2048) & 7);
        }
        if (!conv_first) LATE_PREP()
        }
        if constexpr (COOP) if (ph + 1 < ph_hi) xcd_barrier_impl(xb.bar, xb.x, xb.st, (int)tid_local(), (unsigned)nb);
      }
      if (PHON(4) && ph_lo <= 4 && 4 < ph_hi) { const int ph = 4; (void)ph;
        PH_IDS
        for (int rep_ = 0; rep_ < REP_GEMM; ++rep_) {
        gemm_phase(p.ABUF1, DM, p.WT_EVOUT, DM, TS, DM, DM, smem, bid, nb, [&](int row0, int col, f32x4 v) {
#pragma unroll
          for (int j = 0; j < 4; ++j) {
            const int row = row0 + j;
            const float base = row < TX ? p.x[(size_t)row * DM + col] : p.ctx[(size_t)(row - TX) * DM + col];
            const float g = p.MOD[(size_t)(row < TX ? 0 : 1) * 12288 + 2 * DM + col];
            p.XA[(size_t)row * DM + col] = base + g * v[j];
          }
        });
        }
        if constexpr (COOP) if (ph + 1 < ph_hi) xcd_barrier_impl(xb.bar, xb.x, xb.st, (int)tid_local(), (unsigned)nb);
      }
      if (PHON(5) && ph_lo <= 5 && 5 < ph_hi) { const int ph = 5; (void)ph;
        PH_IDS
        ph_norm(p.XA, p.XA + (size_t)TX * DM, TS, p.norm_ffn, p.MOD, p.MOD + 12288, 3, 4, p.ABUF0, bid, nb);
        if constexpr (COOP) if (ph + 1 < ph_hi) xcd_barrier_impl(xb.bar, xb.x, xb.st, (int)tid_local(), (unsigned)nb);
      }
      if (PHON(6) && ph_lo <= 6 && 6 < ph_hi) { const int ph = 6; (void)ph;
        PH_IDS
        for (int rep_ = 0; rep_ < REP_GEMM; ++rep_) {
        gemm_phase(p.ABUF0, DM, p.WT_PQ, DM, TS, DM, DM, smem, bid, nb, [&](int row0, int col, f32x4 v) {
#pragma unroll
          for (int j = 0; j < 4; ++j) p.QB[(size_t)(row0 + j) * DM + col] = f2bf(v[j]);
        });
        }
        if constexpr (COOP) if (ph + 1 < ph_hi) xcd_barrier_impl(xb.bar, xb.x, xb.st, (int)tid_local(), (unsigned)nb);
      }
      if (PHON(7) && ph_lo <= 7 && 7 < ph_hi) { const int ph = 7; ph_scores(p, 7, smem, bid, nb);
        if constexpr (COOP) if (ph + 1 < ph_hi) xcd_barrier_impl(xb.bar, xb.x, xb.st, (int)tid_local(), (unsigned)nb);
      }
      if (PHON(8) && ph_lo <= 8 && 8 < ph_hi) { const int ph = 8; (void)ph;
        PH_IDS
        ph_peer<0>(p, 0, TS, smem, bid, nb);
        if constexpr (COOP) if (ph + 1 < ph_hi) xcd_barrier_impl(xb.bar, xb.x, xb.st, (int)tid_local(), (unsigned)nb);
      }
      if (PHON(9) && ph_lo <= 9 && 9 < ph_hi) { const int ph = 9; (void)ph;
        PH_IDS
        for (int rep_ = 0; rep_ < REP_GEMM; ++rep_) {
        gemm_phase(p.ABUF1, DM, p.WT_ODIN, DM, TS, 3072, DM, smem, bid, nb, [&](int row0, int col, f32x4 v) {
#pragma unroll
          for (int j = 0; j < 4; ++j) p.PROJ1[(size_t)(row0 + j) * 3072 + col] = (col < 1024) ? gelu_f(v[j]) : v[j];
        });
        }
        if constexpr (COOP) if (ph + 1 < ph_hi) xcd_barrier_impl(xb.bar, xb.x, xb.st, (int)tid_local(), (unsigned)nb);
      }
      if (PHON(10) && ph_lo <= 10 && 10 < ph_hi) { const int ph = 10; (void)ph;
        PH_IDS
        for (int rep_ = 0; rep_ < REP_L1S; ++rep_) {
        for (int idx = bid * 256 + tid; idx < TS * 256; idx += nb * 256) {
          const int t = idx >> 8, c4 = (idx & 255) * 4;
          const int lo = t < TX ? 0 : TX, hi = t < TX ? TX : TS;
          float4 a = *(const float4*)(p.od_conv_b + c4);
#pragma unroll
          for (int k = 0; k < 4; ++k) {
            const int tt = t + k - 1;
            if (tt >= lo && tt < hi) {
              const float4 xv = *(const float4*)(p.PROJ1 + (size_t)tt * 3072 + 1024 + c4);
              const float4 wv = *(const float4*)(p.od_conv_w + k * 1024 + c4);
              a.x += wv.x * xv.x; a.y += wv.y * xv.y; a.z += wv.z * xv.z; a.w += wv.w * xv.w;
            }
          }
          *(float4*)(p.XR + (size_t)t * 1024 + c4) = a;
          *(u32x2*)(p.XRB + (size_t)t * 1024 + c4) = mk2(pack2(a.x, a.y), pack2(a.z, a.w));
        }
        for (int idx = bid * 256 + tid; idx < TX * 256; idx += nb * 256) {
          const int t = idx >> 8, c4 = (idx & 255) * 4;
          const int half = 1 << (c4 >> 8);
          const int lo = (t - half) < 0 ? 0 : (t - half);
          const int hi = (t + half) > TX ? TX : (t + half);
          float4 s = make_float4(0.f, 0.f, 0.f, 0.f);
          for (int q = lo; q < hi; ++q) {
            const float4 xv = *(const float4*)(p.PROJ1 + (size_t)q * 3072 + 2048 + c4);
            s.x += xv.x; s.y += xv.y; s.z += xv.z; s.w += xv.w;
          }
          const float inv = 1.f / (float)(hi - lo);
          const float4 x0 = *(const float4*)(p.PROJ1 + (size_t)t * 3072 + 2048 + c4);
          *(u32x2*)(p.PD + (size_t)t * 1024 + c4) = mk2(pack2(s.x * inv - x0.x, s.y * inv - x0.y), pack2(s.z * inv - x0.z, s.w * inv - x0.w));
        }
        }
        if constexpr (COOP) if (ph + 1 < ph_hi) xcd_barrier_impl(xb.bar, xb.x, xb.st, (int)tid_local(), (unsigned)nb);
      }
      if (PHON(11) && ph_lo <= 11 && 11 < ph_hi) { const int ph = 11; (void)ph;
        PH_IDS
        for (int rep_ = 0; rep_ < REP_L1S; ++rep_) {
        bf16_t* sA = (bf16_t*)smem;
        bf16_t* sB = sA + 128 * LDS_S;
        for (int id = bid; id < 2112 + 512; id += nb) {
          f32x4 acc[4][4];
          if (id < 2112) {
            const int mt = id % 66, g = id / 66, dir = g >> 4, hh = g & 15, h = hh >> 1, half = hh & 1;
            gemm_core(acc, p.XRB + (size_t)mt * 128 * 1024 + h * 128, 1024, p.WG + (size_t)(dir * 16 + hh) * 128 * 128, 128, 128, sA, sB);
#pragma unroll
            for (int gq = 0; gq < 2; ++gq) {
              const int c = h * 128 + half * 64 + (wc * 2 + gq) * 16 + (lane & 15);
              const float ba = p.lru_ba[dir * 1024 + c], bx = p.lru_bx[dir * 1024 + c];
              const float sp = log1pf(expf(-p.lru_lam[dir * 1024 + c]));
#pragma unroll
              for (int mi = 0; mi < 4; ++mi)
#pragma unroll
                for (int j = 0; j < 4; ++j) {
                  const int t = mt * 128 + wr * 64 + mi * 16 + (lane >> 4) * 4 + j;
                  const float r = sigmoid_f(acc[mi][2 * gq][j] + ba);
                  const float ii = sigmoid_f(acc[mi][2 * gq + 1][j] + bx);
                  const float la = -8.f * r * sp;
                  const float a = expf(la);
                  const float b = sqrtf(-expm1f(2.f * la)) * ii * p.XR[(size_t)t * 1024 + c];
                  p.ABA[((size_t)dir * TS + t) * 1024 + c] = a;
                  p.ABB[((size_t)dir * TS + t) * 1024 + c] = b;
                }
            }
          } else {
            const int id2 = id - 2112, mt = id2 & 63, rest = id2 >> 6, g = rest >> 1, nh = rest & 1;
            gemm_core(acc, p.PD + (size_t)mt * 128 * 1024 + g * 256, 1024, p.WTPOOL + (size_t)g * 256 * 256 + (size_t)nh * 128 * 256, 256, 256, sA, sB);
#pragma unroll
            for (int mi = 0; mi < 4; ++mi)
#pragma unroll
              for (int ni = 0; ni < 4; ++ni) {
                const int cc = g * 256 + nh * 128 + wc * 64 + ni * 16 + (lane & 15);
                const float pb = p.pool_b[cc], ps = p.pool_scale[cc];
#pragma unroll
                for (int j = 0; j < 4; ++j) {
                  const int t = mt * 128 + wr * 64 + mi * 16 + (lane >> 4) * 4 + j;
                  p.ABUF0[(size_t)t * DM + 1024 + cc] = f2bf((acc[mi][ni][j] + pb) * ps);
                }
              }
          }
        }
        }
        if constexpr (COOP) if (ph + 1 < ph_hi) xcd_barrier_impl(xb.bar, xb.x, xb.st, (int)tid_local(), (unsigned)nb);
      }
      if (PHON(12) && ph_lo <= 12 && 12 < ph_hi) { const int ph = 12; (void)ph;
        PH_IDS
        for (int rep_ = 0; rep_ < REP_L1S; ++rep_) {
        for (int item = bid; item < 2 * 132 * 4; item += nb) {
          const int dir = item / 528, rem = item % 528, k = rem >> 2, c = (rem & 3) * 256 + tid;
          const float* pa = p.ABA + (size_t)dir * TS * 1024 + c;
          const float* pb = p.ABB + (size_t)dir * TS * 1024 + c;
          float Pp = 1.f, H = 0.f;
#pragma unroll 8
          for (int s = 0; s < 64; ++s) {
            const int t = dir ? (k * 64 + 63 - s) : (k * 64 + s);
            const float a = pa[(size_t)t * 1024], b = pb[(size_t)t * 1024];
            H = a * H + b; Pp *= a;
          }
          p.AGG[(size_t)(dir * 132 + k) * 1024 + c] = make_float2(Pp, H);
        }
        }
        if constexpr (COOP) if (ph + 1 < ph_hi) xcd_barrier_impl(xb.bar, xb.x, xb.st, (int)tid_local(), (unsigned)nb);
      }
      if (PHON(13) && ph_lo <= 13 && 13 < ph_hi) { const int ph = 13; (void)ph;
        PH_IDS
        for (int rep_ = 0; rep_ < REP_L1S; ++rep_) {
        float* hf = (float*)smem;
        for (int item = bid; item < 1024; item += nb) {
          const int k = item >> 3, cb = item & 7, cl = tid & 127, c = cb * 128 + cl, dir = tid >> 7;
          const float2* ag = p.AGG + (size_t)dir * 132 * 1024 + c;
          const int npre = 4 + (dir ? (127 - k) : k);
          float h = 0.f;
#pragma unroll 8
          for (int v = 0; v < npre; ++v) {
            const int q = dir ? (v < 4 ? 131 - v : 131 - v) : (v < 4 ? 128 + v : v - 4);
            const float2 g = ag[(size_t)q * 1024];
            h = g.x * h + g.y;
          }
          const float* pa = p.ABA + (size_t)dir * TS * 1024 + c;
          const float* pb = p.ABB + (size_t)dir * TS * 1024 + c;
          if (dir == 0) {
#pragma unroll 8
            for (int s = 0; s < 64; ++s) {
              const int t = k * 64 + s;
              h = pa[(size_t)t * 1024] * h + pb[(size_t)t * 1024];
              hf[s * 128 + cl] = h;
            }
          }
          __syncthreads();
          if (dir == 1) {
#pragma unroll 8
            for (int s = 63; s >= 0; --s) {
              const int t = k * 64 + s;
              h = pa[(size_t)t * 1024] * h + pb[(size_t)t * 1024];
              const float y = p.PROJ1[(size_t)t * 3072 + c] * (hf[s * 128 + cl] + h);
              p.ABUF0[(size_t)t * DM + c] = f2bf(y);
            }
          }
          __syncthreads();
        }
        }
        if constexpr (COOP) if (ph + 1 < ph_hi) xcd_barrier_impl(xb.bar, xb.x, xb.st, (int)tid_local(), (unsigned)nb);
      }
      if (PHON(14) && ph_lo <= 14 && 14 < ph_hi) { const int ph = 14; (void)ph;
        PH_IDS
        gemm_phase(p.ABUF0, DM, p.WT_ODOUT, DM, TX, DM, DM, smem, bid, nb, [&](int row0, int col, f32x4 v) {
          const float g = p.MOD[(size_t)2 * 12288 + 2 * DM + col];
#pragma unroll
          for (int j = 0; j < 4; ++j) {
            float* d = p.XA + (size_t)(row0 + j) * DM + col;
            *d = *d + g * v[j];
          }
        });
        if constexpr (COOP) if (ph + 1 < ph_hi) xcd_barrier_impl(xb.bar, xb.x, xb.st, (int)tid_local(), (unsigned)nb);
      }
      if (PHON(15) && ph_lo <= 15 && 15 < ph_hi) { const int ph = 15; (void)ph;
        PH_IDS
        ph_norm(p.XA, p.XA + (size_t)TX * DM, TX, p.norm_ffn + DM, p.MOD + 2 * 12288, p.MOD + 3 * 12288, 3, 4, p.ABUF1, bid, nb);
        if constexpr (COOP) if (ph + 1 < ph_hi) xcd_barrier_impl(xb.bar, xb.x, xb.st, (int)tid_local(), (unsigned)nb);
      }
      if (PHON(16) && ph_lo <= 16 && 16 < ph_hi) { const int ph = 16; (void)ph;
        PH_IDS
        for (int rep_ = 0; rep_ < REP_GEMM; ++rep_) {
        gemm_phase(p.ABUF1, DM, p.WT_PQ + (size_t)DM * DM, DM, TX, DM, DM, smem, bid, nb, [&](int row0, int col, f32x4 v) {
#pragma unroll
          for (int j = 0; j < 4; ++j) p.QB[(size_t)(row0 + j) * DM + col] = f2bf(v[j]);
        });
        }
        if constexpr (COOP) if (ph + 1 < ph_hi) xcd_barrier_impl(xb.bar, xb.x, xb.st, (int)tid_local(), (unsigned)nb);
      }
      if (PHON(7) && ph_lo <= 17 && 17 < ph_hi) { const int ph = 17; ph_scores(p, 17, smem, bid, nb);
        if constexpr (COOP) if (ph + 1 < ph_hi) xcd_barrier_impl(xb.bar, xb.x, xb.st, (int)tid_local(), (unsigned)nb);
      }
      if (PHON(18) && ph_lo <= 18 && 18 < ph_hi) { const int ph = 18; (void)ph;
        PH_IDS
        for (int rep_ = 0; rep_ < REP_P18; ++rep_) {
        ph_peer<1>(p, 1, TX, smem, bid, nb);
        }
        if constexpr (COOP) if (ph + 1 < ph_hi) xcd_barrier_impl(xb.bar, xb.x, xb.st, (int)tid_local(), (unsigned)nb);
      }
    }
  }
}

extern "C" void kernel_launch(void* const* d_in, const int* in_sizes, int n_in, void* d_out, int out_size, void* d_ws,
                              size_t ws_size, hipStream_t stream) {
  P p{};
  const float** pin = (const float**)&p;
  for (int i = 0; i < 40; ++i) pin[i] = (const float*)d_in[i];
  p.out = (float*)d_out;
  char* ws = (char*)d_ws;
  size_t off = 0;
  auto alloc = [&](size_t bytes) { char* r = ws + off; off += (bytes + 255) & ~(size_t)255; return r; };
  p.MOD = (float*)alloc(4 * 12288 * 4);
  p.H2B = (bf16_t*)alloc((size_t)TS * 64 * 2);
  p.W3T = (bf16_t*)alloc((size_t)4096 * 64 * 2);
  p.WT_EVIN = (bf16_t*)alloc((size_t)5120 * 2048 * 2);
  p.WT_EVOUT = (bf16_t*)alloc((size_t)2048 * 2048 * 2);
  p.WT_ODIN = (bf16_t*)alloc((size_t)3072 * 2048 * 2);
  p.WT_ODOUT = (bf16_t*)alloc((size_t)2048 * 2048 * 2);
  p.WT_PQ = (bf16_t*)alloc((size_t)2 * 2048 * 2048 * 2);
  p.WG = (bf16_t*)alloc((size_t)2 * 16 * 128 * 128 * 2);
  p.KEYB = (bf16_t*)alloc((size_t)2 * 16 * 128 * 128 * 2);
  p.GMWS = (bf16_t*)alloc((size_t)8 * 128 * 128 * 2);
  p.WTPOOL = (bf16_t*)alloc((size_t)4 * 256 * 256 * 2);
  p.UB = (unsigned char*)alloc((size_t)2 * 16384 * 2048);
  p.VB = (unsigned char*)alloc((size_t)2 * 16384 * 2048);
  p.SU = (float*)alloc((size_t)2 * 16384 * 4);
  p.SV = (float*)alloc((size_t)2 * 16384 * 4);
  p.ABUF0 = (bf16_t*)alloc((size_t)TS * DM * 2);
  p.ABUF1 = (bf16_t*)alloc((size_t)TS * DM * 2);
  {
    char* r1 = alloc((size_t)5120 * TS * 4);
    p.PROJT = (float*)r1;
    p.PROJ1 = (float*)r1;
    p.XR = (float*)(r1 + (size_t)TS * 3072 * 4);
    p.XRB = (bf16_t*)(r1 + (size_t)TS * 3072 * 4 + (size_t)TS * 1024 * 4);
    p.PD = (bf16_t*)(r1 + (size_t)TS * 3072 * 4 + (size_t)TS * 1024 * 4 + (size_t)TS * 1024 * 2);
  }
  {
    char* r2 = alloc((size_t)2 * 2 * TS * 1024 * 4);
    p.FILT = (bf16_t*)r2;
    p.Z1 = (float*)(r2 + (size_t)4096 * TS * 2);
    p.ABA = (float*)r2;
    p.ABB = (float*)(r2 + (size_t)2 * TS * 1024 * 4);
  }
  p.XA = (float*)alloc((size_t)TS * DM * 4);
  p.QB = (bf16_t*)alloc((size_t)TS * DM * 2);
  p.SC = (float*)alloc((size_t)TS * DM * 4);
  p.AGG = (float2*)alloc((size_t)2 * 132 * 1024 * 8);
  p.BAR = (unsigned*)alloc(XCD_BAR_WORDS * 4);
  if (off > ws_size) { fprintf(stderr, "workspace too small: need %zu have %zu\n", off, ws_size); return; }

#if ONE_LAUNCH
  static int grid_blocks = 0;
  if (!grid_blocks) {
    int dev = 0, cus = 0, per_cu = 0;
    hipGetDevice(&dev);
    hipDeviceGetAttribute(&cus, hipDeviceAttributeMultiprocessorCount, dev);
    hipOccupancyMaxActiveBlocksPerMultiprocessor(&per_cu, mega<true>, 256, 0);
    if (per_cu > 2) per_cu = 2;
    grid_blocks = cus * per_cu;
  }
  int lo = 0, hi = NPH;
  void* args[] = {&p, &lo, &hi};
  hipMemsetAsync(p.BAR, 0, XCD_BAR_WORDS * 4, stream);
  hipError_t e = hipLaunchCooperativeKernel((void*)mega<true>, dim3(grid_blocks), dim3(256), args, 0, stream);
  if (e != hipSuccess) fprintf(stderr, "cooperative launch failed: %s (grid %d)\n", hipGetErrorString(e), grid_blocks);
#else
  for (int ph = 0; ph < NPH; ++ph) mega<false><<<512, 256, 0, stream>>>(p, ph, ph + 1);
#endif
}
```

```cpp
#include <hip/hip_runtime.h>
#include <hip/hip_cooperative_groups.h>
#include <stdint.h>
#include <cstdio>
namespace cg = cooperative_groups;

#ifndef ONE_LAUNCH
#define ONE_LAUNCH 1
#endif

typedef unsigned short bf16_t;
using bf16x8 = __attribute__((ext_vector_type(8))) short;
using f32x4 = __attribute__((ext_vector_type(4))) float;
using u32x4 = __attribute__((ext_vector_type(4))) unsigned int;
using u32x2 = __attribute__((ext_vector_type(2))) unsigned int;
__device__ __forceinline__ u32x4 mk4(unsigned a, unsigned b, unsigned c, unsigned d) { u32x4 r; r.x = a; r.y = b; r.z = c; r.w = d; return r; }
__device__ __forceinline__ u32x2 mk2(unsigned a, unsigned b) { u32x2 r; r.x = a; r.y = b; return r; }

#define TS 8448
#define TX 8192
#define DM 2048
#define NPH 19
#ifndef ONLY_PH
#define ONLY_PH -1
#endif
#define PHON(k) (ONLY_PH < 0 || ONLY_PH == (k))
#ifndef REP_P0
#define REP_P0 1
#endif
#ifndef REP_GEMM
#define REP_GEMM 1
#endif
#ifndef REP_P3
#define REP_P3 1
#endif
#ifndef REP_P18
#define REP_P18 1
#endif
#ifndef REP_TOPK
#define REP_TOPK 1
#endif
#ifndef REP_L1S
#define REP_L1S 1
#endif

struct P {
  const float *x, *c, *ctx, *cctx, *ada_w, *ada_b, *norm_mix, *norm_ffn, *norm_final;
  const float *ev_w_in, *ev_conv_w, *ev_conv_b, *hy_w1, *hy_b1, *hy_w2, *hy_b2, *hy_w3, *hy_freq, *hy_deltas, *hy_bias;
  const float *gm_norm, *gm_ws, *gm_bs, *ev_w_out;
  const float *od_w_in, *od_conv_w, *od_conv_b, *lru_wa, *lru_ba, *lru_wx, *lru_bx, *lru_lam, *pool_w, *pool_b, *pool_scale, *od_w_out;
  const float *peer_q, *peer_keys, *peer_u, *peer_v;
  float* out;
  float* MOD;
  bf16_t* H2B;
  bf16_t* W3T;
  bf16_t* WT_EVIN;
  bf16_t* WT_EVOUT;
  bf16_t* WT_ODIN;
  bf16_t* WT_ODOUT;
  bf16_t* WT_PQ;
  bf16_t* WG;
  bf16_t* KEYB;
  bf16_t* GMWS;
  bf16_t* WTPOOL;
  unsigned char* UB;
  unsigned char* VB;
  float* SU;
  float* SV;
  bf16_t* ABUF0;
  bf16_t* ABUF1;
  float* PROJT;
  float* PROJ1;
  float* XR;
  bf16_t* XRB;
  bf16_t* PD;
  bf16_t* FILT;
  float* Z1;
  float* ABA;
  float* ABB;
  float* XA;
  bf16_t* QB;
  float* SC;
  float2* AGG;
  unsigned* BAR;
};

__device__ __forceinline__ int tid_local() { int t_ = (int)threadIdx.x; asm volatile("" : "+v"(t_)); return t_; }
__device__ __forceinline__ bf16_t f2bf(float f) {
  uint32_t u = __float_as_uint(f);
  u += 0x7FFFu + ((u >> 16) & 1u);
  return (bf16_t)(u >> 16);
}
__device__ __forceinline__ float bf2f(bf16_t b) { return __uint_as_float(((uint32_t)b) << 16); }
__device__ __forceinline__ uint32_t pack2(float a, float b) { return (uint32_t)f2bf(a) | ((uint32_t)f2bf(b) << 16); }
__device__ __forceinline__ float bflo(uint32_t u) { return __uint_as_float(u << 16); }
__device__ __forceinline__ float bfhi(uint32_t u) { return __uint_as_float(u & 0xFFFF0000u); }
__device__ __forceinline__ float gelu_f(float x) {
  float u = 0.7978845608028654f * (x + 0.044715f * x * x * x);
  return x / (1.f + __expf(-2.f * u));
}
__device__ __forceinline__ float sigmoid_f(float x) { return 1.f / (1.f + __expf(-x)); }
__device__ __forceinline__ float wave_sum(float v) {
#pragma unroll
  for (int o = 32; o >= 1; o >>= 1) v += __shfl_xor(v, o);
  return v;
}
__device__ __forceinline__ uint32_t wave_max_u32(uint32_t v) {
#pragma unroll
  for (int o = 32; o >= 1; o >>= 1) { uint32_t t = (uint32_t)__shfl_xor((int)v, o); v = v > t ? v : t; }
  return v;
}
__device__ __forceinline__ uint32_t fkey(float f) { uint32_t u = __float_as_uint(f); return (u & 0x80000000u) ? ~u : (u | 0x80000000u); }
__device__ __forceinline__ float funkey(uint32_t k) { uint32_t u = (k & 0x80000000u) ? (k & 0x7FFFFFFFu) : ~k; return __uint_as_float(u); }

#define LDS_S 72
template <int NI>
__device__ __forceinline__ void gemm_core_t(f32x4 (&acc)[4][NI], const bf16_t* __restrict__ A, int lda,
                                            const bf16_t* __restrict__ Bt, int ldb, int K, bf16_t* sA, bf16_t* sB) {
  const int tid = tid_local(), lane = tid & 63, wid = tid >> 6, wr = wid >> 1, wc = wid & 1;
  const int lr = tid >> 3, lc = (tid & 7) * 8;
#pragma unroll
  for (int i = 0; i < 4; ++i)
#pragma unroll
    for (int j = 0; j < NI; ++j) acc[i][j] = (f32x4){0.f, 0.f, 0.f, 0.f};
  u32x4 ra[4], rb[NI];
#pragma unroll
  for (int i = 0; i < 4; ++i) ra[i] = *(const u32x4*)(A + (size_t)(lr + 32 * i) * lda + lc);
#pragma unroll
  for (int i = 0; i < NI; ++i) rb[i] = *(const u32x4*)(Bt + (size_t)(lr + 32 * i) * ldb + lc);
  const int nk = K >> 6;
  for (int kt = 0; kt < nk; ++kt) {
    __syncthreads();
#pragma unroll
    for (int i = 0; i < 4; ++i) *(u32x4*)(sA + (lr + 32 * i) * LDS_S + lc) = ra[i];
#pragma unroll
    for (int i = 0; i < NI; ++i) *(u32x4*)(sB + (lr + 32 * i) * LDS_S + lc) = rb[i];
    __syncthreads();
    if (kt + 1 < nk) {
      const int ko = (kt + 1) * 64;
#pragma unroll
      for (int i = 0; i < 4; ++i) ra[i] = *(const u32x4*)(A + (size_t)(lr + 32 * i) * lda + ko + lc);
#pragma unroll
      for (int i = 0; i < NI; ++i) rb[i] = *(const u32x4*)(Bt + (size_t)(lr + 32 * i) * ldb + ko + lc);
    }
    bf16x8 af[2][4], bfr[2][NI];
#pragma unroll
    for (int ks = 0; ks < 2; ++ks) {
#pragma unroll
      for (int mi = 0; mi < 4; ++mi)
        af[ks][mi] = *(const bf16x8*)(sA + (wr * 64 + mi * 16 + (lane & 15)) * LDS_S + ks * 32 + (lane >> 4) * 8);
#pragma unroll
      for (int ni = 0; ni < NI; ++ni)
        bfr[ks][ni] = *(const bf16x8*)(sB + (wc * 16 * NI + ni * 16 + (lane & 15)) * LDS_S + ks * 32 + (lane >> 4) * 8);
    }
#pragma unroll
    for (int ks = 0; ks < 2; ++ks)
#pragma unroll
      for (int mi = 0; mi < 4; ++mi)
#pragma unroll
        for (int ni = 0; ni < NI; ++ni)
          acc[mi][ni] = __builtin_amdgcn_mfma_f32_16x16x32_bf16(af[ks][mi], bfr[ks][ni], acc[mi][ni], 0, 0, 0);
  }
}
__device__ __forceinline__ void gemm_core(f32x4 (&acc)[4][4], const bf16_t* __restrict__ A, int lda,
                                          const bf16_t* __restrict__ Bt, int ldb, int K, bf16_t* sA, bf16_t* sB) {
  gemm_core_t<4>(acc, A, lda, Bt, ldb, K, sA, sB);
}

template <class Epi>
__device__ __forceinline__ void gemm_phase(const bf16_t* A, int lda, const bf16_t* Bt, int ldb, int M, int N, int K,
                                           char* smem, int bid, int nb, Epi epi) {
  const int numM = M >> 7, numN = N >> 7;
  bf16_t* sA = (bf16_t*)smem;
  bf16_t* sB = sA + 128 * LDS_S;
  const int lane = tid_local() & 63, wid = tid_local() >> 6, wr = wid >> 1, wc = wid & 1;
  const int total = numM * numN;
  const int full = (total / nb) * nb;
  const int vb = ((nb & 7) == 0) ? (bid & 7) * (nb >> 3) + (bid >> 3) : bid;
  auto tile_of = [&](int id, int& mt, int& nt) {
    const int gsz = 8 * numN, g = id / gsz, fm = g * 8;
    const int rows = (numM - fm) < 8 ? (numM - fm) : 8;
    const int r = id - g * gsz;
    mt = fm + r % rows; nt = r / rows;
  };
  for (int id = vb; id < full; id += nb) {
    int mt, nt;
    tile_of(id, mt, nt);
    f32x4 acc[4][4];
    gemm_core_t<4>(acc, A + (size_t)mt * 128 * lda, lda, Bt + (size_t)nt * 128 * ldb, ldb, K, sA, sB);
#pragma unroll
    for (int mi = 0; mi < 4; ++mi)
#pragma unroll
      for (int ni = 0; ni < 4; ++ni)
        epi(mt * 128 + wr * 64 + mi * 16 + (lane >> 4) * 4, nt * 128 + wc * 64 + ni * 16 + (lane & 15), acc[mi][ni]);
  }
  for (int u = vb; u < (total - full) * 4; u += nb) {
    const int id = full + (u >> 2), qd = u & 3;
    int mt, nt;
    tile_of(id, mt, nt);
    f32x4 acc[4][1];
    gemm_core_t<1>(acc, A + (size_t)mt * 128 * lda, lda, Bt + (size_t)(nt * 128 + qd * 32) * ldb, ldb, K, sA, sB);
#pragma unroll
    for (int mi = 0; mi < 4; ++mi)
      epi(mt * 128 + wr * 64 + mi * 16 + (lane >> 4) * 4, nt * 128 + qd * 32 + wc * 16 + (lane & 15), acc[mi][0]);
  }
}

__device__ __forceinline__ void ph_ada(const P& p, char* smem, int bid, int nb, int layer) {
  float* sc = (float*)smem;
  float* sx = sc + 2048;
  float* red = sx + 2048;
  const int tid = tid_local();
  bool loaded = false;
  for (int item0 = bid; item0 < 384; item0 += nb) {
    const int item = item0 + layer * 384;
    if (!loaded) {
      for (int i = tid; i < 2048; i += 256) {
        float v = p.c[i]; sc[i] = v * sigmoid_f(v);
        float w = p.cctx[i]; sx[i] = w * sigmoid_f(w);
      }
      __syncthreads();
      loaded = true;
    }
    const int l = item / 384, cgp = item % 384;
    const int col = cgp * 32 + (tid & 31), kg = tid >> 5;
    const float* w = p.ada_w + (size_t)l * 2048 * 12288 + col;
    float a0 = 0.f, a1 = 0.f;
#pragma unroll 16
    for (int k = kg; k < 2048; k += 8) {
      float wv = w[(size_t)k * 12288];
      a0 += sc[k] * wv; a1 += sx[k] * wv;
    }
    red[(kg * 32 + (tid & 31)) * 2 + 0] = a0;
    red[(kg * 32 + (tid & 31)) * 2 + 1] = a1;
    __syncthreads();
    if (tid < 64) {
      const int cc = tid & 31, which = tid >> 5;
      float s = 0.f;
#pragma unroll
      for (int g = 0; g < 8; ++g) s += red[(g * 32 + cc) * 2 + which];
      const int colo = cgp * 32 + cc;
      p.MOD[(size_t)(l * 2 + which) * 12288 + colo] = s + p.ada_b[l * 12288 + colo];
    }
    __syncthreads();
  }
  __syncthreads();
}

__device__ __forceinline__ void ph_h2(const P& p, char* smem, int bid, int nb) {
  float* feats = (float*)smem;
  float* h1 = feats + 160;
  float* w1s = feats + 512;
  float* w2s = w1s + 33 * 64;
  const int tid = tid_local(), r = tid >> 6, j = tid & 63;
  if (bid < 2112) {
    for (int i = tid; i < 33 * 64; i += 256) w1s[i] = p.hy_w1[i];
    for (int i = tid; i < 64 * 64; i += 256) w2s[i] = p.hy_w2[i];
  }
  const float b1 = p.hy_b1[j], b2 = p.hy_b2[j], fr = p.hy_freq[j];
  __syncthreads();
  for (int item = bid; item < 2112; item += nb) {
    const int row = item * 4 + r;
    const int L = row < TX ? TX : 256;
    const int t = row < TX ? row : row - TX;
    if (j < 33) {
      const float tn = (float)t / (float)(L - 1);
      float f;
      if (j == 0) f = tn;
      else {
        const int bi = (j - 1) & 15;
        const float band = 1e-4f + (float)bi * ((15.f - 1e-4f) / 15.f);
        const float ang = (6.283185307179586f / (float)L) * (float)t * band;
        f = (j <= 16) ? cosf(ang) : -sinf(ang);
      }
      feats[r * 36 + j] = f;
    }
    __syncthreads();
    float a = b1;
#pragma unroll
    for (int i = 0; i < 33; ++i) a += feats[r * 36 + i] * w1s[i * 64 + j];
    h1[r * 64 + j] = sinf(fr * a);
    __syncthreads();
    float a2 = b2;
#pragma unroll 16
    for (int i = 0; i < 64; ++i) a2 += h1[r * 64 + i] * w2s[i * 64 + j];
    p.H2B[(size_t)row * 64 + j] = f2bf(sinf(fr * a2));
  }
  __syncthreads();
}

using f32x2 = __attribute__((ext_vector_type(2))) float;
#ifndef FP6_ORDER
#define FP6_ORDER 1
#endif
using v16f = __attribute__((ext_vector_type(16))) float;
using v32f = __attribute__((ext_vector_type(32))) float;
using v6u = __attribute__((ext_vector_type(6))) unsigned int;
#define ROWB 1536
__device__ __forceinline__ void ph_tables(const P& p, int bid, int nb) {
  const int lane = tid_local() & 63, w = tid_local() >> 6;
  for (int r = bid * 4 + w; r < 65536; r += nb * 4) {
    const int tb = r >> 15, row = r & 32767;
    const float* src = (tb ? p.peer_v : p.peer_u) + (size_t)row * 2048 + lane * 32;
    unsigned char* dst = (tb ? p.VB : p.UB) + (size_t)row * ROWB;
    f32x4 v[8];
    float amax = 0.f;
#pragma unroll
    for (int q = 0; q < 8; ++q) {
      v[q] = *(const f32x4*)(src + q * 4);
      amax = fmaxf(amax, fmaxf(fmaxf(fabsf(v[q].x), fabsf(v[q].y)), fmaxf(fabsf(v[q].z), fabsf(v[q].w))));
    }
#pragma unroll
    for (int o = 32; o >= 1; o >>= 1) amax = fmaxf(amax, __shfl_xor(amax, o));
    const float sc = (amax > 0.f) ? exp2f(floorf(log2f(7.5f / amax))) : 1.f;
    v16f a, b;
#pragma unroll
    for (int k = 0; k < 16; ++k) {
#if FP6_ORDER == 0
      const int ia = k, ib = 16 + k;
#else
      const int ia = 2 * k, ib = 2 * k + 1;
#endif
      a[k] = v[ia >> 2][ia & 3] * sc;
      b[k] = v[ib >> 2][ib & 3] * sc;
    }
    const v6u pk = __builtin_amdgcn_cvt_scalef32_2xpk16_fp6_f32(a, b, 1.0f);
#pragma unroll
    for (int jc = 0; jc < 3; ++jc) *(u32x2*)(dst + jc * 512 + lane * 8) = mk2(pk[2 * jc], pk[2 * jc + 1]);
    if (lane == 0) (tb ? p.SV : p.SU)[row] = 1.f / sc;
  }
}

__device__ __forceinline__ void transpose_job(const float* src, bf16_t* dst, int K, int N, int batch, char* smem, int bid, int nb) {
  float* s = (float*)smem;
  const int tid = tid_local();
  const int tK = K >> 6, tN = N >> 6, per = tK * tN, total = batch * per;
  for (int item = bid; item < total; item += nb) {
    const int b = item / per, rem = item % per, tk = rem / tN, tn = rem % tN;
    const float* sp = src + (size_t)b * K * N + (size_t)(tk * 64) * N + tn * 64;
#pragma unroll
    for (int i = 0; i < 4; ++i) {
      const int row = (tid >> 4) + 16 * i, c4 = (tid & 15) * 4;
      float4 v = *(const float4*)(sp + (size_t)row * N + c4);
      s[row * 65 + c4 + 0] = v.x; s[row * 65 + c4 + 1] = v.y; s[row * 65 + c4 + 2] = v.z; s[row * 65 + c4 + 3] = v.w;
    }
    __syncthreads();
    const int n = tid >> 2, kq = tid & 3;
    uint32_t w[8];
#pragma unroll
    for (int e = 0; e < 8; ++e) w[e] = pack2(s[(kq * 16 + 2 * e) * 65 + n], s[(kq * 16 + 2 * e + 1) * 65 + n]);
    bf16_t* d = dst + (size_t)b * N * K + (size_t)(tn * 64 + n) * K + tk * 64 + kq * 16;
    *(u32x4*)d = mk4(w[0], w[1], w[2], w[3]);
    *(u32x4*)(d + 8) = mk4(w[4], w[5], w[6], w[7]);
    __syncthreads();
  }
}

__device__ __forceinline__ void ph_small_convert(const P& p, int bid, int nb) {
  const int gt = bid * 256 + tid_local(), gs = nb * 256;
  for (int i = gt; i < 2 * 16 * 128 * 128; i += gs) {
    const int k = i & 127, n = (i >> 7) & 127, hh = (i >> 14) & 15, dir = i >> 18;
    const int wc = n >> 6, ni = (n >> 4) & 3, l = n & 15;
    const int type = ni & 1, cl = (wc * 2 + (ni >> 1)) * 16 + l;
    const int h = hh >> 1, half = hh & 1, j = half * 64 + cl;
    const float* src = type ? p.lru_wx : p.lru_wa;
    p.WG[i] = f2bf(src[((size_t)(dir * 8 + h) * 128 + k) * 128 + j]);
  }
  for (int i = gt; i < 2 * 16 * 128 * 128; i += gs) p.KEYB[i] = f2bf(p.peer_keys[i]);
  for (int i = gt; i < 8 * 128 * 128; i += gs) p.GMWS[i] = f2bf(p.gm_ws[i]);
}

__device__ __forceinline__ void ph_norm(const float* srcx, const float* srcc, int nrows, const float* gnorm, const float* modx,
                        const float* modc, int shIdx, int scIdx, bf16_t* dst, int bid, int nb) {
  const int lane = tid_local() & 63, w = tid_local() >> 6;
  for (int row = bid * 4 + w; row < nrows; row += nb * 4) {
    const float* s = row < TX ? srcx + (size_t)row * DM : srcc + (size_t)(row - TX) * DM;
    const float* md = row < TX ? modx : modc;
    float4 v[8];
    float ss = 0.f;
#pragma unroll
    for (int i = 0; i < 8; ++i) {
      v[i] = ((const float4*)s)[i * 64 + lane];
      ss += v[i].x * v[i].x + v[i].y * v[i].y + v[i].z * v[i].z + v[i].w * v[i].w;
    }
    ss = wave_sum(ss);
    const float rstd = rsqrtf(ss * (1.f / DM) + 1e-6f);
#pragma unroll
    for (int i = 0; i < 8; ++i) {
      const int d = (i * 64 + lane) * 4;
      const float4 g = *(const float4*)(gnorm + d);
      const float4 sc = *(const float4*)(md + scIdx * DM + d);
      const float4 sh = *(const float4*)(md + shIdx * DM + d);
      const float y0 = v[i].x * rstd * g.x * (1.f + sc.x) + sh.x;
      const float y1 = v[i].y * rstd * g.y * (1.f + sc.y) + sh.y;
      const float y2 = v[i].z * rstd * g.z * (1.f + sc.z) + sh.z;
      const float y3 = v[i].w * rstd * g.w * (1.f + sc.w) + sh.w;
      *(u32x2*)(dst + (size_t)row * DM + d) = mk2(pack2(y0, y1), pack2(y2, y3));
    }
  }
}

__device__ __forceinline__ float conv3_at(const P& p, int part, int ch, int toff, int L, int s) {
  const int c = part * 1024 + ch;
  const float* row = p.PROJT + (size_t)c * TS + toff;
  float v = p.ev_conv_b[c] + p.ev_conv_w[3072 + c] * row[s];
  if (s > 0) v += p.ev_conv_w[c] * row[s - 1];
  if (s < L - 1) v += p.ev_conv_w[2 * 3072 + c] * row[s + 1];
  return v;
}

__device__ __forceinline__ float4 conv3_vec4(const P& p, int part, int ch, int toff, int L, int s0) {
  const int c = part * 1024 + ch;
  const float* row = p.PROJT + (size_t)c * TS + toff;
  const float4 m = *(const float4*)(row + s0);
  const float l = (s0 > 0) ? row[s0 - 1] : 0.f;
  const float r = (s0 + 4 < L) ? row[s0 + 4] : 0.f;
  const float b = p.ev_conv_b[c], w0 = p.ev_conv_w[c], w1 = p.ev_conv_w[3072 + c], w2 = p.ev_conv_w[2 * 3072 + c];
  float4 o;
  o.x = b + w0 * l + w1 * m.x + w2 * m.y;
  o.y = b + w0 * m.x + w1 * m.y + w2 * m.z;
  o.z = b + w0 * m.y + w1 * m.z + w2 * m.w;
  o.w = b + w0 * m.z + w1 * m.w + w2 * r;
  return o;
}

#define C3_LOAD(M, Lf, Rt, part, s0) { const float* row_ = p.PROJT + (size_t)((part) * 1024 + ch) * TS + toff; \
    M = *(const f32x4*)(row_ + (s0)); Lf = ((s0) > 0) ? row_[(s0) - 1] : 0.f; Rt = ((s0) + 4 < L) ? row_[(s0) + 4] : 0.f; }
__device__ __forceinline__ f32x4 c3_eval(f32x4 m, float l, float r, float b, float w0, float w1, float w2) {
  f32x4 o;
  o.x = b + w0 * l + w1 * m.x + w2 * m.y;
  o.y = b + w0 * m.x + w1 * m.y + w2 * m.z;
  o.z = b + w0 * m.y + w1 * m.z + w2 * m.w;
  o.w = b + w0 * m.z + w1 * m.w + w2 * r;
  return o;
}

template <int SEQ>
__device__ __forceinline__ void hyena_item(const P& p, char* smem, int ch) {
  constexpr int L = SEQ ? 256 : TX;
  constexpr int toff = SEQ ? TX : 0;
  constexpr int nB = L >> 7;
  constexpr int NT = SEQ ? 1 : 4;
  bf16_t* KK = (bf16_t*)smem;
  float* ybuf = (float*)smem;
  bf16_t* UP = (bf16_t*)(smem + 34816);
  bf16_t* CP = (bf16_t*)(smem + 51712);
  float* red = (float*)(smem + 59904);
  const int tid = tid_local(), lane = tid & 63, w = tid >> 6;
  for (int n = 0; n < 2; ++n) {
    const bf16_t* ff = p.FILT + (size_t)(n * 1024 + ch) * TS + toff;
    const bf16_t* fb = p.FILT + (size_t)(2048 + n * 1024 + ch) * TS + toff;
    float sabs = 0.f;
    {
      constexpr int NKK = ((2 * L) / 8 + 255) / 256;
      u32x4 kv[NKK];
#pragma unroll
      for (int k = 0; k < NKK; ++k) {
        const int idx = (tid + 256 * k) * 8;
        kv[k] = mk4(0u, 0u, 0u, 0u);
        if (idx < 2 * L) kv[k] = (idx >= L) ? *(const u32x4*)(ff + (idx - L)) : *(const u32x4*)(fb + (L - 8 - idx));
      }
#pragma unroll
      for (int k = 0; k < NKK; ++k) {
        const int idx = (tid + 256 * k) * 8;
        if (idx < 2 * L) {
          u32x4 v = kv[k];
          if (idx < L) {
            const u32x4 r = v;
            v.x = (r.w >> 16) | (r.w << 16); v.y = (r.z >> 16) | (r.z << 16); v.z = (r.y >> 16) | (r.y << 16); v.w = (r.x >> 16) | (r.x << 16);
          }
          sabs += fabsf(bflo(v.x)) + fabsf(bfhi(v.x)) + fabsf(bflo(v.y)) + fabsf(bfhi(v.y)) + fabsf(bflo(v.z)) + fabsf(bfhi(v.z)) + fabsf(bflo(v.w)) + fabsf(bfhi(v.w));
          *(u32x4*)(KK + (idx >> 7) * 136 + (idx & 127)) = v;
        }
      }
    }
    sabs = wave_sum(sabs);
    if (lane == 0) red[w] = sabs;
    const float cb0 = p.ev_conv_b[ch], cw00 = p.ev_conv_w[ch], cw01 = p.ev_conv_w[3072 + ch], cw02 = p.ev_conv_w[2 * 3072 + ch];
    {
      constexpr int NUP = ((L + 256) / 4 + 255) / 256;
      if (n == 0) {
        constexpr int CH = SEQ ? 1 : 3;
#pragma unroll 1
        for (int k0 = 0; k0 < NUP; k0 += CH) {
          f32x4 cm[CH]; float cl[CH], cr[CH];
#pragma unroll
          for (int k = 0; k < CH; ++k) {
            const int s0 = (tid + 256 * (k0 + k)) * 4 - 128;
            cm[k] = (f32x4){0.f, 0.f, 0.f, 0.f}; cl[k] = 0.f; cr[k] = 0.f;
            if (s0 >= 0 && s0 < L) C3_LOAD(cm[k], cl[k], cr[k], 0, s0)
          }
#pragma unroll
          for (int k = 0; k < CH; ++k) {
            const int iv = tid + 256 * (k0 + k), s0 = iv * 4 - 128;
            if (iv < (L + 256) / 4) {
              f32x4 u = (f32x4){0.f, 0.f, 0.f, 0.f};
              if (s0 >= 0 && s0 < L) u = c3_eval(cm[k], cl[k], cr[k], cb0, cw00, cw01, cw02);
              *(u32x2*)(UP + iv * 4) = mk2(pack2(u.x, u.y), pack2(u.z, u.w));
            }
          }
        }
      } else {
        f32x4 zv[NUP];
#pragma unroll
        for (int k = 0; k < NUP; ++k) {
          const int s0 = (tid + 256 * k) * 4 - 128;
          zv[k] = (f32x4){0.f, 0.f, 0.f, 0.f};
          if (s0 >= 0 && s0 < L) zv[k] = *(const f32x4*)(p.Z1 + (size_t)ch * TS + toff + s0);
        }
#pragma unroll
        for (int k = 0; k < NUP; ++k) {
          const int iv = tid + 256 * k;
          if (iv < (L + 256) / 4) *(u32x2*)(UP + iv * 4) = mk2(pack2(zv[k].x, zv[k].y), pack2(zv[k].z, zv[k].w));
        }
      }
    }
    __syncthreads();
    const float invS = 1.f / (red[0] + red[1] + red[2] + red[3]);

    f32x4 acc[2][NT];
#pragma unroll
    for (int a = 0; a < 2; ++a)
#pragma unroll
      for (int b = 0; b < NT; ++b) acc[a][b] = (f32x4){0.f, 0.f, 0.f, 0.f};

    auto build_window = [&](int c, int buf) {
      const int sg = tid >> 5, y0 = (tid & 31) * 8;
      uint32_t wv[4] = {0u, 0u, 0u, 0u};
      if (y0 < 248) {
        const int base = (c + 1) * 128 - 1 - y0 - sg + 128;
#pragma unroll
        for (int e = 0; e < 4; ++e) wv[e] = (uint32_t)UP[base - 2 * e] | ((uint32_t)UP[base - 2 * e - 1] << 16);
      }
      *(u32x4*)(CP + buf * 2048 + sg * 256 + y0) = mk4(wv[0], wv[1], wv[2], wv[3]);
    };
    build_window(0, 0);
    __syncthreads();
    for (int c = 0; c <= nB; ++c) {
      const int buf = c & 1;
      if (c < nB) build_window(c + 1, buf ^ 1);
      const bf16_t* cp = CP + buf * 2048;
      bf16x8 aF[2][2], bF[2][NT];
      const bf16_t* kbase[NT];
#pragma unroll
      for (int nt = 0; nt < NT; ++nt) {
        int e = nt * 16 + (lane & 15);
        if (e > nB - 1) e = nB - 1;
        kbase[nt] = KK + (e - c + nB) * 136 + 8 * (lane >> 4);
      }
      const bf16_t* abase = cp + 120 + 8 * (lane >> 4) - 8 * (lane & 15);
#pragma unroll
      for (int mi = 0; mi < 2; ++mi) aF[0][mi] = *(const bf16x8*)(abase + (7 - (2 * w + mi)) * 256);
#pragma unroll
      for (int nt = 0; nt < NT; ++nt) bF[0][nt] = *(const bf16x8*)(kbase[nt]);
#pragma unroll
      for (int js = 0; js < 4; ++js) {
        if (js < 3) {
#pragma unroll
          for (int mi = 0; mi < 2; ++mi) aF[(js + 1) & 1][mi] = *(const bf16x8*)(abase + (7 - (2 * w + mi)) * 256 + 32 * (js + 1));
#pragma unroll
          for (int nt = 0; nt < NT; ++nt) bF[(js + 1) & 1][nt] = *(const bf16x8*)(kbase[nt] + 32 * (js + 1));
        }
#pragma unroll
        for (int nt = 0; nt < NT; ++nt)
#pragma unroll
          for (int mi = 0; mi < 2; ++mi)
            acc[mi][nt] = __builtin_amdgcn_mfma_f32_16x16x32_bf16(aF[js & 1][mi], bF[js & 1][nt], acc[mi][nt], 0, 0, 0);
      }
      __syncthreads();
    }
#pragma unroll
    for (int mi = 0; mi < 2; ++mi)
#pragma unroll
      for (int nt = 0; nt < NT; ++nt) {
        const int e = nt * 16 + (lane & 15);
        if (e < nB) {
#pragma unroll
          for (int j = 0; j < 4; ++j) {
            const int rho = (lane >> 4) * 4 + j;
            const int tau = (2 * w + mi) + 8 * rho;
            ybuf[e * 128 + tau] = acc[mi][nt][j] * invS;
          }
        }
      }
    __syncthreads();
    const float bias = p.hy_bias[n * 1024 + ch];
    {
      constexpr int NE = (L / 4 + 255) / 256;
      const int pa = (n == 0) ? 1 : 2;
      const float pb = p.ev_conv_b[pa * 1024 + ch], pw0 = p.ev_conv_w[pa * 1024 + ch], pw1 = p.ev_conv_w[3072 + pa * 1024 + ch], pw2 = p.ev_conv_w[2 * 3072 + pa * 1024 + ch];
      constexpr int CE = SEQ ? 1 : 4;
#pragma unroll 1
      for (int k0 = 0; k0 < NE; k0 += CE) {
        f32x4 am[CE], bm[CE];
        float al[CE], ar[CE], bl[CE], br[CE];
#pragma unroll
        for (int k = 0; k < CE; ++k) {
          const int t0 = (tid + 256 * (k0 + k)) * 4;
          am[k] = (f32x4){0.f, 0.f, 0.f, 0.f}; bm[k] = am[k]; al[k] = 0.f; ar[k] = 0.f; bl[k] = 0.f; br[k] = 0.f;
          if (t0 < L) {
            C3_LOAD(am[k], al[k], ar[k], pa, t0)
            if (n == 0) C3_LOAD(bm[k], bl[k], br[k], 0, t0)
            else bm[k] = *(const f32x4*)(p.Z1 + (size_t)ch * TS + toff + t0);
          }
        }
#pragma unroll
        for (int k = 0; k < CE; ++k) {
          const int t0 = (tid + 256 * (k0 + k)) * 4;
          if (t0 < L) {
            const f32x4 y = *(const f32x4*)(ybuf + t0);
            const f32x4 xm = c3_eval(am[k], al[k], ar[k], pb, pw0, pw1, pw2);
            if (n == 0) {
              const f32x4 v = c3_eval(bm[k], bl[k], br[k], cb0, cw00, cw01, cw02);
              f32x4 z;
              z.x = xm.x * (y.x + bias * v.x); z.y = xm.y * (y.y + bias * v.y); z.z = xm.z * (y.z + bias * v.z); z.w = xm.w * (y.w + bias * v.w);
              *(f32x4*)(p.Z1 + (size_t)ch * TS + toff + t0) = z;
            } else {
              const f32x4 z1 = bm[k];
              bf16_t* o = p.ABUF1 + (size_t)(toff + t0) * DM + ch;
              o[0] = f2bf(xm.x * (y.x + bias * z1.x));
              o[DM] = f2bf(xm.y * (y.y + bias * z1.y));
              o[2 * DM] = f2bf(xm.z * (y.z + bias * z1.z));
              o[3 * DM] = f2bf(xm.w * (y.w + bias * z1.w));
            }
          }
        }
      }
    }
    __threadfence_block();
    __syncthreads();
  }
}

__device__ __forceinline__ void gmlp_item(const P& p, char* smem, int n, int h) {
  bf16_t* Bt = (bf16_t*)smem;
  float* rs = (float*)(smem + 34816);
  const int tid = tid_local(), lane = tid & 63, w = tid >> 6;
  const float* VG = p.PROJT + (size_t)4096 * TS + n * 128;
  {
    const int c8 = tid >> 5, q4 = (tid & 31) * 4;
    float4 s4 = make_float4(0.f, 0.f, 0.f, 0.f);
#pragma unroll 16
    for (int c = c8; c < 1024; c += 8) {
      const float4 v = *(const float4*)(VG + (size_t)c * TS + q4);
      s4.x += v.x * v.x; s4.y += v.y * v.y; s4.z += v.z * v.z; s4.w += v.w * v.w;
    }
    float* rs8 = rs + 128;
    *(float4*)(rs8 + c8 * 128 + q4) = s4;
  }
  __syncthreads();
  if (tid < 128) {
    float a = 0.f;
#pragma unroll
    for (int g = 0; g < 8; ++g) a += rs[128 + g * 128 + tid];
    rs[tid] = rsqrtf(a * (1.f / 1024.f) + 1e-6f);
  }
  __syncthreads();
  {
    const int c = tid >> 1, q0 = (tid & 1) * 64;
    const float g = p.gm_norm[h * 128 + c];
    const float* src = VG + (size_t)(h * 128 + c) * TS + q0;
#pragma unroll 4
    for (int i = 0; i < 16; ++i) {
      const float4 v = *(const float4*)(src + 4 * i);
      const int q = q0 + 4 * i;
      *(u32x2*)(Bt + c * 136 + q) = mk2(pack2(v.x * rs[q] * g, v.y * rs[q + 1] * g), pack2(v.z * rs[q + 2] * g, v.w * rs[q + 3] * g));
    }
  }
  __syncthreads();
  f32x4 acc[2][8];
#pragma unroll
  for (int a = 0; a < 2; ++a)
#pragma unroll
    for (int b = 0; b < 8; ++b) acc[a][b] = (f32x4){0.f, 0.f, 0.f, 0.f};
  const bf16_t* Aw = p.GMWS + (size_t)h * 128 * 128;
  bf16x8 afA[4][2];
#pragma unroll
  for (int ks = 0; ks < 4; ++ks)
#pragma unroll
    for (int mi = 0; mi < 2; ++mi)
      afA[ks][mi] = *(const bf16x8*)(Aw + (32 * w + 16 * mi + (lane & 15)) * 128 + ks * 32 + (lane >> 4) * 8);
#pragma unroll
  for (int ks = 0; ks < 4; ++ks) {
    bf16x8 bB[8];
#pragma unroll
    for (int ni = 0; ni < 8; ++ni) bB[ni] = *(const bf16x8*)(Bt + (ni * 16 + (lane & 15)) * 136 + ks * 32 + (lane >> 4) * 8);
#pragma unroll
    for (int ni = 0; ni < 8; ++ni)
#pragma unroll
      for (int mi = 0; mi < 2; ++mi)
        acc[mi][ni] = __builtin_amdgcn_mfma_f32_16x16x32_bf16(afA[ks][mi], bB[ni], acc[mi][ni], 0, 0, 0);
  }
#pragma unroll
  for (int mi = 0; mi < 2; ++mi)
#pragma unroll
    for (int ni = 0; ni < 8; ++ni) {
      const int c = ni * 16 + (lane & 15);
      const int p0 = 32 * w + 16 * mi + (lane >> 4) * 4;
      const float4 u = *(const float4*)(p.PROJT + (size_t)(3072 + h * 128 + c) * TS + n * 128 + p0);
      const float uu[4] = {u.x, u.y, u.z, u.w};
#pragma unroll
      for (int j = 0; j < 4; ++j) {
        const int pp = p0 + j;
        const float s = acc[mi][ni][j] + p.gm_bs[h * 128 + pp];
        p.ABUF1[(size_t)(n * 128 + pp) * DM + 1024 + h * 128 + c] = f2bf(uu[j] * s);
      }
    }
  __syncthreads();
}

#define BF8(dst, o, q) dst[o + 0] = bflo(q.x); dst[o + 1] = bfhi(q.x); dst[o + 2] = bflo(q.y); dst[o + 3] = bfhi(q.y); \
                       dst[o + 4] = bflo(q.z); dst[o + 5] = bfhi(q.z); dst[o + 6] = bflo(q.w); dst[o + 7] = bfhi(q.w);
template <int LAST>
__device__ __forceinline__ void ph_peer(const P& p, int layer, int ntok, char* smem, int bid, int nb) {
  const int tid = tid_local();
  const int lane = tid & 63, w = tid >> 6;
  int* sExp = (int*)smem + w * 32;
  float* sGate = (float*)(smem + 512) + w * 32;
  uint32_t* LL = (uint32_t*)(smem + 1024) + w * 128;
  float* sPart = (float*)(smem + 4096);
  float* sRed = (float*)(smem + 4096 + 32768);
  const unsigned char* UBl = p.UB + (size_t)layer * 16384 * ROWB;
  const unsigned char* VBl = p.VB + (size_t)layer * 16384 * ROWB;
  const float* SUl = p.SU + layer * 16384;
  const float* SVl = p.SV + layer * 16384;
  const bf16_t* HP = LAST ? p.ABUF1 : p.ABUF0;
  int pi_ = 0, pj_ = 0;
  {
    int rem = lane;
    bool found = false;
#pragma unroll
    for (int ii = 0; ii < 16; ++ii) {
      const int nn = 16 / (ii + 1);
      if (!found && rem < nn) { pi_ = ii; pj_ = rem; found = true; }
      if (!found) rem -= nn;
    }
  }
  const bool pvalid_ = lane < 50;
  float scv[8];
  if (bid < ntok) {
    const float* sp = p.SC + (size_t)bid * DM + w * 512 + lane;
#pragma unroll
    for (int k = 0; k < 8; ++k) scv[k] = sp[k * 64];
  }
  for (int t = bid; t < ntok; t += nb) {
    for (int rep_ = 0; rep_ < REP_TOPK; ++rep_) {
      uint32_t key[4][2], prefix[4];
      int need[4];
#pragma unroll
      for (int g = 0; g < 4; ++g) {
        key[g][0] = (((fkey(scv[g * 2 + 0]) + 0x2000u) >> 14) << 7) | (uint32_t)lane;
        key[g][1] = (((fkey(scv[g * 2 + 1]) + 0x2000u) >> 14) << 7) | (uint32_t)(lane + 64);
        prefix[g] = 0u; need[g] = 16;
      }
#pragma unroll 4
      for (int bit = 24; bit >= 0; --bit) {
        const uint32_t mh = ~((1u << bit) - 1u);
#pragma unroll
        for (int g = 0; g < 4; ++g) {
          const uint32_t cand = prefix[g] | (1u << bit);
          const int c = __popcll(__ballot((key[g][0] & mh) == cand)) + __popcll(__ballot((key[g][1] & mh) == cand));
          const bool ge_ = c >= need[g];
          prefix[g] = ge_ ? cand : prefix[g];
          need[g] = ge_ ? need[g] : need[g] - c;
        }
      }
#pragma unroll
      for (int g = 0; g < 4; ++g) {
        const bool q0 = key[g][0] >= prefix[g], q1 = key[g][1] >= prefix[g];
        const unsigned long long b0 = __ballot(q0), b1 = __ballot(q1);
        const int r0 = __builtin_amdgcn_mbcnt_hi((unsigned)(b0 >> 32), __builtin_amdgcn_mbcnt_lo((unsigned)b0, 0u));
        const int r1 = __popcll(b0) + __builtin_amdgcn_mbcnt_hi((unsigned)(b1 >> 32), __builtin_amdgcn_mbcnt_lo((unsigned)b1, 0u));
        uint32_t* Ls = LL + (g >> 1) * 48 + (g & 1) * 16;
        if (q0) Ls[r0 & 15] = key[g][0];
        if (q1) Ls[r1 & 15] = key[g][1];
      }
      {
        uint32_t* Lg = LL + (lane >> 5) * 48 + ((lane >> 4) & 1) * 16;
        const uint32_t my = Lg[lane & 15];
        int rk = 0;
#pragma unroll
        for (int k = 0; k < 16; ++k) rk += (Lg[k] > my) ? 1 : 0;
        Lg[rk] = my;
      }
      uint32_t pk[2], cpre[2];
      int cneed[2];
#pragma unroll
      for (int hh = 0; hh < 2; ++hh) {
        const float s0 = funkey((LL[hh * 48 + pi_] >> 7) << 14);
        const float s1 = funkey((LL[hh * 48 + 16 + pj_] >> 7) << 14);
        pk[hh] = pvalid_ ? ((((fkey(s0 + s1) + 0x2000u) >> 14) << 8) | (uint32_t)(pi_ * 16 + pj_)) : 0u;
        cpre[hh] = 0u; cneed[hh] = 16;
      }
#pragma unroll 4
      for (int bit = 25; bit >= 0; --bit) {
        const uint32_t mh = ~((1u << bit) - 1u);
#pragma unroll
        for (int hh = 0; hh < 2; ++hh) {
          const uint32_t cand = cpre[hh] | (1u << bit);
          const int c = __popcll(__ballot((pk[hh] & mh) == cand));
          const bool ge_ = c >= cneed[hh];
          cpre[hh] = ge_ ? cand : cpre[hh];
          cneed[hh] = ge_ ? cneed[hh] : cneed[hh] - c;
        }
      }
#pragma unroll
      for (int hh = 0; hh < 2; ++hh) {
        uint32_t* L0 = LL + hh * 48;
        uint32_t* L1 = L0 + 16;
        uint32_t* L2 = L0 + 32;
        {
          const bool q = pk[hh] >= cpre[hh] && pk[hh] != 0u;
          const unsigned long long bq = __ballot(q);
          const int r = __builtin_amdgcn_mbcnt_hi((unsigned)(bq >> 32), __builtin_amdgcn_mbcnt_lo((unsigned)bq, 0u));
          if (q) L2[r & 15] = pk[hh];
        }
        const uint32_t mine = L2[lane & 15];
        const int cidx = (int)(mine & 255u);
        const float cv = funkey((mine >> 8) << 14);
        const int ia = (int)(L0[(cidx >> 4) & 15] & 127u);
        const int ib = (int)(L1[cidx & 15] & 127u);
        float mx = cv;
#pragma unroll
        for (int o = 8; o >= 1; o >>= 1) mx = fmaxf(mx, __shfl_xor(mx, o));
        const float ev = __expf(cv - mx);
        float sum = ev;
#pragma unroll
        for (int o = 8; o >= 1; o >>= 1) sum += __shfl_xor(sum, o);
        if (lane < 16) {
          sExp[hh * 16 + lane] = ia * 128 + ib;
          sGate[hh * 16 + lane] = ev / sum;
        }
      }
    }
    if (t + nb < ntok) {
      const float* sp = p.SC + (size_t)(t + nb) * DM + w * 512 + lane;
#pragma unroll
      for (int k = 0; k < 8; ++k) scv[k] = sp[k * 64];
    }
    u32x4 xq[4];
    {
      const u32x4* xr = (const u32x4*)(HP + (size_t)t * DM) + lane * 4;
#pragma unroll
      for (int q = 0; q < 4; ++q) xq[q] = xr[q];
    }
    float acc[32];
#pragma unroll
    for (int i = 0; i < 32; ++i) acc[i] = 0.f;
    u32x2 ub[2][3], vb[2][3];
    int ex[2], exn[2];
#pragma unroll
    for (int e = 0; e < 2; ++e) {
      exn[e] = __builtin_amdgcn_readfirstlane(sExp[e]);
      const u32x2* ur = (const u32x2*)(UBl + (size_t)exn[e] * ROWB) + lane;
#pragma unroll
      for (int jc = 0; jc < 3; ++jc) ub[e][jc] = ur[jc * 64];
    }
#pragma unroll 1
    for (int eb = 0; eb < 32; eb += 2) {
      float d[2];
#pragma unroll
      for (int e = 0; e < 2; ++e) {
        ex[e] = exn[e];
        v6u pk;
        pk[0] = ub[e][0].x; pk[1] = ub[e][0].y; pk[2] = ub[e][1].x; pk[3] = ub[e][1].y; pk[4] = ub[e][2].x; pk[5] = ub[e][2].y;
        const v32f uu = __builtin_amdgcn_cvt_scalef32_pk32_f32_fp6(pk, 1.0f);
        float sdot = 0.f;
#pragma unroll
        for (int q = 0; q < 4; ++q) {
          sdot += bflo(xq[q].x) * uu[q * 8 + 0] + bfhi(xq[q].x) * uu[q * 8 + 1] + bflo(xq[q].y) * uu[q * 8 + 2] + bfhi(xq[q].y) * uu[q * 8 + 3] +
                  bflo(xq[q].z) * uu[q * 8 + 4] + bfhi(xq[q].z) * uu[q * 8 + 5] + bflo(xq[q].w) * uu[q * 8 + 6] + bfhi(xq[q].w) * uu[q * 8 + 7];
        }
        d[e] = sdot;
        __builtin_amdgcn_sched_barrier(0);
      }
#pragma unroll
      for (int e = 0; e < 2; ++e) {
        const u32x2* vr = (const u32x2*)(VBl + (size_t)ex[e] * ROWB) + lane;
#pragma unroll
        for (int jc = 0; jc < 3; ++jc) vb[e][jc] = vr[jc * 64];
      }
      if (eb + 2 < 32) {
#pragma unroll
        for (int e = 0; e < 2; ++e) {
          exn[e] = __builtin_amdgcn_readfirstlane(sExp[eb + 2 + e]);
          const u32x2* ur = (const u32x2*)(UBl + (size_t)exn[e] * ROWB) + lane;
#pragma unroll
          for (int jc = 0; jc < 3; ++jc) ub[e][jc] = ur[jc * 64];
        }
      }
#pragma unroll
      for (int o = 32; o >= 1; o >>= 1) {
#pragma unroll
        for (int e = 0; e < 2; ++e) d[e] += __shfl_xor(d[e], o);
      }
#pragma unroll
      for (int e = 0; e < 2; ++e) {
        const float wg = sGate[eb + e] * gelu_f(d[e] * SUl[ex[e]]) * SVl[ex[e]];
        v6u pk;
        pk[0] = vb[e][0].x; pk[1] = vb[e][0].y; pk[2] = vb[e][1].x; pk[3] = vb[e][1].y; pk[4] = vb[e][2].x; pk[5] = vb[e][2].y;
        const v32f vv = __builtin_amdgcn_cvt_scalef32_pk32_f32_fp6(pk, 1.0f);
#pragma unroll
        for (int k = 0; k < 32; ++k) acc[k] += wg * vv[k];
        __builtin_amdgcn_sched_barrier(0);
      }
    }
    {
      float* dst = sPart + w * 2048 + lane * 32;
#pragma unroll
      for (int q = 0; q < 8; ++q) *(float4*)(dst + q * 4) = make_float4(acc[q * 4 + 0], acc[q * 4 + 1], acc[q * 4 + 2], acc[q * 4 + 3]);
    }
    __syncthreads();
    const int d0 = tid * 8;
    float r[8];
    {
      float4 a = *(const float4*)(sPart + d0), b = *(const float4*)(sPart + d0 + 4);
#pragma unroll
      for (int ww = 1; ww < 4; ++ww) {
        const float4 a2 = *(const float4*)(sPart + ww * 2048 + d0), b2 = *(const float4*)(sPart + ww * 2048 + d0 + 4);
        a.x += a2.x; a.y += a2.y; a.z += a2.z; a.w += a2.w; b.x += b2.x; b.y += b2.y; b.z += b2.z; b.w += b2.w;
      }
      r[0] = a.x; r[1] = a.y; r[2] = a.z; r[3] = a.w; r[4] = b.x; r[5] = b.y; r[6] = b.z; r[7] = b.w;
    }
    const int which = (t < TX) ? 0 : 1;
    const float* md = p.MOD + (size_t)(layer * 2 + which) * 12288;
    float* xrow = p.XA + (size_t)t * DM;
    float ss = 0.f;
#pragma unroll
    for (int hq = 0; hq < 2; ++hq) {
      const float4 xv = *(const float4*)(xrow + d0 + hq * 4);
      const float4 g2 = *(const float4*)(md + 5 * DM + d0 + hq * 4);
      float4 o;
      o.x = xv.x + g2.x * r[hq * 4 + 0]; o.y = xv.y + g2.y * r[hq * 4 + 1];
      o.z = xv.z + g2.z * r[hq * 4 + 2]; o.w = xv.w + g2.w * r[hq * 4 + 3];
      r[hq * 4 + 0] = o.x; r[hq * 4 + 1] = o.y; r[hq * 4 + 2] = o.z; r[hq * 4 + 3] = o.w;
      ss += o.x * o.x + o.y * o.y + o.z * o.z + o.w * o.w;
      if (!LAST) *(float4*)(xrow + d0 + hq * 4) = o;
    }
    ss = wave_sum(ss);
    if (lane == 0) sRed[w] = ss;
    __syncthreads();
    const float rstd = rsqrtf((sRed[0] + sRed[1] + sRed[2] + sRed[3]) * (1.f / DM) + 1e-6f);
    if (LAST) {
      float* orow = p.out + (size_t)t * DM;
#pragma unroll
      for (int hq = 0; hq < 2; ++hq) {
        const float4 g = *(const float4*)(p.norm_final + d0 + hq * 4);
        float4 o;
        o.x = r[hq * 4 + 0] * rstd * g.x; o.y = r[hq * 4 + 1] * rstd * g.y; o.z = r[hq * 4 + 2] * rstd * g.z; o.w = r[hq * 4 + 3] * rstd * g.w;
        *(float4*)(orow + d0 + hq * 4) = o;
      }
    } else {
      const float* md1 = p.MOD + (size_t)(2 + which) * 12288;
      const float* gn = p.norm_mix + DM;
      uint32_t o[4];
#pragma unroll
      for (int hq = 0; hq < 2; ++hq) {
        const float4 g = *(const float4*)(gn + d0 + hq * 4);
        const float4 sh = *(const float4*)(md1 + 0 * DM + d0 + hq * 4);
        const float4 sc = *(const float4*)(md1 + 1 * DM + d0 + hq * 4);
        const float y0 = r[hq * 4 + 0] * rstd * g.x * (1.f + sc.x) + sh.x;
        const float y1 = r[hq * 4 + 1] * rstd * g.y * (1.f + sc.y) + sh.y;
        const float y2 = r[hq * 4 + 2] * rstd * g.z * (1.f + sc.z) + sh.z;
        const float y3 = r[hq * 4 + 3] * rstd * g.w * (1.f + sc.w) + sh.w;
        o[hq * 2 + 0] = pack2(y0, y1); o[hq * 2 + 1] = pack2(y2, y3);
      }
      *(u32x4*)(p.ABUF1 + (size_t)t * DM + d0) = mk4(o[0], o[1], o[2], o[3]);
    }
    __syncthreads();
  }
}

__device__ __forceinline__ void ph_scores(const P& p, int ph, char* smem, int bid, int nb) {
  const int tid = tid_local(), lane = tid & 63, wid = tid >> 6, wr = wid >> 1, wc = wid & 1;
        const int layer = (ph == 7) ? 0 : 1;
        const int numM = (ph == 7) ? 66 : 64;
        bf16_t* sA = (bf16_t*)smem;
        bf16_t* sB = sA + 128 * LDS_S;
        for (int id = bid; id < numM * 16; id += nb) {
          const int mt = id % numM, hs = id / numM;
          f32x4 acc[4][4];
          gemm_core(acc, p.QB + (size_t)mt * 128 * DM + hs * 128, DM, p.KEYB + (size_t)(layer * 16 + hs) * 128 * 128, 128, 128, sA, sB);
#pragma unroll
          for (int mi = 0; mi < 4; ++mi)
#pragma unroll
            for (int ni = 0; ni < 4; ++ni)
#pragma unroll
              for (int j = 0; j < 4; ++j) {
                const int row = mt * 128 + wr * 64 + mi * 16 + (lane >> 4) * 4 + j;
                const int col = wc * 64 + ni * 16 + (lane & 15);
                p.SC[(size_t)row * DM + hs * 128 + col] = acc[mi][ni][j];
              }
        }
}

__device__ __forceinline__ void ph_qscores(const P& p, int layer, int M, char* smem, int bid, int nb) {
  const int tid = tid_local(), lane = tid & 63, wid = tid >> 6, wr = wid >> 1, wc = wid & 1;
  bf16_t* sA = (bf16_t*)smem;
  bf16_t* sB = sA + 128 * LDS_S;
  bf16_t* sQ = (bf16_t*)smem;
  const bf16_t* A = layer ? p.ABUF1 : p.ABUF0;
  const bf16_t* W = p.WT_PQ + (size_t)layer * DM * DM;
  const int numM = M >> 7, numN = 16, total = numM * numN;
  const int vb = ((nb & 7) == 0) ? (bid & 7) * (nb >> 3) + (bid >> 3) : bid;
  for (int id = vb; id < total; id += nb) {
    const int gsz = 8 * numN, g = id / gsz, fm = g * 8;
    const int rows = (numM - fm) < 8 ? (numM - fm) : 8;
    const int r = id - g * gsz;
    const int mt = fm + r % rows, nt = r / rows;
    f32x4 acc[4][4];
    gemm_core_t<4>(acc, A + (size_t)mt * 128 * DM, DM, W + (size_t)nt * 128 * DM, DM, DM, sA, sB);
    __syncthreads();
#pragma unroll
    for (int mi = 0; mi < 4; ++mi)
#pragma unroll
      for (int ni = 0; ni < 4; ++ni)
#pragma unroll
        for (int j = 0; j < 4; ++j)
          sQ[(wr * 64 + mi * 16 + (lane >> 4) * 4 + j) * 136 + wc * 64 + ni * 16 + (lane & 15)] = f2bf(acc[mi][ni][j]);
    __syncthreads();
    const bf16_t* Kb = p.KEYB + (size_t)(layer * 16 + nt) * 128 * 128;
    f32x4 acc2[4][4];
#pragma unroll
    for (int mi = 0; mi < 4; ++mi)
#pragma unroll
      for (int ni = 0; ni < 4; ++ni) acc2[mi][ni] = (f32x4){0.f, 0.f, 0.f, 0.f};
#pragma unroll
    for (int ks = 0; ks < 4; ++ks) {
      bf16x8 af[4], bk[4];
#pragma unroll
      for (int mi = 0; mi < 4; ++mi) af[mi] = *(const bf16x8*)(sQ + (wr * 64 + mi * 16 + (lane & 15)) * 136 + ks * 32 + (lane >> 4) * 8);
#pragma unroll
      for (int ni = 0; ni < 4; ++ni) bk[ni] = *(const bf16x8*)(Kb + (wc * 64 + ni * 16 + (lane & 15)) * 128 + ks * 32 + (lane >> 4) * 8);
#pragma unroll
      for (int mi = 0; mi < 4; ++mi)
#pragma unroll
        for (int ni = 0; ni < 4; ++ni)
          acc2[mi][ni] = __builtin_amdgcn_mfma_f32_16x16x32_bf16(af[mi], bk[ni], acc2[mi][ni], 0, 0, 0);
    }
#pragma unroll
    for (int mi = 0; mi < 4; ++mi)
#pragma unroll
      for (int ni = 0; ni < 4; ++ni)
#pragma unroll
        for (int j = 0; j < 4; ++j)
          p.SC[(size_t)(mt * 128 + wr * 64 + mi * 16 + (lane >> 4) * 4 + j) * DM + nt * 128 + wc * 64 + ni * 16 + (lane & 15)] = acc2[mi][ni][j];
  }
}

#define XB_TMO      128
#define XB_XCNT(j)  (256  + 64 * (j))
#define XB_XSUB(j)  (1280 + 64 * (j))
#define XB_XGEN(j)  (2304 + 64 * (j))
#define XB_TOP      3328
#define XB_TOPGEN   3392
#define XCD_BAR_WORDS 3456
#define XB_SPIN_CAP (1u << 22)
#define LAS __attribute__((address_space(3)))
__device__ __forceinline__ unsigned xb_ld(unsigned* p)              { return __hip_atomic_load(p, __ATOMIC_RELAXED, __HIP_MEMORY_SCOPE_AGENT); }
__device__ __forceinline__ unsigned xb_add(unsigned* p, unsigned v) { return __hip_atomic_fetch_add(p, v, __ATOMIC_RELAXED, __HIP_MEMORY_SCOPE_AGENT); }
__device__ __forceinline__ unsigned xb_xcc_id() { return (unsigned)__builtin_amdgcn_s_getreg((3 << 11) | 20) & 0xFu; }
#define XB_SPIN(cond, bar) do { unsigned _sp = 0; while (cond) { __builtin_amdgcn_s_sleep(1); \
    if ((++_sp & 255u) == 0u) { if (xb_ld(&(bar)[XB_TMO])) break; if (_sp > XB_SPIN_CAP) { atomicAdd(&(bar)[XB_TMO], 1u); break; } } } } while (0)
struct XcdBarrier { unsigned* bar; unsigned x; volatile LAS unsigned* st; };
__device__ __forceinline__ XcdBarrier xcd_barrier_post(unsigned* bar, volatile LAS unsigned* st) {
  XcdBarrier b; b.bar = bar; b.x = xb_xcc_id(); b.st = st;
  if (tid_local() == 0) (void)xb_add(&bar[XB_XCNT(b.x)], 1u);
  return b;
}
__device__ __forceinline__ void xcd_barrier_complete(unsigned* bar, unsigned x, unsigned& nloc, unsigned& nx, unsigned G) {
  unsigned sum, cnt, mine, sp = 0u;
  for (;;) {
    sum = 0u; cnt = 0u; mine = 0u;
#pragma unroll
    for (unsigned j = 0; j < 16; ++j) { const unsigned c = xb_ld(&bar[XB_XCNT(j)]); sum += c; cnt += (c > 0u) ? 1u : 0u; mine = (j == x) ? c : mine; }
    if (sum == G) break;
    __builtin_amdgcn_s_sleep(1);
    if ((++sp & 255u) == 0u) { if (xb_ld(&bar[XB_TMO])) break; if (sp > XB_SPIN_CAP) { atomicAdd(&bar[XB_TMO], 1u); break; } }
  }
  nloc = mine > 0u ? mine : 1u; nx = cnt > 0u ? cnt : 1u;
}
__device__ __forceinline__ void xcd_barrier_impl(unsigned* bar, unsigned x, volatile LAS unsigned* st, int tid_, unsigned G_) {
  asm volatile("s_waitcnt vmcnt(0)" ::: "memory");
  __syncthreads();
  if (tid_ == 0) {
    __builtin_amdgcn_s_waitcnt(0);
    const unsigned nloc = st[0], nx = st[1];
    const unsigned old = xb_add(&bar[XB_XSUB(x)], 1u);
    const unsigned gen = old / nloc;
    if (old + 1u == (gen + 1u) * nloc) {
      __builtin_amdgcn_fence(__ATOMIC_RELEASE, "agent");
      asm volatile("s_waitcnt vmcnt(0)" ::: "memory");
      const unsigned og = xb_add(&bar[XB_TOP], 1u);
      const unsigned tg = og / nx;
      if (og + 1u == (tg + 1u) * nx) xb_add(&bar[XB_TOPGEN], 1u);
      else XB_SPIN(xb_ld(&bar[XB_TOPGEN]) == tg, bar);
      __builtin_amdgcn_fence(__ATOMIC_ACQUIRE, "agent");
      xb_add(&bar[XB_XGEN(x)], 1u);
      asm volatile("s_waitcnt vmcnt(0)" ::: "memory");
    } else {
      XB_SPIN(xb_ld(&bar[XB_XGEN(x)]) == gen, bar);
      __builtin_amdgcn_fence(__ATOMIC_ACQUIRE, "agent");
      asm volatile("s_waitcnt vmcnt(0)" ::: "memory");
    }
  }
  __syncthreads();
}

template <bool COOP>
__global__ void __launch_bounds__(256, 2) mega(P p, int ph_lo, int ph_hi) {
  __shared__ __attribute__((aligned(16))) char smem[61424];
  const int bid = blockIdx.x, nb = gridDim.x;
  const int tid0 = tid_local();
#define PH_IDS int tid = tid_local(); const int lane = tid & 63, wid = tid >> 6, wr = wid >> 1, wc = wid & 1; (void)lane; (void)wr; (void)wc;
  if constexpr (COOP) { if (ph_hi < 0) cg::this_grid().sync(); }
  __shared__ uint4 xb_words;
  XcdBarrier xb;
  xb.bar = p.BAR; xb.x = 0u; xb.st = (volatile LAS unsigned*)&xb_words;
  if constexpr (COOP) {
    if (tid0 == 0) { xb.st[0] = 0u; xb.st[1] = 0u; }
    __syncthreads();
    xb = xcd_barrier_post(p.BAR, (volatile LAS unsigned*)&xb_words);
    if (tid0 == 0) {
      unsigned nloc = 1u, nx = 1u;
      xcd_barrier_complete(p.BAR, xb.x, nloc, nx, (unsigned)nb);
      xb.st[0] = nloc; xb.st[1] = nx;
    }
    __syncthreads();
  }
  {
    {
      if (PHON(0) && ph_lo <= 0 && 0 < ph_hi) { const int ph = 0; (void)ph;
        PH_IDS
        for (int rep_ = 0; rep_ < REP_P0; ++rep_) {
        ph_ada(p, smem, bid, nb, 0);
        ph_h2(p, smem, bid, nb);
        transpose_job(p.hy_w3, p.W3T, 64, 4096, 1, smem, bid, nb);
        transpose_job(p.ev_w_in, p.WT_EVIN, 2048, 5120, 1, smem, bid, nb);
        transpose_job(p.ev_w_out, p.WT_EVOUT, 2048, 2048, 1, smem, bid, nb);
        transpose_job(p.peer_q, p.WT_PQ, 2048, 2048, 1, smem, bid, nb);
        ph_small_convert(p, bid, nb);
        }
        if constexpr (COOP) if (ph + 1 < ph_hi) xcd_barrier_impl(xb.bar, xb.x, xb.st, (int)tid_local(), (unsigned)nb);
      }
      if (PHON(1) && ph_lo <= 1 && 1 < ph_hi) { const int ph = 1; (void)ph;
        PH_IDS
        for (int rep_ = 0; rep_ < REP_GEMM; ++rep_) {
        ph_norm(p.x, p.ctx, TS, p.norm_mix, p.MOD, p.MOD + 12288, 0, 1, p.ABUF0, bid, nb);
        gemm_phase(p.H2B, 64, p.W3T, 64, TS, 4096, 64, smem, bid, nb, [&](int row0, int col, f32x4 v) {
          const float ad = fabsf(p.hy_deltas[col]);
          float o[4];
#pragma unroll
          for (int j = 0; j < 4; ++j) {
            const int row = row0 + j;
            const float tn = row < TX ? (float)row * (1.f / 8191.f) : (float)(row - TX) * (1.f / 255.f);
            o[j] = v[j] * __expf(-tn * ad);
          }
          *(u32x2*)(p.FILT + (size_t)col * TS + row0) = mk2(pack2(o[0], o[1]), pack2(o[2], o[3]));
        });
        }
        if constexpr (COOP) if (ph + 1 < ph_hi) xcd_barrier_impl(xb.bar, xb.x, xb.st, (int)tid_local(), (unsigned)nb);
      }
      if (PHON(2) && ph_lo <= 2 && 2 < ph_hi) { const int ph = 2; (void)ph;
        PH_IDS
        for (int rep_ = 0; rep_ < REP_GEMM; ++rep_) {
        gemm_phase(p.ABUF0, DM, p.WT_EVIN, DM, TS, 5120, DM, smem, bid, nb, [&](int row0, int col, f32x4 v) {
          float4 o;
          if (col < 3072) { o.x = v[0]; o.y = v[1]; o.z = v[2]; o.w = v[3]; }
          else { o.x = gelu_f(v[0]); o.y = gelu_f(v[1]); o.z = gelu_f(v[2]); o.w = gelu_f(v[3]); }
          *(float4*)(p.PROJT + (size_t)col * TS + row0) = o;
        });
        }
        if constexpr (COOP) if (ph + 1 < ph_hi) xcd_barrier_impl(xb.bar, xb.x, xb.st, (int)tid_local(), (unsigned)nb);
      }
      if (PHON(3) && ph_lo <= 3 && 3 < ph_hi) { const int ph = 3; (void)ph;
        PH_IDS
        for (int rep_ = 0; rep_ < REP_P3; ++rep_) {
        const bool conv_first = ((bid / (nb >> 1)) & 1) != 0;
#define LATE_PREP() { ph_tables(p, bid, nb); __syncthreads(); ph_ada(p, smem, bid, nb, 1); \
          transpose_job(p.od_w_in, p.WT_ODIN, 2048, 3072, 1, smem, bid, nb); \
          transpose_job(p.od_w_out, p.WT_ODOUT, 2048, 2048, 1, smem, bid, nb); \
          transpose_job(p.peer_q + (size_t)DM * DM, p.WT_PQ + (size_t)DM * DM, 2048, 2048, 1, smem, bid, nb); \
          transpose_job(p.pool_w, p.WTPOOL, 256, 256, 4, smem, bid, nb); __syncthreads(); }
        if (conv_first) LATE_PREP()
        for (int item = bid; item < 2048 + 528; item += nb) {
          if (item < 1024) hyena_item<0>(p, smem, item);
          else if (item < 2048) hyena_item<1>(p, smem, item - 1024);
          else gmlp_item(p, smem, (item - 2048) >> 3, (item - 2048) & 7);
        }
        if (!conv_first) LATE_PREP()
        }
        if constexpr (COOP) if (ph + 1 < ph_hi) xcd_barrier_impl(xb.bar, xb.x, xb.st, (int)tid_local(), (unsigned)nb);
      }
      if (PHON(4) && ph_lo <= 4 && 4 < ph_hi) { const int ph = 4; (void)ph;
        PH_IDS
        for (int rep_ = 0; rep_ < REP_GEMM; ++rep_) {
        gemm_phase(p.ABUF1, DM, p.WT_EVOUT, DM, TS, DM, DM, smem, bid, nb, [&](int row0, int col, f32x4 v) {
#pragma unroll
          for (int j = 0; j < 4; ++j) {
            const int row = row0 + j;
            const float base = row < TX ? p.x[(size_t)row * DM + col] : p.ctx[(size_t)(row - TX) * DM + col];
            const float g = p.MOD[(size_t)(row < TX ? 0 : 1) * 12288 + 2 * DM + col];
            p.XA[(size_t)row * DM + col] = base + g * v[j];
          }
        });
        }
        if constexpr (COOP) if (ph + 1 < ph_hi) xcd_barrier_impl(xb.bar, xb.x, xb.st, (int)tid_local(), (unsigned)nb);
      }
      if (PHON(5) && ph_lo <= 5 && 5 < ph_hi) { const int ph = 5; (void)ph;
        PH_IDS
        ph_norm(p.XA, p.XA + (size_t)TX * DM, TS, p.norm_ffn, p.MOD, p.MOD + 12288, 3, 4, p.ABUF0, bid, nb);
        if constexpr (COOP) if (ph + 1 < ph_hi) xcd_barrier_impl(xb.bar, xb.x, xb.st, (int)tid_local(), (unsigned)nb);
      }
      if (PHON(6) && ph_lo <= 6 && 6 < ph_hi) { const int ph = 6; (void)ph;
        ph_qscores(p, 0, TS, smem, bid, nb);
        if constexpr (COOP) if (ph + 1 < ph_hi) xcd_barrier_impl(xb.bar, xb.x, xb.st, (int)tid_local(), (unsigned)nb);
      }
      if (PHON(8) && ph_lo <= 8 && 8 < ph_hi) { const int ph = 8; (void)ph;
        PH_IDS
        ph_peer<0>(p, 0, TS, smem, bid, nb);
        if constexpr (COOP) if (ph + 1 < ph_hi) xcd_barrier_impl(xb.bar, xb.x, xb.st, (int)tid_local(), (unsigned)nb);
      }
      if (PHON(9) && ph_lo <= 9 && 9 < ph_hi) { const int ph = 9; (void)ph;
        PH_IDS
        for (int rep_ = 0; rep_ < REP_GEMM; ++rep_) {
        gemm_phase(p.ABUF1, DM, p.WT_ODIN, DM, TS, 3072, DM, smem, bid, nb, [&](int row0, int col, f32x4 v) {
#pragma unroll
          for (int j = 0; j < 4; ++j) p.PROJ1[(size_t)(row0 + j) * 3072 + col] = (col < 1024) ? gelu_f(v[j]) : v[j];
        });
        }
        if constexpr (COOP) if (ph + 1 < ph_hi) xcd_barrier_impl(xb.bar, xb.x, xb.st, (int)tid_local(), (unsigned)nb);
      }
      if (PHON(10) && ph_lo <= 10 && 10 < ph_hi) { const int ph = 10; (void)ph;
        PH_IDS
        for (int rep_ = 0; rep_ < REP_L1S; ++rep_) {
        for (int idx = bid * 256 + tid; idx < TS * 256; idx += nb * 256) {
          const int t = idx >> 8, c4 = (idx & 255) * 4;
          const int lo = t < TX ? 0 : TX, hi = t < TX ? TX : TS;
          float4 a = *(const float4*)(p.od_conv_b + c4);
#pragma unroll
          for (int k = 0; k < 4; ++k) {
            const int tt = t + k - 1;
            if (tt >= lo && tt < hi) {
              const float4 xv = *(const float4*)(p.PROJ1 + (size_t)tt * 3072 + 1024 + c4);
              const float4 wv = *(const float4*)(p.od_conv_w + k * 1024 + c4);
              a.x += wv.x * xv.x; a.y += wv.y * xv.y; a.z += wv.z * xv.z; a.w += wv.w * xv.w;
            }
          }
          *(float4*)(p.XR + (size_t)t * 1024 + c4) = a;
          *(u32x2*)(p.XRB + (size_t)t * 1024 + c4) = mk2(pack2(a.x, a.y), pack2(a.z, a.w));
        }
        for (int idx = bid * 256 + tid; idx < TX * 256; idx += nb * 256) {
          const int t = idx >> 8, c4 = (idx & 255) * 4;
          const int half = 1 << (c4 >> 8);
          const int lo = (t - half) < 0 ? 0 : (t - half);
          const int hi = (t + half) > TX ? TX : (t + half);
          float4 s = make_float4(0.f, 0.f, 0.f, 0.f);
          for (int q = lo; q < hi; ++q) {
            const float4 xv = *(const float4*)(p.PROJ1 + (size_t)q * 3072 + 2048 + c4);
            s.x += xv.x; s.y += xv.y; s.z += xv.z; s.w += xv.w;
          }
          const float inv = 1.f / (float)(hi - lo);
          const float4 x0 = *(const float4*)(p.PROJ1 + (size_t)t * 3072 + 2048 + c4);
          *(u32x2*)(p.PD + (size_t)t * 1024 + c4) = mk2(pack2(s.x * inv - x0.x, s.y * inv - x0.y), pack2(s.z * inv - x0.z, s.w * inv - x0.w));
        }
        }
        if constexpr (COOP) if (ph + 1 < ph_hi) xcd_barrier_impl(xb.bar, xb.x, xb.st, (int)tid_local(), (unsigned)nb);
      }
      if (PHON(11) && ph_lo <= 11 && 11 < ph_hi) { const int ph = 11; (void)ph;
        PH_IDS
        for (int rep_ = 0; rep_ < REP_L1S; ++rep_) {
        bf16_t* sA = (bf16_t*)smem;
        bf16_t* sB = sA + 128 * LDS_S;
        for (int id = bid; id < 2112 + 512; id += nb) {
          f32x4 acc[4][4];
          if (id < 2112) {
            const int mt = id % 66, g = id / 66, dir = g >> 4, hh = g & 15, h = hh >> 1, half = hh & 1;
            gemm_core(acc, p.XRB + (size_t)mt * 128 * 1024 + h * 128, 1024, p.WG + (size_t)(dir * 16 + hh) * 128 * 128, 128, 128, sA, sB);
#pragma unroll
            for (int gq = 0; gq < 2; ++gq) {
              const int c = h * 128 + half * 64 + (wc * 2 + gq) * 16 + (lane & 15);
              const float ba = p.lru_ba[dir * 1024 + c], bx = p.lru_bx[dir * 1024 + c];
              const float sp = log1pf(expf(-p.lru_lam[dir * 1024 + c]));
#pragma unroll
              for (int mi = 0; mi < 4; ++mi)
#pragma unroll
                for (int j = 0; j < 4; ++j) {
                  const int t = mt * 128 + wr * 64 + mi * 16 + (lane >> 4) * 4 + j;
                  const float r = sigmoid_f(acc[mi][2 * gq][j] + ba);
                  const float ii = sigmoid_f(acc[mi][2 * gq + 1][j] + bx);
                  const float la = -8.f * r * sp;
                  const float a = expf(la);
                  const float b = sqrtf(-expm1f(2.f * la)) * ii * p.XR[(size_t)t * 1024 + c];
                  p.ABA[((size_t)dir * TS + t) * 1024 + c] = a;
                  p.ABB[((size_t)dir * TS + t) * 1024 + c] = b;
                }
            }
          } else {
            const int id2 = id - 2112, mt = id2 & 63, rest = id2 >> 6, g = rest >> 1, nh = rest & 1;
            gemm_core(acc, p.PD + (size_t)mt * 128 * 1024 + g * 256, 1024, p.WTPOOL + (size_t)g * 256 * 256 + (size_t)nh * 128 * 256, 256, 256, sA, sB);
#pragma unroll
            for (int mi = 0; mi < 4; ++mi)
#pragma unroll
              for (int ni = 0; ni < 4; ++ni) {
                const int cc = g * 256 + nh * 128 + wc * 64 + ni * 16 + (lane & 15);
                const float pb = p.pool_b[cc], ps = p.pool_scale[cc];
#pragma unroll
                for (int j = 0; j < 4; ++j) {
                  const int t = mt * 128 + wr * 64 + mi * 16 + (lane >> 4) * 4 + j;
                  p.ABUF0[(size_t)t * DM + 1024 + cc] = f2bf((acc[mi][ni][j] + pb) * ps);
                }
              }
          }
        }
        }
        if constexpr (COOP) if (ph + 1 < ph_hi) xcd_barrier_impl(xb.bar, xb.x, xb.st, (int)tid_local(), (unsigned)nb);
      }
      if (PHON(12) && ph_lo <= 12 && 12 < ph_hi) { const int ph = 12; (void)ph;
        PH_IDS
        for (int rep_ = 0; rep_ < REP_L1S; ++rep_) {
        for (int item = bid; item < 2 * 132 * 4; item += nb) {
          const int dir = item / 528, rem = item % 528, k = rem >> 2, c = (rem & 3) * 256 + tid;
          const float* pa = p.ABA + (size_t)dir * TS * 1024 + c;
          const float* pb = p.ABB + (size_t)dir * TS * 1024 + c;
          float Pp = 1.f, H = 0.f;
#pragma unroll 8
          for (int s = 0; s < 64; ++s) {
            const int t = dir ? (k * 64 + 63 - s) : (k * 64 + s);
            const float a = pa[(size_t)t * 1024], b = pb[(size_t)t * 1024];
            H = a * H + b; Pp *= a;
          }
          p.AGG[(size_t)(dir * 132 + k) * 1024 + c] = make_float2(Pp, H);
        }
        }
        if constexpr (COOP) if (ph + 1 < ph_hi) xcd_barrier_impl(xb.bar, xb.x, xb.st, (int)tid_local(), (unsigned)nb);
      }
      if (PHON(13) && ph_lo <= 13 && 13 < ph_hi) { const int ph = 13; (void)ph;
        PH_IDS
        for (int rep_ = 0; rep_ < REP_L1S; ++rep_) {
        float* hf = (float*)smem;
        for (int item = bid; item < 1024; item += nb) {
          const int k = item >> 3, cb = item & 7, cl = tid & 127, c = cb * 128 + cl, dir = tid >> 7;
          const float2* ag = p.AGG + (size_t)dir * 132 * 1024 + c;
          const int npre = 4 + (dir ? (127 - k) : k);
          float h = 0.f;
#pragma unroll 8
          for (int v = 0; v < npre; ++v) {
            const int q = dir ? (v < 4 ? 131 - v : 131 - v) : (v < 4 ? 128 + v : v - 4);
            const float2 g = ag[(size_t)q * 1024];
            h = g.x * h + g.y;
          }
          const float* pa = p.ABA + (size_t)dir * TS * 1024 + c;
          const float* pb = p.ABB + (size_t)dir * TS * 1024 + c;
          if (dir == 0) {
#pragma unroll 8
            for (int s = 0; s < 64; ++s) {
              const int t = k * 64 + s;
              h = pa[(size_t)t * 1024] * h + pb[(size_t)t * 1024];
              hf[s * 128 + cl] = h;
            }
          }
          __syncthreads();
          if (dir == 1) {
#pragma unroll 8
            for (int s = 63; s >= 0; --s) {
              const int t = k * 64 + s;
              h = pa[(size_t)t * 1024] * h + pb[(size_t)t * 1024];
              const float y = p.PROJ1[(size_t)t * 3072 + c] * (hf[s * 128 + cl] + h);
              p.ABUF0[(size_t)t * DM + c] = f2bf(y);
            }
          }
          __syncthreads();
        }
        }
        if constexpr (COOP) if (ph + 1 < ph_hi) xcd_barrier_impl(xb.bar, xb.x, xb.st, (int)tid_local(), (unsigned)nb);
      }
      if (PHON(14) && ph_lo <= 14 && 14 < ph_hi) { const int ph = 14; (void)ph;
        PH_IDS
        gemm_phase(p.ABUF0, DM, p.WT_ODOUT, DM, TX, DM, DM, smem, bid, nb, [&](int row0, int col, f32x4 v) {
          const float g = p.MOD[(size_t)2 * 12288 + 2 * DM + col];
#pragma unroll
          for (int j = 0; j < 4; ++j) {
            float* d = p.XA + (size_t)(row0 + j) * DM + col;
            *d = *d + g * v[j];
          }
        });
        if constexpr (COOP) if (ph + 1 < ph_hi) xcd_barrier_impl(xb.bar, xb.x, xb.st, (int)tid_local(), (unsigned)nb);
      }
      if (PHON(15) && ph_lo <= 15 && 15 < ph_hi) { const int ph = 15; (void)ph;
        PH_IDS
        ph_norm(p.XA, p.XA + (size_t)TX * DM, TX, p.norm_ffn + DM, p.MOD + 2 * 12288, p.MOD + 3 * 12288, 3, 4, p.ABUF1, bid, nb);
        if constexpr (COOP) if (ph + 1 < ph_hi) xcd_barrier_impl(xb.bar, xb.x, xb.st, (int)tid_local(), (unsigned)nb);
      }
      if (PHON(16) && ph_lo <= 16 && 16 < ph_hi) { const int ph = 16; (void)ph;
        ph_qscores(p, 1, TX, smem, bid, nb);
        if constexpr (COOP) if (ph + 1 < ph_hi) xcd_barrier_impl(xb.bar, xb.x, xb.st, (int)tid_local(), (unsigned)nb);
      }
      if (PHON(18) && ph_lo <= 18 && 18 < ph_hi) { const int ph = 18; (void)ph;
        PH_IDS
        for (int rep_ = 0; rep_ < REP_P18; ++rep_) {
        ph_peer<1>(p, 1, TX, smem, bid, nb);
        }
        if constexpr (COOP) if (ph + 1 < ph_hi) xcd_barrier_impl(xb.bar, xb.x, xb.st, (int)tid_local(), (unsigned)nb);
      }
    }
  }
}

extern "C" void kernel_launch(void* const* d_in, const int* in_sizes, int n_in, void* d_out, int out_size, void* d_ws,
                              size_t ws_size, hipStream_t stream) {
  P p{};
  const float** pin = (const float**)&p;
  for (int i = 0; i < 40; ++i) pin[i] = (const float*)d_in[i];
  p.out = (float*)d_out;
  char* ws = (char*)d_ws;
  size_t off = 0;
  auto alloc = [&](size_t bytes) { char* r = ws + off; off += (bytes + 255) & ~(size_t)255; return r; };
  p.MOD = (float*)alloc(4 * 12288 * 4);
  p.H2B = (bf16_t*)alloc((size_t)TS * 64 * 2);
  p.W3T = (bf16_t*)alloc((size_t)4096 * 64 * 2);
  p.WT_EVIN = (bf16_t*)alloc((size_t)5120 * 2048 * 2);
  p.WT_EVOUT = (bf16_t*)alloc((size_t)2048 * 2048 * 2);
  p.WT_ODIN = (bf16_t*)alloc((size_t)3072 * 2048 * 2);
  p.WT_ODOUT = (bf16_t*)alloc((size_t)2048 * 2048 * 2);
  p.WT_PQ = (bf16_t*)alloc((size_t)2 * 2048 * 2048 * 2);
  p.WG = (bf16_t*)alloc((size_t)2 * 16 * 128 * 128 * 2);
  p.KEYB = (bf16_t*)alloc((size_t)2 * 16 * 128 * 128 * 2);
  p.GMWS = (bf16_t*)alloc((size_t)8 * 128 * 128 * 2);
  p.WTPOOL = (bf16_t*)alloc((size_t)4 * 256 * 256 * 2);
  p.UB = (unsigned char*)alloc((size_t)2 * 16384 * 2048);
  p.VB = (unsigned char*)alloc((size_t)2 * 16384 * 2048);
  p.SU = (float*)alloc((size_t)2 * 16384 * 4);
  p.SV = (float*)alloc((size_t)2 * 16384 * 4);
  p.ABUF0 = (bf16_t*)alloc((size_t)TS * DM * 2);
  p.ABUF1 = (bf16_t*)alloc((size_t)TS * DM * 2);
  {
    char* r1 = alloc((size_t)5120 * TS * 4);
    p.PROJT = (float*)r1;
    p.PROJ1 = (float*)r1;
    p.XR = (float*)(r1 + (size_t)TS * 3072 * 4);
    p.XRB = (bf16_t*)(r1 + (size_t)TS * 3072 * 4 + (size_t)TS * 1024 * 4);
    p.PD = (bf16_t*)(r1 + (size_t)TS * 3072 * 4 + (size_t)TS * 1024 * 4 + (size_t)TS * 1024 * 2);
  }
  {
    char* r2 = alloc((size_t)2 * 2 * TS * 1024 * 4);
    p.FILT = (bf16_t*)r2;
    p.Z1 = (float*)(r2 + (size_t)4096 * TS * 2);
    p.ABA = (float*)r2;
    p.ABB = (float*)(r2 + (size_t)2 * TS * 1024 * 4);
  }
  p.XA = (float*)alloc((size_t)TS * DM * 4);
  p.QB = (bf16_t*)alloc((size_t)TS * DM * 2);
  p.SC = (float*)alloc((size_t)TS * DM * 4);
  p.AGG = (float2*)alloc((size_t)2 * 132 * 1024 * 8);
  p.BAR = (unsigned*)alloc(XCD_BAR_WORDS * 4);
  if (off > ws_size) { fprintf(stderr, "workspace too small: need %zu have %zu\n", off, ws_size); return; }

#if ONE_LAUNCH
  static int grid_blocks = 0;
  if (!grid_blocks) {
    int dev = 0, cus = 0, per_cu = 0;
    hipGetDevice(&dev);
    hipDeviceGetAttribute(&cus, hipDeviceAttributeMultiprocessorCount, dev);
    hipOccupancyMaxActiveBlocksPerMultiprocessor(&per_cu, mega<true>, 256, 0);
    if (per_cu > 2) per_cu = 2;
    grid_blocks = cus * per_cu;
  }
  int lo = 0, hi = NPH;
  void* args[] = {&p, &lo, &hi};
  hipMemsetAsync(p.BAR, 0, XCD_BAR_WORDS * 4, stream);
  hipError_t e = hipLaunchCooperativeKernel((void*)mega<true>, dim3(grid_blocks), dim3(256), args, 0, stream);
  if (e != hipSuccess) fprintf(stderr, "cooperative launch failed: %s (grid %d)\n", hipGetErrorString(e), grid_blocks);
#else
  for (int ph = 0; ph < NPH; ++ph) mega<false><<<512, 256, 0, stream>>>(p, ph, ph + 1);
#endif
}
```

```cpp
#include <hip/hip_runtime.h>
#include <hip/hip_cooperative_groups.h>
#include <stdint.h>
#include <cstdio>
namespace cg = cooperative_groups;

#ifndef ONE_LAUNCH
#define ONE_LAUNCH 1
#endif

typedef unsigned short bf16_t;
using bf16x8 = __attribute__((ext_vector_type(8))) short;
using f32x4 = __attribute__((ext_vector_type(4))) float;
using u32x4 = __attribute__((ext_vector_type(4))) unsigned int;
using u32x2 = __attribute__((ext_vector_type(2))) unsigned int;
__device__ __forceinline__ u32x4 mk4(unsigned a, unsigned b, unsigned c, unsigned d) { u32x4 r; r.x = a; r.y = b; r.z = c; r.w = d; return r; }
__device__ __forceinline__ u32x2 mk2(unsigned a, unsigned b) { u32x2 r; r.x = a; r.y = b; return r; }

#define TS 8448
#define TX 8192
#define DM 2048
#define NPH 19
#ifndef ONLY_PH
#define ONLY_PH -1
#endif
#define PHON(k) (ONLY_PH < 0 || ONLY_PH == (k))
#ifndef REP_P0
#define REP_P0 1
#endif
#ifndef REP_GEMM
#define REP_GEMM 1
#endif
#ifndef REP_P3
#define REP_P3 1
#endif
#ifndef REP_P18
#define REP_P18 1
#endif
#ifndef REP_TOPK
#define REP_TOPK 1
#endif
#ifndef REP_L1S
#define REP_L1S 1
#endif

struct P {
  const float *x, *c, *ctx, *cctx, *ada_w, *ada_b, *norm_mix, *norm_ffn, *norm_final;
  const float *ev_w_in, *ev_conv_w, *ev_conv_b, *hy_w1, *hy_b1, *hy_w2, *hy_b2, *hy_w3, *hy_freq, *hy_deltas, *hy_bias;
  const float *gm_norm, *gm_ws, *gm_bs, *ev_w_out;
  const float *od_w_in, *od_conv_w, *od_conv_b, *lru_wa, *lru_ba, *lru_wx, *lru_bx, *lru_lam, *pool_w, *pool_b, *pool_scale, *od_w_out;
  const float *peer_q, *peer_keys, *peer_u, *peer_v;
  float* out;
  float* MOD;
  bf16_t* H2B;
  bf16_t* W3T;
  bf16_t* WT_EVIN;
  bf16_t* WT_EVOUT;
  bf16_t* WT_ODIN;
  bf16_t* WT_ODOUT;
  bf16_t* WT_PQ;
  bf16_t* WG;
  bf16_t* KEYB;
  bf16_t* GMWS;
  bf16_t* WTPOOL;
  unsigned char* UB;
  unsigned char* VB;
  float* SU;
  float* SV;
  bf16_t* ABUF0;
  bf16_t* ABUF1;
  float* PROJT;
  float* PROJ1;
  float* XR;
  bf16_t* XRB;
  bf16_t* PD;
  bf16_t* FILT;
  float* Z1;
  float* ABA;
  float* ABB;
  float* XA;
  bf16_t* QB;
  float* SC;
  float2* AGG;
  unsigned* BAR;
};

__device__ __forceinline__ int tid_local() { int t_ = (int)threadIdx.x; asm volatile("" : "+v"(t_)); return t_; }
__device__ __forceinline__ bf16_t f2bf(float f) {
  uint32_t u = __float_as_uint(f);
  u += 0x7FFFu + ((u >> 16) & 1u);
  return (bf16_t)(u >> 16);
}
__device__ __forceinline__ float bf2f(bf16_t b) { return __uint_as_float(((uint32_t)b) << 16); }
__device__ __forceinline__ uint32_t pack2(float a, float b) { return (uint32_t)f2bf(a) | ((uint32_t)f2bf(b) << 16); }
__device__ __forceinline__ float bflo(uint32_t u) { return __uint_as_float(u << 16); }
__device__ __forceinline__ float bfhi(uint32_t u) { return __uint_as_float(u & 0xFFFF0000u); }
__device__ __forceinline__ float gelu_f(float x) {
  float u = 0.7978845608028654f * (x + 0.044715f * x * x * x);
  return x / (1.f + __expf(-2.f * u));
}
__device__ __forceinline__ float sigmoid_f(float x) { return 1.f / (1.f + __expf(-x)); }
__device__ __forceinline__ float wave_sum(float v) {
#pragma unroll
  for (int o = 32; o >= 1; o >>= 1) v += __shfl_xor(v, o);
  return v;
}
__device__ __forceinline__ uint32_t wave_max_u32(uint32_t v) {
#pragma unroll
  for (int o = 32; o >= 1; o >>= 1) { uint32_t t = (uint32_t)__shfl_xor((int)v, o); v = v > t ? v : t; }
  return v;
}
__device__ __forceinline__ uint32_t fkey(float f) { uint32_t u = __float_as_uint(f); return (u & 0x80000000u) ? ~u : (u | 0x80000000u); }
__device__ __forceinline__ float funkey(uint32_t k) { uint32_t u = (k & 0x80000000u) ? (k & 0x7FFFFFFFu) : ~k; return __uint_as_float(u); }

#define LDS_S 72
template <int NI>
__device__ __forceinline__ void gemm_core_t(f32x4 (&acc)[4][NI], const bf16_t* __restrict__ A, int lda,
                                            const bf16_t* __restrict__ Bt, int ldb, int K, bf16_t* sA, bf16_t* sB) {
  const int tid = tid_local(), lane = tid & 63, wid = tid >> 6, wr = wid >> 1, wc = wid & 1;
  const int lr = tid >> 3, lc = (tid & 7) * 8;
#pragma unroll
  for (int i = 0; i < 4; ++i)
#pragma unroll
    for (int j = 0; j < NI; ++j) acc[i][j] = (f32x4){0.f, 0.f, 0.f, 0.f};
  u32x4 ra[4], rb[NI];
#pragma unroll
  for (int i = 0; i < 4; ++i) ra[i] = *(const u32x4*)(A + (size_t)(lr + 32 * i) * lda + lc);
#pragma unroll
  for (int i = 0; i < NI; ++i) rb[i] = *(const u32x4*)(Bt + (size_t)(lr + 32 * i) * ldb + lc);
  const int nk = K >> 6;
  for (int kt = 0; kt < nk; ++kt) {
    __syncthreads();
#pragma unroll
    for (int i = 0; i < 4; ++i) *(u32x4*)(sA + (lr + 32 * i) * LDS_S + lc) = ra[i];
#pragma unroll
    for (int i = 0; i < NI; ++i) *(u32x4*)(sB + (lr + 32 * i) * LDS_S + lc) = rb[i];
    __syncthreads();
    if (kt + 1 < nk) {
      const int ko = (kt + 1) * 64;
#pragma unroll
      for (int i = 0; i < 4; ++i) ra[i] = *(const u32x4*)(A + (size_t)(lr + 32 * i) * lda + ko + lc);
#pragma unroll
      for (int i = 0; i < NI; ++i) rb[i] = *(const u32x4*)(Bt + (size_t)(lr + 32 * i) * ldb + ko + lc);
    }
    bf16x8 af[2][4], bfr[2][NI];
#pragma unroll
    for (int ks = 0; ks < 2; ++ks) {
#pragma unroll
      for (int mi = 0; mi < 4; ++mi)
        af[ks][mi] = *(const bf16x8*)(sA + (wr * 64 + mi * 16 + (lane & 15)) * LDS_S + ks * 32 + (lane >> 4) * 8);
#pragma unroll
      for (int ni = 0; ni < NI; ++ni)
        bfr[ks][ni] = *(const bf16x8*)(sB + (wc * 16 * NI + ni * 16 + (lane & 15)) * LDS_S + ks * 32 + (lane >> 4) * 8);
    }
#pragma unroll
    for (int ks = 0; ks < 2; ++ks)
#pragma unroll
      for (int mi = 0; mi < 4; ++mi)
#pragma unroll
        for (int ni = 0; ni < NI; ++ni)
          acc[mi][ni] = __builtin_amdgcn_mfma_f32_16x16x32_bf16(af[ks][mi], bfr[ks][ni], acc[mi][ni], 0, 0, 0);
  }
}
__device__ __forceinline__ void gemm_core(f32x4 (&acc)[4][4], const bf16_t* __restrict__ A, int lda,
                                          const bf16_t* __restrict__ Bt, int ldb, int K, bf16_t* sA, bf16_t* sB) {
  gemm_core_t<4>(acc, A, lda, Bt, ldb, K, sA, sB);
}

template <class Epi>
__device__ __forceinline__ void gemm_phase(const bf16_t* A, int lda, const bf16_t* Bt, int ldb, int M, int N, int K,
                                           char* smem, int bid, int nb, Epi epi) {
  const int numM = M >> 7, numN = N >> 7;
  bf16_t* sA = (bf16_t*)smem;
  bf16_t* sB = sA + 128 * LDS_S;
  const int lane = tid_local() & 63, wid = tid_local() >> 6, wr = wid >> 1, wc = wid & 1;
  const int total = numM * numN;
  const int full = (total / nb) * nb;
  const int vb = ((nb & 7) == 0) ? (bid & 7) * (nb >> 3) + (bid >> 3) : bid;
  auto tile_of = [&](int id, int& mt, int& nt) {
    const int gsz = 8 * numN, g = id / gsz, fm = g * 8;
    const int rows = (numM - fm) < 8 ? (numM - fm) : 8;
    const int r = id - g * gsz;
    mt = fm + r % rows; nt = r / rows;
  };
  for (int id = vb; id < full; id += nb) {
    int mt, nt;
    tile_of(id, mt, nt);
    f32x4 acc[4][4];
    gemm_core_t<4>(acc, A + (size_t)mt * 128 * lda, lda, Bt + (size_t)nt * 128 * ldb, ldb, K, sA, sB);
#pragma unroll
    for (int mi = 0; mi < 4; ++mi)
#pragma unroll
      for (int ni = 0; ni < 4; ++ni)
        epi(mt * 128 + wr * 64 + mi * 16 + (lane >> 4) * 4, nt * 128 + wc * 64 + ni * 16 + (lane & 15), acc[mi][ni]);
  }
  for (int u = vb; u < (total - full) * 4; u += nb) {
    const int id = full + (u >> 2), qd = u & 3;
    int mt, nt;
    tile_of(id, mt, nt);
    f32x4 acc[4][1];
    gemm_core_t<1>(acc, A + (size_t)mt * 128 * lda, lda, Bt + (size_t)(nt * 128 + qd * 32) * ldb, ldb, K, sA, sB);
#pragma unroll
    for (int mi = 0; mi < 4; ++mi)
      epi(mt * 128 + wr * 64 + mi * 16 + (lane >> 4) * 4, nt * 128 + qd * 32 + wc * 16 + (lane & 15), acc[mi][0]);
  }
}

__device__ __forceinline__ void ph_ada(const P& p, char* smem, int bid, int nb, int layer) {
  float* sc = (float*)smem;
  float* sx = sc + 2048;
  float* red = sx + 2048;
  const int tid = tid_local();
  bool loaded = false;
  for (int item0 = bid; item0 < 384; item0 += nb) {
    const int item = item0 + layer * 384;
    if (!loaded) {
      for (int i = tid; i < 2048; i += 256) {
        float v = p.c[i]; sc[i] = v * sigmoid_f(v);
        float w = p.cctx[i]; sx[i] = w * sigmoid_f(w);
      }
      __syncthreads();
      loaded = true;
    }
    const int l = item / 384, cgp = item % 384;
    const int col = cgp * 32 + (tid & 31), kg = tid >> 5;
    const float* w = p.ada_w + (size_t)l * 2048 * 12288 + col;
    float a0 = 0.f, a1 = 0.f;
#pragma unroll 16
    for (int k = kg; k < 2048; k += 8) {
      float wv = w[(size_t)k * 12288];
      a0 += sc[k] * wv; a1 += sx[k] * wv;
    }
    red[(kg * 32 + (tid & 31)) * 2 + 0] = a0;
    red[(kg * 32 + (tid & 31)) * 2 + 1] = a1;
    __syncthreads();
    if (tid < 64) {
      const int cc = tid & 31, which = tid >> 5;
      float s = 0.f;
#pragma unroll
      for (int g = 0; g < 8; ++g) s += red[(g * 32 + cc) * 2 + which];
      const int colo = cgp * 32 + cc;
      p.MOD[(size_t)(l * 2 + which) * 12288 + colo] = s + p.ada_b[l * 12288 + colo];
    }
    __syncthreads();
  }
  __syncthreads();
}

__device__ __forceinline__ void ph_h2(const P& p, char* smem, int bid, int nb) {
  float* feats = (float*)smem;
  float* h1 = feats + 160;
  float* w1s = feats + 512;
  float* w2s = w1s + 33 * 64;
  const int tid = tid_local(), r = tid >> 6, j = tid & 63;
  if (bid < 2112) {
    for (int i = tid; i < 33 * 64; i += 256) w1s[i] = p.hy_w1[i];
    for (int i = tid; i < 64 * 64; i += 256) w2s[i] = p.hy_w2[i];
  }
  const float b1 = p.hy_b1[j], b2 = p.hy_b2[j], fr = p.hy_freq[j];
  __syncthreads();
  for (int item = bid; item < 2112; item += nb) {
    const int row = item * 4 + r;
    const int L = row < TX ? TX : 256;
    const int t = row < TX ? row : row - TX;
    if (j < 33) {
      const float tn = (float)t / (float)(L - 1);
      float f;
      if (j == 0) f = tn;
      else {
        const int bi = (j - 1) & 15;
        const float band = 1e-4f + (float)bi * ((15.f - 1e-4f) / 15.f);
        const float ang = (6.283185307179586f / (float)L) * (float)t * band;
        f = (j <= 16) ? cosf(ang) : -sinf(ang);
      }
      feats[r * 36 + j] = f;
    }
    __syncthreads();
    float a = b1;
#pragma unroll
    for (int i = 0; i < 33; ++i) a += feats[r * 36 + i] * w1s[i * 64 + j];
    h1[r * 64 + j] = sinf(fr * a);
    __syncthreads();
    float a2 = b2;
#pragma unroll 16
    for (int i = 0; i < 64; ++i) a2 += h1[r * 64 + i] * w2s[i * 64 + j];
    p.H2B[(size_t)row * 64 + j] = f2bf(sinf(fr * a2));
  }
  __syncthreads();
}

using f32x2 = __attribute__((ext_vector_type(2))) float;
#ifndef FP6_ORDER
#define FP6_ORDER 1
#endif
using v16f = __attribute__((ext_vector_type(16))) float;
using v32f = __attribute__((ext_vector_type(32))) float;
using v6u = __attribute__((ext_vector_type(6))) unsigned int;
#define ROWB 1536
__device__ __forceinline__ void ph_tables(const P& p, int bid, int nb) {
  const int lane = tid_local() & 63, w = tid_local() >> 6;
  for (int r = bid * 4 + w; r < 65536; r += nb * 4) {
    const int tb = r >> 15, row = r & 32767;
    const float* src = (tb ? p.peer_v : p.peer_u) + (size_t)row * 2048 + lane * 32;
    unsigned char* dst = (tb ? p.VB : p.UB) + (size_t)row * ROWB;
    f32x4 v[8];
    float amax = 0.f;
#pragma unroll
    for (int q = 0; q < 8; ++q) {
      v[q] = *(const f32x4*)(src + q * 4);
      amax = fmaxf(amax, fmaxf(fmaxf(fabsf(v[q].x), fabsf(v[q].y)), fmaxf(fabsf(v[q].z), fabsf(v[q].w))));
    }
#pragma unroll
    for (int o = 32; o >= 1; o >>= 1) amax = fmaxf(amax, __shfl_xor(amax, o));
    const float sc = (amax > 0.f) ? exp2f(floorf(log2f(7.5f / amax))) : 1.f;
    v16f a, b;
#pragma unroll
    for (int k = 0; k < 16; ++k) {
#if FP6_ORDER == 0
      const int ia = k, ib = 16 + k;
#else
      const int ia = 2 * k, ib = 2 * k + 1;
#endif
      a[k] = v[ia >> 2][ia & 3] * sc;
      b[k] = v[ib >> 2][ib & 3] * sc;
    }
    const v6u pk = __builtin_amdgcn_cvt_scalef32_2xpk16_fp6_f32(a, b, 1.0f);
#pragma unroll
    for (int jc = 0; jc < 3; ++jc) *(u32x2*)(dst + jc * 512 + lane * 8) = mk2(pk[2 * jc], pk[2 * jc + 1]);
    if (lane == 0) (tb ? p.SV : p.SU)[row] = 1.f / sc;
  }
}

__device__ __forceinline__ void transpose_job(const float* src, bf16_t* dst, int K, int N, int batch, char* smem, int bid, int nb) {
  float* s = (float*)smem;
  const int tid = tid_local();
  const int tK = K >> 6, tN = N >> 6, per = tK * tN, total = batch * per;
  for (int item = bid; item < total; item += nb) {
    const int b = item / per, rem = item % per, tk = rem / tN, tn = rem % tN;
    const float* sp = src + (size_t)b * K * N + (size_t)(tk * 64) * N + tn * 64;
#pragma unroll
    for (int i = 0; i < 4; ++i) {
      const int row = (tid >> 4) + 16 * i, c4 = (tid & 15) * 4;
      float4 v = *(const float4*)(sp + (size_t)row * N + c4);
      s[row * 65 + c4 + 0] = v.x; s[row * 65 + c4 + 1] = v.y; s[row * 65 + c4 + 2] = v.z; s[row * 65 + c4 + 3] = v.w;
    }
    __syncthreads();
    const int n = tid >> 2, kq = tid & 3;
    uint32_t w[8];
#pragma unroll
    for (int e = 0; e < 8; ++e) w[e] = pack2(s[(kq * 16 + 2 * e) * 65 + n], s[(kq * 16 + 2 * e + 1) * 65 + n]);
    bf16_t* d = dst + (size_t)b * N * K + (size_t)(tn * 64 + n) * K + tk * 64 + kq * 16;
    *(u32x4*)d = mk4(w[0], w[1], w[2], w[3]);
    *(u32x4*)(d + 8) = mk4(w[4], w[5], w[6], w[7]);
    __syncthreads();
  }
}

__device__ __forceinline__ void ph_small_convert(const P& p, int bid, int nb) {
  const int gt = bid * 256 + tid_local(), gs = nb * 256;
  for (int i = gt; i < 2 * 16 * 128 * 128; i += gs) {
    const int k = i & 127, n = (i >> 7) & 127, hh = (i >> 14) & 15, dir = i >> 18;
    const int wc = n >> 6, ni = (n >> 4) & 3, l = n & 15;
    const int type = ni & 1, cl = (wc * 2 + (ni >> 1)) * 16 + l;
    const int h = hh >> 1, half = hh & 1, j = half * 64 + cl;
    const float* src = type ? p.lru_wx : p.lru_wa;
    p.WG[i] = f2bf(src[((size_t)(dir * 8 + h) * 128 + k) * 128 + j]);
  }
  for (int i = gt; i < 2 * 16 * 128 * 128; i += gs) p.KEYB[i] = f2bf(p.peer_keys[i]);
  for (int i = gt; i < 8 * 128 * 128; i += gs) p.GMWS[i] = f2bf(p.gm_ws[i]);
}

__device__ __forceinline__ void ph_norm(const float* srcx, const float* srcc, int nrows, const float* gnorm, const float* modx,
                        const float* modc, int shIdx, int scIdx, bf16_t* dst, int bid, int nb) {
  const int lane = tid_local() & 63, w = tid_local() >> 6;
  for (int row = bid * 4 + w; row < nrows; row += nb * 4) {
    const float* s = row < TX ? srcx + (size_t)row * DM : srcc + (size_t)(row - TX) * DM;
    const float* md = row < TX ? modx : modc;
    float4 v[8];
    float ss = 0.f;
#pragma unroll
    for (int i = 0; i < 8; ++i) {
      v[i] = ((const float4*)s)[i * 64 + lane];
      ss += v[i].x * v[i].x + v[i].y * v[i].y + v[i].z * v[i].z + v[i].w * v[i].w;
    }
    ss = wave_sum(ss);
    const float rstd = rsqrtf(ss * (1.f / DM) + 1e-6f);
#pragma unroll
    for (int i = 0; i < 8; ++i) {
      const int d = (i * 64 + lane) * 4;
      const float4 g = *(const float4*)(gnorm + d);
      const float4 sc = *(const float4*)(md + scIdx * DM + d);
      const float4 sh = *(const float4*)(md + shIdx * DM + d);
      const float y0 = v[i].x * rstd * g.x * (1.f + sc.x) + sh.x;
      const float y1 = v[i].y * rstd * g.y * (1.f + sc.y) + sh.y;
      const float y2 = v[i].z * rstd * g.z * (1.f + sc.z) + sh.z;
      const float y3 = v[i].w * rstd * g.w * (1.f + sc.w) + sh.w;
      *(u32x2*)(dst + (size_t)row * DM + d) = mk2(pack2(y0, y1), pack2(y2, y3));
    }
  }
}

__device__ __forceinline__ float conv3_at(const P& p, int part, int ch, int toff, int L, int s) {
  const int c = part * 1024 + ch;
  const float* row = p.PROJT + (size_t)c * TS + toff;
  float v = p.ev_conv_b[c] + p.ev_conv_w[3072 + c] * row[s];
  if (s > 0) v += p.ev_conv_w[c] * row[s - 1];
  if (s < L - 1) v += p.ev_conv_w[2 * 3072 + c] * row[s + 1];
  return v;
}

__device__ __forceinline__ float4 conv3_vec4(const P& p, int part, int ch, int toff, int L, int s0) {
  const int c = part * 1024 + ch;
  const float* row = p.PROJT + (size_t)c * TS + toff;
  const float4 m = *(const float4*)(row + s0);
  const float l = (s0 > 0) ? row[s0 - 1] : 0.f;
  const float r = (s0 + 4 < L) ? row[s0 + 4] : 0.f;
  const float b = p.ev_conv_b[c], w0 = p.ev_conv_w[c], w1 = p.ev_conv_w[3072 + c], w2 = p.ev_conv_w[2 * 3072 + c];
  float4 o;
  o.x = b + w0 * l + w1 * m.x + w2 * m.y;
  o.y = b + w0 * m.x + w1 * m.y + w2 * m.z;
  o.z = b + w0 * m.y + w1 * m.z + w2 * m.w;
  o.w = b + w0 * m.z + w1 * m.w + w2 * r;
  return o;
}

#define C3_LOAD(M, Lf, Rt, part, s0) { const float* row_ = p.PROJT + (size_t)((part) * 1024 + ch) * TS + toff; \
    M = *(const f32x4*)(row_ + (s0)); Lf = ((s0) > 0) ? row_[(s0) - 1] : 0.f; Rt = ((s0) + 4 < L) ? row_[(s0) + 4] : 0.f; }
__device__ __forceinline__ f32x4 c3_eval(f32x4 m, float l, float r, float b, float w0, float w1, float w2) {
  f32x4 o;
  o.x = b + w0 * l + w1 * m.x + w2 * m.y;
  o.y = b + w0 * m.x + w1 * m.y + w2 * m.z;
  o.z = b + w0 * m.y + w1 * m.z + w2 * m.w;
  o.w = b + w0 * m.z + w1 * m.w + w2 * r;
  return o;
}

template <int SEQ>
__device__ __forceinline__ void hyena_item(const P& p, char* smem, int ch) {
  constexpr int L = SEQ ? 256 : TX;
  constexpr int toff = SEQ ? TX : 0;
  constexpr int nB = L >> 7;
  constexpr int NT = SEQ ? 1 : 4;
  bf16_t* KK = (bf16_t*)smem;
  float* ybuf = (float*)smem;
  bf16_t* UP = (bf16_t*)(smem + 34816);
  bf16_t* CP = (bf16_t*)(smem + 51712);
  float* red = (float*)(smem + 59904);
  const int tid = tid_local(), lane = tid & 63, w = tid >> 6;
  for (int n = 0; n < 2; ++n) {
    const bf16_t* ff = p.FILT + (size_t)(n * 1024 + ch) * TS + toff;
    const bf16_t* fb = p.FILT + (size_t)(2048 + n * 1024 + ch) * TS + toff;
    float sabs = 0.f;
    {
      constexpr int NKK = ((2 * L) / 8 + 255) / 256;
      u32x4 kv[NKK];
#pragma unroll
      for (int k = 0; k < NKK; ++k) {
        const int idx = (tid + 256 * k) * 8;
        kv[k] = mk4(0u, 0u, 0u, 0u);
        if (idx < 2 * L) kv[k] = (idx >= L) ? *(const u32x4*)(ff + (idx - L)) : *(const u32x4*)(fb + (L - 8 - idx));
      }
#pragma unroll
      for (int k = 0; k < NKK; ++k) {
        const int idx = (tid + 256 * k) * 8;
        if (idx < 2 * L) {
          u32x4 v = kv[k];
          if (idx < L) {
            const u32x4 r = v;
            v.x = (r.w >> 16) | (r.w << 16); v.y = (r.z >> 16) | (r.z << 16); v.z = (r.y >> 16) | (r.y << 16); v.w = (r.x >> 16) | (r.x << 16);
          }
          sabs += fabsf(bflo(v.x)) + fabsf(bfhi(v.x)) + fabsf(bflo(v.y)) + fabsf(bfhi(v.y)) + fabsf(bflo(v.z)) + fabsf(bfhi(v.z)) + fabsf(bflo(v.w)) + fabsf(bfhi(v.w));
          *(u32x4*)(KK + (idx >> 7) * 136 + (idx & 127)) = v;
        }
      }
    }
    sabs = wave_sum(sabs);
    if (lane == 0) red[w] = sabs;
    const float cb0 = p.ev_conv_b[ch], cw00 = p.ev_conv_w[ch], cw01 = p.ev_conv_w[3072 + ch], cw02 = p.ev_conv_w[2 * 3072 + ch];
    {
      constexpr int NUP = ((L + 256) / 4 + 255) / 256;
      if (n == 0) {
        constexpr int CH = SEQ ? 1 : 3;
#pragma unroll 1
        for (int k0 = 0; k0 < NUP; k0 += CH) {
          f32x4 cm[CH]; float cl[CH], cr[CH];
#pragma unroll
          for (int k = 0; k < CH; ++k) {
            const int s0 = (tid + 256 * (k0 + k)) * 4 - 128;
            cm[k] = (f32x4){0.f, 0.f, 0.f, 0.f}; cl[k] = 0.f; cr[k] = 0.f;
            if (s0 >= 0 && s0 < L) C3_LOAD(cm[k], cl[k], cr[k], 0, s0)
          }
#pragma unroll
          for (int k = 0; k < CH; ++k) {
            const int iv = tid + 256 * (k0 + k), s0 = iv * 4 - 128;
            if (iv < (L + 256) / 4) {
              f32x4 u = (f32x4){0.f, 0.f, 0.f, 0.f};
              if (s0 >= 0 && s0 < L) u = c3_eval(cm[k], cl[k], cr[k], cb0, cw00, cw01, cw02);
              *(u32x2*)(UP + iv * 4) = mk2(pack2(u.x, u.y), pack2(u.z, u.w));
            }
          }
        }
      } else {
        f32x4 zv[NUP];
#pragma unroll
        for (int k = 0; k < NUP; ++k) {
          const int s0 = (tid + 256 * k) * 4 - 128;
          zv[k] = (f32x4){0.f, 0.f, 0.f, 0.f};
          if (s0 >= 0 && s0 < L) zv[k] = *(const f32x4*)(p.Z1 + (size_t)ch * TS + toff + s0);
        }
#pragma unroll
        for (int k = 0; k < NUP; ++k) {
          const int iv = tid + 256 * k;
          if (iv < (L + 256) / 4) *(u32x2*)(UP + iv * 4) = mk2(pack2(zv[k].x, zv[k].y), pack2(zv[k].z, zv[k].w));
        }
      }
    }
    __syncthreads();
    const float invS = 1.f / (red[0] + red[1] + red[2] + red[3]);

    f32x4 acc[2][NT];
#pragma unroll
    for (int a = 0; a < 2; ++a)
#pragma unroll
      for (int b = 0; b < NT; ++b) acc[a][b] = (f32x4){0.f, 0.f, 0.f, 0.f};

    const unsigned hy_cp_off = (unsigned)(unsigned long long)((__attribute__((address_space(3))) char*)CP) +
                               (unsigned)(((7 - (2 * w + 1)) * 256 + 120 + 8 * (lane >> 4) - 8 * (lane & 15)) * 2);
    const unsigned hy_kk_off = (unsigned)(unsigned long long)((__attribute__((address_space(3))) char*)KK) +
                               (unsigned)((((lane & 15) + nB) * 136 + 8 * (lane >> 4)) * 2);
    auto build_window = [&](int c, int buf) {
      const int sg = tid >> 5, y0 = (tid & 31) * 8;
      uint32_t wv[4] = {0u, 0u, 0u, 0u};
      if (y0 < 248) {
        const int base = (c + 1) * 128 - 1 - y0 - sg + 128;
#pragma unroll
        for (int e = 0; e < 4; ++e) wv[e] = (uint32_t)UP[base - 2 * e] | ((uint32_t)UP[base - 2 * e - 1] << 16);
      }
      *(u32x4*)(CP + buf * 2048 + sg * 256 + y0) = mk4(wv[0], wv[1], wv[2], wv[3]);
    };
    build_window(0, 0);
    __syncthreads();
    for (int c = 0; c <= nB; ++c) {
      const int buf = c & 1;
      if (c < nB) build_window(c + 1, buf ^ 1);
      if constexpr (SEQ == 0) {
        const unsigned aB = hy_cp_off + (unsigned)buf * 4096u;
        const unsigned bB = hy_kk_off - (unsigned)c * 272u;
        bf16x8 a0s0, a1s0, b0s0, b1s0, b2s0, b3s0, a0s1, a1s1, b0s1, b1s1, b2s1, b3s1;
#define HY_LOADS(a0, a1, b0, b1, b2, b3, JS) \
        asm volatile("ds_read_b128 %0, %6 offset:%8\n\tds_read_b128 %1, %6 offset:%9\n\t" \
                     "ds_read_b128 %2, %7 offset:%10\n\tds_read_b128 %3, %7 offset:%11\n\t" \
                     "ds_read_b128 %4, %7 offset:%12\n\tds_read_b128 %5, %7 offset:%13" \
                     : "=&v"(a0), "=&v"(a1), "=&v"(b0), "=&v"(b1), "=&v"(b2), "=&v"(b3) \
                     : "v"(aB), "v"(bB), "i"(512 + 64 * (JS)), "i"(64 * (JS)), "i"(64 * (JS)), "i"(4352 + 64 * (JS)), \
                       "i"(8704 + 64 * (JS)), "i"(13056 + 64 * (JS)) : "memory")
#define HY_WAIT(N, a0, a1, b0, b1, b2, b3) \
        asm volatile("s_waitcnt lgkmcnt(" #N ")" : "+v"(a0), "+v"(a1), "+v"(b0), "+v"(b1), "+v"(b2), "+v"(b3))
#define HY_MMA(a0, a1, b0, b1, b2, b3) { \
          acc[0][0] = __builtin_amdgcn_mfma_f32_16x16x32_bf16(a0, b0, acc[0][0], 0, 0, 0); \
          acc[1][0] = __builtin_amdgcn_mfma_f32_16x16x32_bf16(a1, b0, acc[1][0], 0, 0, 0); \
          acc[0][1] = __builtin_amdgcn_mfma_f32_16x16x32_bf16(a0, b1, acc[0][1], 0, 0, 0); \
          acc[1][1] = __builtin_amdgcn_mfma_f32_16x16x32_bf16(a1, b1, acc[1][1], 0, 0, 0); \
          acc[0][2] = __builtin_amdgcn_mfma_f32_16x16x32_bf16(a0, b2, acc[0][2], 0, 0, 0); \
          acc[1][2] = __builtin_amdgcn_mfma_f32_16x16x32_bf16(a1, b2, acc[1][2], 0, 0, 0); \
          acc[0][3] = __builtin_amdgcn_mfma_f32_16x16x32_bf16(a0, b3, acc[0][3], 0, 0, 0); \
          acc[1][3] = __builtin_amdgcn_mfma_f32_16x16x32_bf16(a1, b3, acc[1][3], 0, 0, 0); }
        HY_LOADS(a0s0, a1s0, b0s0, b1s0, b2s0, b3s0, 0);
        HY_LOADS(a0s1, a1s1, b0s1, b1s1, b2s1, b3s1, 1);
        HY_WAIT(6, a0s0, a1s0, b0s0, b1s0, b2s0, b3s0);
        HY_MMA(a0s0, a1s0, b0s0, b1s0, b2s0, b3s0)
        HY_LOADS(a0s0, a1s0, b0s0, b1s0, b2s0, b3s0, 2);
        HY_WAIT(6, a0s1, a1s1, b0s1, b1s1, b2s1, b3s1);
        HY_MMA(a0s1, a1s1, b0s1, b1s1, b2s1, b3s1)
        HY_LOADS(a0s1, a1s1, b0s1, b1s1, b2s1, b3s1, 3);
        HY_WAIT(6, a0s0, a1s0, b0s0, b1s0, b2s0, b3s0);
        HY_MMA(a0s0, a1s0, b0s0, b1s0, b2s0, b3s0)
        HY_WAIT(0, a0s1, a1s1, b0s1, b1s1, b2s1, b3s1);
        HY_MMA(a0s1, a1s1, b0s1, b1s1, b2s1, b3s1)
      } else {
      const bf16_t* cp = CP + buf * 2048;
      bf16x8 aF[2][2], bF[2][NT];
      const bf16_t* kbase[NT];
#pragma unroll
      for (int nt = 0; nt < NT; ++nt) {
        int e = nt * 16 + (lane & 15);
        if (e > nB - 1) e = nB - 1;
        kbase[nt] = KK + (e - c + nB) * 136 + 8 * (lane >> 4);
      }
      const bf16_t* abase = cp + 120 + 8 * (lane >> 4) - 8 * (lane & 15);
#pragma unroll
      for (int mi = 0; mi < 2; ++mi) aF[0][mi] = *(const bf16x8*)(abase + (7 - (2 * w + mi)) * 256);
#pragma unroll
      for (int nt = 0; nt < NT; ++nt) bF[0][nt] = *(const bf16x8*)(kbase[nt]);
#pragma unroll
      for (int js = 0; js < 4; ++js) {
        if (js < 3) {
#pragma unroll
          for (int mi = 0; mi < 2; ++mi) aF[(js + 1) & 1][mi] = *(const bf16x8*)(abase + (7 - (2 * w + mi)) * 256 + 32 * (js + 1));
#pragma unroll
          for (int nt = 0; nt < NT; ++nt) bF[(js + 1) & 1][nt] = *(const bf16x8*)(kbase[nt] + 32 * (js + 1));
        }
#pragma unroll
        for (int nt = 0; nt < NT; ++nt)
#pragma unroll
          for (int mi = 0; mi < 2; ++mi)
            acc[mi][nt] = __builtin_amdgcn_mfma_f32_16x16x32_bf16(aF[js & 1][mi], bF[js & 1][nt], acc[mi][nt], 0, 0, 0);
      }
      }
      __syncthreads();
    }
#pragma unroll
    for (int mi = 0; mi < 2; ++mi)
#pragma unroll
      for (int nt = 0; nt < NT; ++nt) {
        const int e = nt * 16 + (lane & 15);
        if (e < nB) {
#pragma unroll
          for (int j = 0; j < 4; ++j) {
            const int rho = (lane >> 4) * 4 + j;
            const int tau = (2 * w + mi) + 8 * rho;
            ybuf[e * 128 + tau] = acc[mi][nt][j] * invS;
          }
        }
      }
    __syncthreads();
    const float bias = p.hy_bias[n * 1024 + ch];
    {
      constexpr int NE = (L / 4 + 255) / 256;
      const int pa = (n == 0) ? 1 : 2;
      const float pb = p.ev_conv_b[pa * 1024 + ch], pw0 = p.ev_conv_w[pa * 1024 + ch], pw1 = p.ev_conv_w[3072 + pa * 1024 + ch], pw2 = p.ev_conv_w[2 * 3072 + pa * 1024 + ch];
      constexpr int CE = SEQ ? 1 : 4;
#pragma unroll 1
      for (int k0 = 0; k0 < NE; k0 += CE) {
        f32x4 am[CE], bm[CE];
        float al[CE], ar[CE], bl[CE], br[CE];
#pragma unroll
        for (int k = 0; k < CE; ++k) {
          const int t0 = (tid + 256 * (k0 + k)) * 4;
          am[k] = (f32x4){0.f, 0.f, 0.f, 0.f}; bm[k] = am[k]; al[k] = 0.f; ar[k] = 0.f; bl[k] = 0.f; br[k] = 0.f;
          if (t0 < L) {
            C3_LOAD(am[k], al[k], ar[k], pa, t0)
            if (n == 0) C3_LOAD(bm[k], bl[k], br[k], 0, t0)
            else bm[k] = *(const f32x4*)(p.Z1 + (size_t)ch * TS + toff + t0);
          }
        }
#pragma unroll
        for (int k = 0; k < CE; ++k) {
          const int t0 = (tid + 256 * (k0 + k)) * 4;
          if (t0 < L) {
            const f32x4 y = *(const f32x4*)(ybuf + t0);
            const f32x4 xm = c3_eval(am[k], al[k], ar[k], pb, pw0, pw1, pw2);
            if (n == 0) {
              const f32x4 v = c3_eval(bm[k], bl[k], br[k], cb0, cw00, cw01, cw02);
              f32x4 z;
              z.x = xm.x * (y.x + bias * v.x); z.y = xm.y * (y.y + bias * v.y); z.z = xm.z * (y.z + bias * v.z); z.w = xm.w * (y.w + bias * v.w);
              *(f32x4*)(p.Z1 + (size_t)ch * TS + toff + t0) = z;
            } else {
              const f32x4 z1 = bm[k];
              bf16_t* o = p.ABUF1 + (size_t)(toff + t0) * DM + ch;
              o[0] = f2bf(xm.x * (y.x + bias * z1.x));
              o[DM] = f2bf(xm.y * (y.y + bias * z1.y));
              o[2 * DM] = f2bf(xm.z * (y.z + bias * z1.z));
              o[3 * DM] = f2bf(xm.w * (y.w + bias * z1.w));
            }
          }
        }
      }
    }
    __threadfence_block();
    __syncthreads();
  }
}

__device__ __forceinline__ void gmlp_item(const P& p, char* smem, int n, int h) {
  bf16_t* Bt = (bf16_t*)smem;
  float* rs = (float*)(smem + 34816);
  const int tid = tid_local(), lane = tid & 63, w = tid >> 6;
  const float* VG = p.PROJT + (size_t)4096 * TS + n * 128;
  {
    const int c8 = tid >> 5, q4 = (tid & 31) * 4;
    float4 s4 = make_float4(0.f, 0.f, 0.f, 0.f);
#pragma unroll 16
    for (int c = c8; c < 1024; c += 8) {
      const float4 v = *(const float4*)(VG + (size_t)c * TS + q4);
      s4.x += v.x * v.x; s4.y += v.y * v.y; s4.z += v.z * v.z; s4.w += v.w * v.w;
    }
    float* rs8 = rs + 128;
    *(float4*)(rs8 + c8 * 128 + q4) = s4;
  }
  __syncthreads();
  if (tid < 128) {
    float a = 0.f;
#pragma unroll
    for (int g = 0; g < 8; ++g) a += rs[128 + g * 128 + tid];
    rs[tid] = rsqrtf(a * (1.f / 1024.f) + 1e-6f);
  }
  __syncthreads();
  {
    const int c = tid >> 1, q0 = (tid & 1) * 64;
    const float g = p.gm_norm[h * 128 + c];
    const float* src = VG + (size_t)(h * 128 + c) * TS + q0;
#pragma unroll 4
    for (int i = 0; i < 16; ++i) {
      const float4 v = *(const float4*)(src + 4 * i);
      const int q = q0 + 4 * i;
      *(u32x2*)(Bt + c * 136 + q) = mk2(pack2(v.x * rs[q] * g, v.y * rs[q + 1] * g), pack2(v.z * rs[q + 2] * g, v.w * rs[q + 3] * g));
    }
  }
  __syncthreads();
  f32x4 acc[2][8];
#pragma unroll
  for (int a = 0; a < 2; ++a)
#pragma unroll
    for (int b = 0; b < 8; ++b) acc[a][b] = (f32x4){0.f, 0.f, 0.f, 0.f};
  const bf16_t* Aw = p.GMWS + (size_t)h * 128 * 128;
  bf16x8 afA[4][2];
#pragma unroll
  for (int ks = 0; ks < 4; ++ks)
#pragma unroll
    for (int mi = 0; mi < 2; ++mi)
      afA[ks][mi] = *(const bf16x8*)(Aw + (32 * w + 16 * mi + (lane & 15)) * 128 + ks * 32 + (lane >> 4) * 8);
#pragma unroll
  for (int ks = 0; ks < 4; ++ks) {
    bf16x8 bB[8];
#pragma unroll
    for (int ni = 0; ni < 8; ++ni) bB[ni] = *(const bf16x8*)(Bt + (ni * 16 + (lane & 15)) * 136 + ks * 32 + (lane >> 4) * 8);
#pragma unroll
    for (int ni = 0; ni < 8; ++ni)
#pragma unroll
      for (int mi = 0; mi < 2; ++mi)
        acc[mi][ni] = __builtin_amdgcn_mfma_f32_16x16x32_bf16(afA[ks][mi], bB[ni], acc[mi][ni], 0, 0, 0);
  }
#pragma unroll
  for (int mi = 0; mi < 2; ++mi)
#pragma unroll
    for (int ni = 0; ni < 8; ++ni) {
      const int c = ni * 16 + (lane & 15);
      const int p0 = 32 * w + 16 * mi + (lane >> 4) * 4;
      const float4 u = *(const float4*)(p.PROJT + (size_t)(3072 + h * 128 + c) * TS + n * 128 + p0);
      const float uu[4] = {u.x, u.y, u.z, u.w};
#pragma unroll
      for (int j = 0; j < 4; ++j) {
        const int pp = p0 + j;
        const float s = acc[mi][ni][j] + p.gm_bs[h * 128 + pp];
        p.ABUF1[(size_t)(n * 128 + pp) * DM + 1024 + h * 128 + c] = f2bf(uu[j] * s);
      }
    }
  __syncthreads();
}

#define BF8(dst, o, q) dst[o + 0] = bflo(q.x); dst[o + 1] = bfhi(q.x); dst[o + 2] = bflo(q.y); dst[o + 3] = bfhi(q.y); \
                       dst[o + 4] = bflo(q.z); dst[o + 5] = bfhi(q.z); dst[o + 6] = bflo(q.w); dst[o + 7] = bfhi(q.w);
template <int LAST>
__device__ __forceinline__ void ph_peer(const P& p, int layer, int ntok, char* smem, int bid, int nb) {
  const int tid = tid_local();
  const int lane = tid & 63, w = tid >> 6;
  int* sExp = (int*)smem + w * 32;
  float* sGate = (float*)(smem + 512) + w * 32;
  uint32_t* LL = (uint32_t*)(smem + 1024) + w * 128;
  float* sPart = (float*)(smem + 4096);
  float* sRed = (float*)(smem + 4096 + 32768);
  const unsigned char* UBl = p.UB + (size_t)layer * 16384 * ROWB;
  const unsigned char* VBl = p.VB + (size_t)layer * 16384 * ROWB;
  const float* SUl = p.SU + layer * 16384;
  const float* SVl = p.SV + layer * 16384;
  const bf16_t* HP = LAST ? p.ABUF1 : p.ABUF0;
  int pi_ = 0, pj_ = 0;
  {
    int rem = lane;
    bool found = false;
#pragma unroll
    for (int ii = 0; ii < 16; ++ii) {
      const int nn = 16 / (ii + 1);
      if (!found && rem < nn) { pi_ = ii; pj_ = rem; found = true; }
      if (!found) rem -= nn;
    }
  }
  const bool pvalid_ = lane < 50;
  float scv[8];
  if (bid < ntok) {
    const float* sp = p.SC + (size_t)bid * DM + w * 512 + lane;
#pragma unroll
    for (int k = 0; k < 8; ++k) scv[k] = sp[k * 64];
  }
  for (int t = bid; t < ntok; t += nb) {
    for (int rep_ = 0; rep_ < REP_TOPK; ++rep_) {
      uint32_t key[4][2], prefix[4];
      int need[4];
#pragma unroll
      for (int g = 0; g < 4; ++g) {
        key[g][0] = (((fkey(scv[g * 2 + 0]) + 0x2000u) >> 14) << 7) | (uint32_t)lane;
        key[g][1] = (((fkey(scv[g * 2 + 1]) + 0x2000u) >> 14) << 7) | (uint32_t)(lane + 64);
        prefix[g] = 0u; need[g] = 16;
      }
#pragma unroll 4
      for (int bit = 24; bit >= 0; --bit) {
        const uint32_t mh = ~((1u << bit) - 1u);
#pragma unroll
        for (int g = 0; g < 4; ++g) {
          const uint32_t cand = prefix[g] | (1u << bit);
          const int c = __popcll(__ballot((key[g][0] & mh) == cand)) + __popcll(__ballot((key[g][1] & mh) == cand));
          const bool ge_ = c >= need[g];
          prefix[g] = ge_ ? cand : prefix[g];
          need[g] = ge_ ? need[g] : need[g] - c;
        }
      }
#pragma unroll
      for (int g = 0; g < 4; ++g) {
        const bool q0 = key[g][0] >= prefix[g], q1 = key[g][1] >= prefix[g];
        const unsigned long long b0 = __ballot(q0), b1 = __ballot(q1);
        const int r0 = __builtin_amdgcn_mbcnt_hi((unsigned)(b0 >> 32), __builtin_amdgcn_mbcnt_lo((unsigned)b0, 0u));
        const int r1 = __popcll(b0) + __builtin_amdgcn_mbcnt_hi((unsigned)(b1 >> 32), __builtin_amdgcn_mbcnt_lo((unsigned)b1, 0u));
        uint32_t* Ls = LL + (g >> 1) * 48 + (g & 1) * 16;
        if (q0) Ls[r0 & 15] = key[g][0];
        if (q1) Ls[r1 & 15] = key[g][1];
      }
      {
        uint32_t* Lg = LL + (lane >> 5) * 48 + ((lane >> 4) & 1) * 16;
        const uint32_t my = Lg[lane & 15];
        int rk = 0;
#pragma unroll
        for (int k = 0; k < 16; ++k) rk += (Lg[k] > my) ? 1 : 0;
        Lg[rk] = my;
      }
      uint32_t pk[2], cpre[2];
      int cneed[2];
#pragma unroll
      for (int hh = 0; hh < 2; ++hh) {
        const float s0 = funkey((LL[hh * 48 + pi_] >> 7) << 14);
        const float s1 = funkey((LL[hh * 48 + 16 + pj_] >> 7) << 14);
        pk[hh] = pvalid_ ? ((((fkey(s0 + s1) + 0x2000u) >> 14) << 8) | (uint32_t)(pi_ * 16 + pj_)) : 0u;
        cpre[hh] = 0u; cneed[hh] = 16;
      }
#pragma unroll 4
      for (int bit = 25; bit >= 0; --bit) {
        const uint32_t mh = ~((1u << bit) - 1u);
#pragma unroll
        for (int hh = 0; hh < 2; ++hh) {
          const uint32_t cand = cpre[hh] | (1u << bit);
          const int c = __popcll(__ballot((pk[hh] & mh) == cand));
          const bool ge_ = c >= cneed[hh];
          cpre[hh] = ge_ ? cand : cpre[hh];
          cneed[hh] = ge_ ? cneed[hh] : cneed[hh] - c;
        }
      }
#pragma unroll
      for (int hh = 0; hh < 2; ++hh) {
        uint32_t* L0 = LL + hh * 48;
        uint32_t* L1 = L0 + 16;
        uint32_t* L2 = L0 + 32;
        {
          const bool q = pk[hh] >= cpre[hh] && pk[hh] != 0u;
          const unsigned long long bq = __ballot(q);
          const int r = __builtin_amdgcn_mbcnt_hi((unsigned)(bq >> 32), __builtin_amdgcn_mbcnt_lo((unsigned)bq, 0u));
          if (q) L2[r & 15] = pk[hh];
        }
        const uint32_t mine = L2[lane & 15];
        const int cidx = (int)(mine & 255u);
        const float cv = funkey((mine >> 8) << 14);
        const int ia = (int)(L0[(cidx >> 4) & 15] & 127u);
        const int ib = (int)(L1[cidx & 15] & 127u);
        float mx = cv;
#pragma unroll
        for (int o = 8; o >= 1; o >>= 1) mx = fmaxf(mx, __shfl_xor(mx, o));
        const float ev = __expf(cv - mx);
        float sum = ev;
#pragma unroll
        for (int o = 8; o >= 1; o >>= 1) sum += __shfl_xor(sum, o);
        if (lane < 16) {
          sExp[hh * 16 + lane] = ia * 128 + ib;
          sGate[hh * 16 + lane] = ev / sum;
        }
      }
    }
    if (t + nb < ntok) {
      const float* sp = p.SC + (size_t)(t + nb) * DM + w * 512 + lane;
#pragma unroll
      for (int k = 0; k < 8; ++k) scv[k] = sp[k * 64];
    }
    u32x4 xq[4];
    {
      const u32x4* xr = (const u32x4*)(HP + (size_t)t * DM) + lane * 4;
#pragma unroll
      for (int q = 0; q < 4; ++q) xq[q] = xr[q];
    }
    float acc[32];
#pragma unroll
    for (int i = 0; i < 32; ++i) acc[i] = 0.f;
    u32x2 ub[2][3], vb[2][3];
    int ex[2], exn[2];
#pragma unroll
    for (int e = 0; e < 2; ++e) {
      exn[e] = __builtin_amdgcn_readfirstlane(sExp[e]);
      const u32x2* ur = (const u32x2*)(UBl + (size_t)exn[e] * ROWB) + lane;
#pragma unroll
      for (int jc = 0; jc < 3; ++jc) ub[e][jc] = ur[jc * 64];
    }
#pragma unroll 1
    for (int eb = 0; eb < 32; eb += 2) {
      float d[2];
#pragma unroll
      for (int e = 0; e < 2; ++e) {
        ex[e] = exn[e];
        v6u pk;
        pk[0] = ub[e][0].x; pk[1] = ub[e][0].y; pk[2] = ub[e][1].x; pk[3] = ub[e][1].y; pk[4] = ub[e][2].x; pk[5] = ub[e][2].y;
        const v32f uu = __builtin_amdgcn_cvt_scalef32_pk32_f32_fp6(pk, 1.0f);
        float sdot = 0.f;
#pragma unroll
        for (int q = 0; q < 4; ++q) {
          sdot += bflo(xq[q].x) * uu[q * 8 + 0] + bfhi(xq[q].x) * uu[q * 8 + 1] + bflo(xq[q].y) * uu[q * 8 + 2] + bfhi(xq[q].y) * uu[q * 8 + 3] +
                  bflo(xq[q].z) * uu[q * 8 + 4] + bfhi(xq[q].z) * uu[q * 8 + 5] + bflo(xq[q].w) * uu[q * 8 + 6] + bfhi(xq[q].w) * uu[q * 8 + 7];
        }
        d[e] = sdot;
        __builtin_amdgcn_sched_barrier(0);
      }
#pragma unroll
      for (int e = 0; e < 2; ++e) {
        const u32x2* vr = (const u32x2*)(VBl + (size_t)ex[e] * ROWB) + lane;
#pragma unroll
        for (int jc = 0; jc < 3; ++jc) vb[e][jc] = vr[jc * 64];
      }
      if (eb + 2 < 32) {
#pragma unroll
        for (int e = 0; e < 2; ++e) {
          exn[e] = __builtin_amdgcn_readfirstlane(sExp[eb + 2 + e]);
          const u32x2* ur = (const u32x2*)(UBl + (size_t)exn[e] * ROWB) + lane;
#pragma unroll
          for (int jc = 0; jc < 3; ++jc) ub[e][jc] = ur[jc * 64];
        }
      }
#pragma unroll
      for (int o = 32; o >= 1; o >>= 1) {
#pragma unroll
        for (int e = 0; e < 2; ++e) d[e] += __shfl_xor(d[e], o);
      }
#pragma unroll
      for (int e = 0; e < 2; ++e) {
        const float wg = sGate[eb + e] * gelu_f(d[e] * SUl[ex[e]]) * SVl[ex[e]];
        v6u pk;
        pk[0] = vb[e][0].x; pk[1] = vb[e][0].y; pk[2] = vb[e][1].x; pk[3] = vb[e][1].y; pk[4] = vb[e][2].x; pk[5] = vb[e][2].y;
        const v32f vv = __builtin_amdgcn_cvt_scalef32_pk32_f32_fp6(pk, 1.0f);
#pragma unroll
        for (int k = 0; k < 32; ++k) acc[k] += wg * vv[k];
        __builtin_amdgcn_sched_barrier(0);
      }
    }
    {
      float* dst = sPart + w * 2048 + lane * 32;
#pragma unroll
      for (int q = 0; q < 8; ++q) *(float4*)(dst + q * 4) = make_float4(acc[q * 4 + 0], acc[q * 4 + 1], acc[q * 4 + 2], acc[q * 4 + 3]);
    }
    __syncthreads();
    const int d0 = tid * 8;
    float r[8];
    {
      float4 a = *(const float4*)(sPart + d0), b = *(const float4*)(sPart + d0 + 4);
#pragma unroll
      for (int ww = 1; ww < 4; ++ww) {
        const float4 a2 = *(const float4*)(sPart + ww * 2048 + d0), b2 = *(const float4*)(sPart + ww * 2048 + d0 + 4);
        a.x += a2.x; a.y += a2.y; a.z += a2.z; a.w += a2.w; b.x += b2.x; b.y += b2.y; b.z += b2.z; b.w += b2.w;
      }
      r[0] = a.x; r[1] = a.y; r[2] = a.z; r[3] = a.w; r[4] = b.x; r[5] = b.y; r[6] = b.z; r[7] = b.w;
    }
    const int which = (t < TX) ? 0 : 1;
    const float* md = p.MOD + (size_t)(layer * 2 + which) * 12288;
    float* xrow = p.XA + (size_t)t * DM;
    float ss = 0.f;
#pragma unroll
    for (int hq = 0; hq < 2; ++hq) {
      const float4 xv = *(const float4*)(xrow + d0 + hq * 4);
      const float4 g2 = *(const float4*)(md + 5 * DM + d0 + hq * 4);
      float4 o;
      o.x = xv.x + g2.x * r[hq * 4 + 0]; o.y = xv.y + g2.y * r[hq * 4 + 1];
      o.z = xv.z + g2.z * r[hq * 4 + 2]; o.w = xv.w + g2.w * r[hq * 4 + 3];
      r[hq * 4 + 0] = o.x; r[hq * 4 + 1] = o.y; r[hq * 4 + 2] = o.z; r[hq * 4 + 3] = o.w;
      ss += o.x * o.x + o.y * o.y + o.z * o.z + o.w * o.w;
      if (!LAST) *(float4*)(xrow + d0 + hq * 4) = o;
    }
    ss = wave_sum(ss);
    if (lane == 0) sRed[w] = ss;
    __syncthreads();
    const float rstd = rsqrtf((sRed[0] + sRed[1] + sRed[2] + sRed[3]) * (1.f / DM) + 1e-6f);
    if (LAST) {
      float* orow = p.out + (size_t)t * DM;
#pragma unroll
      for (int hq = 0; hq < 2; ++hq) {
        const float4 g = *(const float4*)(p.norm_final + d0 + hq * 4);
        float4 o;
        o.x = r[hq * 4 + 0] * rstd * g.x; o.y = r[hq * 4 + 1] * rstd * g.y; o.z = r[hq * 4 + 2] * rstd * g.z; o.w = r[hq * 4 + 3] * rstd * g.w;
        *(float4*)(orow + d0 + hq * 4) = o;
      }
    } else {
      const float* md1 = p.MOD + (size_t)(2 + which) * 12288;
      const float* gn = p.norm_mix + DM;
      uint32_t o[4];
#pragma unroll
      for (int hq = 0; hq < 2; ++hq) {
        const float4 g = *(const float4*)(gn + d0 + hq * 4);
        const float4 sh = *(const float4*)(md1 + 0 * DM + d0 + hq * 4);
        const float4 sc = *(const float4*)(md1 + 1 * DM + d0 + hq * 4);
        const float y0 = r[hq * 4 + 0] * rstd * g.x * (1.f + sc.x) + sh.x;
        const float y1 = r[hq * 4 + 1] * rstd * g.y * (1.f + sc.y) + sh.y;
        const float y2 = r[hq * 4 + 2] * rstd * g.z * (1.f + sc.z) + sh.z;
        const float y3 = r[hq * 4 + 3] * rstd * g.w * (1.f + sc.w) + sh.w;
        o[hq * 2 + 0] = pack2(y0, y1); o[hq * 2 + 1] = pack2(y2, y3);
      }
      *(u32x4*)(p.ABUF1 + (size_t)t * DM + d0) = mk4(o[0], o[1], o[2], o[3]);
    }
    __syncthreads();
  }
}

__device__ __forceinline__ void ph_scores(const P& p, int ph, char* smem, int bid, int nb) {
  const int tid = tid_local(), lane = tid & 63, wid = tid >> 6, wr = wid >> 1, wc = wid & 1;
        const int layer = (ph == 7) ? 0 : 1;
        const int numM = (ph == 7) ? 66 : 64;
        bf16_t* sA = (bf16_t*)smem;
        bf16_t* sB = sA + 128 * LDS_S;
        for (int id = bid; id < numM * 16; id += nb) {
          const int mt = id % numM, hs = id / numM;
          f32x4 acc[4][4];
          gemm_core(acc, p.QB + (size_t)mt * 128 * DM + hs * 128, DM, p.KEYB + (size_t)(layer * 16 + hs) * 128 * 128, 128, 128, sA, sB);
#pragma unroll
          for (int mi = 0; mi < 4; ++mi)
#pragma unroll
            for (int ni = 0; ni < 4; ++ni)
#pragma unroll
              for (int j = 0; j < 4; ++j) {
                const int row = mt * 128 + wr * 64 + mi * 16 + (lane >> 4) * 4 + j;
                const int col = wc * 64 + ni * 16 + (lane & 15);
                p.SC[(size_t)row * DM + hs * 128 + col] = acc[mi][ni][j];
              }
        }
}

__device__ __forceinline__ void ph_qscores(const P& p, int layer, int M, char* smem, int bid, int nb) {
  const int tid = tid_local(), lane = tid & 63, wid = tid >> 6, wr = wid >> 1, wc = wid & 1;
  bf16_t* sA = (bf16_t*)smem;
  bf16_t* sB = sA + 128 * LDS_S;
  bf16_t* sQ = (bf16_t*)smem;
  const bf16_t* A = layer ? p.ABUF1 : p.ABUF0;
  const bf16_t* W = p.WT_PQ + (size_t)layer * DM * DM;
  const int numM = M >> 7, numN = 16, total = numM * numN;
  const int vb = ((nb & 7) == 0) ? (bid & 7) * (nb >> 3) + (bid >> 3) : bid;
  for (int id = vb; id < total; id += nb) {
    const int gsz = 8 * numN, g = id / gsz, fm = g * 8;
    const int rows = (numM - fm) < 8 ? (numM - fm) : 8;
    const int r = id - g * gsz;
    const int mt = fm + r % rows, nt = r / rows;
    f32x4 acc[4][4];
    gemm_core_t<4>(acc, A + (size_t)mt * 128 * DM, DM, W + (size_t)nt * 128 * DM, DM, DM, sA, sB);
    __syncthreads();
#pragma unroll
    for (int mi = 0; mi < 4; ++mi)
#pragma unroll
      for (int ni = 0; ni < 4; ++ni)
#pragma unroll
        for (int j = 0; j < 4; ++j)
          sQ[(wr * 64 + mi * 16 + (lane >> 4) * 4 + j) * 136 + wc * 64 + ni * 16 + (lane & 15)] = f2bf(acc[mi][ni][j]);
    __syncthreads();
    const bf16_t* Kb = p.KEYB + (size_t)(layer * 16 + nt) * 128 * 128;
    f32x4 acc2[4][4];
#pragma unroll
    for (int mi = 0; mi < 4; ++mi)
#pragma unroll
      for (int ni = 0; ni < 4; ++ni) acc2[mi][ni] = (f32x4){0.f, 0.f, 0.f, 0.f};
#pragma unroll
    for (int ks = 0; ks < 4; ++ks) {
      bf16x8 af[4], bk[4];
#pragma unroll
      for (int mi = 0; mi < 4; ++mi) af[mi] = *(const bf16x8*)(sQ + (wr * 64 + mi * 16 + (lane & 15)) * 136 + ks * 32 + (lane >> 4) * 8);
#pragma unroll
      for (int ni = 0; ni < 4; ++ni) bk[ni] = *(const bf16x8*)(Kb + (wc * 64 + ni * 16 + (lane & 15)) * 128 + ks * 32 + (lane >> 4) * 8);
#pragma unroll
      for (int mi = 0; mi < 4; ++mi)
#pragma unroll
        for (int ni = 0; ni < 4; ++ni)
          acc2[mi][ni] = __builtin_amdgcn_mfma_f32_16x16x32_bf16(af[mi], bk[ni], acc2[mi][ni], 0, 0, 0);
    }
#pragma unroll
    for (int mi = 0; mi < 4; ++mi)
#pragma unroll
      for (int ni = 0; ni < 4; ++ni)
#pragma unroll
        for (int j = 0; j < 4; ++j)
          p.SC[(size_t)(mt * 128 + wr * 64 + mi * 16 + (lane >> 4) * 4 + j) * DM + nt * 128 + wc * 64 + ni * 16 + (lane & 15)] = acc2[mi][ni][j];
  }
}

#define XB_TMO      128
#define XB_XCNT(j)  (256  + 64 * (j))
#define XB_XSUB(j)  (1280 + 64 * (j))
#define XB_XGEN(j)  (2304 + 64 * (j))
#define XB_TOP      3328
#define XB_TOPGEN   3392
#define XCD_BAR_WORDS 3456
#define XB_SPIN_CAP (1u << 22)
#define LAS __attribute__((address_space(3)))
__device__ __forceinline__ unsigned xb_ld(unsigned* p)              { return __hip_atomic_load(p, __ATOMIC_RELAXED, __HIP_MEMORY_SCOPE_AGENT); }
__device__ __forceinline__ unsigned xb_add(unsigned* p, unsigned v) { return __hip_atomic_fetch_add(p, v, __ATOMIC_RELAXED, __HIP_MEMORY_SCOPE_AGENT); }
__device__ __forceinline__ unsigned xb_xcc_id() { return (unsigned)__builtin_amdgcn_s_getreg((3 << 11) | 20) & 0xFu; }
#define XB_SPIN(cond, bar) do { unsigned _sp = 0; while (cond) { __builtin_amdgcn_s_sleep(1); \
    if ((++_sp & 255u) == 0u) { if (xb_ld(&(bar)[XB_TMO])) break; if (_sp > XB_SPIN_CAP) { atomicAdd(&(bar)[XB_TMO], 1u); break; } } } } while (0)
struct XcdBarrier { unsigned* bar; unsigned x; volatile LAS unsigned* st; };
__device__ __forceinline__ XcdBarrier xcd_barrier_post(unsigned* bar, volatile LAS unsigned* st) {
  XcdBarrier b; b.bar = bar; b.x = xb_xcc_id(); b.st = st;
  if (tid_local() == 0) (void)xb_add(&bar[XB_XCNT(b.x)], 1u);
  return b;
}
__device__ __forceinline__ void xcd_barrier_complete(unsigned* bar, unsigned x, unsigned& nloc, unsigned& nx, unsigned G) {
  unsigned sum, cnt, mine, sp = 0u;
  for (;;) {
    sum = 0u; cnt = 0u; mine = 0u;
#pragma unroll
    for (unsigned j = 0; j < 16; ++j) { const unsigned c = xb_ld(&bar[XB_XCNT(j)]); sum += c; cnt += (c > 0u) ? 1u : 0u; mine = (j == x) ? c : mine; }
    if (sum == G) break;
    __builtin_amdgcn_s_sleep(1);
    if ((++sp & 255u) == 0u) { if (xb_ld(&bar[XB_TMO])) break; if (sp > XB_SPIN_CAP) { atomicAdd(&bar[XB_TMO], 1u); break; } }
  }
  nloc = mine > 0u ? mine : 1u; nx = cnt > 0u ? cnt : 1u;
}
__device__ __forceinline__ void xcd_barrier_impl(unsigned* bar, unsigned x, volatile LAS unsigned* st, int tid_, unsigned G_) {
  asm volatile("s_waitcnt vmcnt(0)" ::: "memory");
  __syncthreads();
  if (tid_ == 0) {
    __builtin_amdgcn_s_waitcnt(0);
    const unsigned nloc = st[0], nx = st[1];
    const unsigned old = xb_add(&bar[XB_XSUB(x)], 1u);
    const unsigned gen = old / nloc;
    if (old + 1u == (gen + 1u) * nloc) {
      __builtin_amdgcn_fence(__ATOMIC_RELEASE, "agent");
      asm volatile("s_waitcnt vmcnt(0)" ::: "memory");
      const unsigned og = xb_add(&bar[XB_TOP], 1u);
      const unsigned tg = og / nx;
      if (og + 1u == (tg + 1u) * nx) xb_add(&bar[XB_TOPGEN], 1u);
      else XB_SPIN(xb_ld(&bar[XB_TOPGEN]) == tg, bar);
      __builtin_amdgcn_fence(__ATOMIC_ACQUIRE, "agent");
      xb_add(&bar[XB_XGEN(x)], 1u);
      asm volatile("s_waitcnt vmcnt(0)" ::: "memory");
    } else {
      XB_SPIN(xb_ld(&bar[XB_XGEN(x)]) == gen, bar);
      __builtin_amdgcn_fence(__ATOMIC_ACQUIRE, "agent");
      asm volatile("s_waitcnt vmcnt(0)" ::: "memory");
    }
  }
  __syncthreads();
}

template <bool COOP>
__global__ void __launch_bounds__(256, 2) mega(P p, int ph_lo, int ph_hi) {
  __shared__ __attribute__((aligned(16))) char smem[61424];
  const int bid = blockIdx.x, nb = gridDim.x;
  const int tid0 = tid_local();
#define PH_IDS int tid = tid_local(); const int lane = tid & 63, wid = tid >> 6, wr = wid >> 1, wc = wid & 1; (void)lane; (void)wr; (void)wc;
  if constexpr (COOP) { if (ph_hi < 0) cg::this_grid().sync(); }
  __shared__ uint4 xb_words;
  XcdBarrier xb;
  xb.bar = p.BAR; xb.x = 0u; xb.st = (volatile LAS unsigned*)&xb_words;
  if constexpr (COOP) {
    if (tid0 == 0) { xb.st[0] = 0u; xb.st[1] = 0u; }
    __syncthreads();
    xb = xcd_barrier_post(p.BAR, (volatile LAS unsigned*)&xb_words);
    if (tid0 == 0) {
      unsigned nloc = 1u, nx = 1u;
      xcd_barrier_complete(p.BAR, xb.x, nloc, nx, (unsigned)nb);
      xb.st[0] = nloc; xb.st[1] = nx;
    }
    __syncthreads();
  }
  {
    {
      if (PHON(0) && ph_lo <= 0 && 0 < ph_hi) { const int ph = 0; (void)ph;
        PH_IDS
        for (int rep_ = 0; rep_ < REP_P0; ++rep_) {
        ph_ada(p, smem, bid, nb, 0);
        ph_h2(p, smem, bid, nb);
        transpose_job(p.hy_w3, p.W3T, 64, 4096, 1, smem, bid, nb);
        transpose_job(p.ev_w_in, p.WT_EVIN, 2048, 5120, 1, smem, bid, nb);
        transpose_job(p.ev_w_out, p.WT_EVOUT, 2048, 2048, 1, smem, bid, nb);
        transpose_job(p.peer_q, p.WT_PQ, 2048, 2048, 1, smem, bid, nb);
        ph_small_convert(p, bid, nb);
        }
        if constexpr (COOP) if (ph + 1 < ph_hi) xcd_barrier_impl(xb.bar, xb.x, xb.st, (int)tid_local(), (unsigned)nb);
      }
      if (PHON(1) && ph_lo <= 1 && 1 < ph_hi) { const int ph = 1; (void)ph;
        PH_IDS
        for (int rep_ = 0; rep_ < REP_GEMM; ++rep_) {
        ph_norm(p.x, p.ctx, TS, p.norm_mix, p.MOD, p.MOD + 12288, 0, 1, p.ABUF0, bid, nb);
        gemm_phase(p.H2B, 64, p.W3T, 64, TS, 4096, 64, smem, bid, nb, [&](int row0, int col, f32x4 v) {
          const float ad = fabsf(p.hy_deltas[col]);
          float o[4];
#pragma unroll
          for (int j = 0; j < 4; ++j) {
            const int row = row0 + j;
            const float tn = row < TX ? (float)row * (1.f / 8191.f) : (float)(row - TX) * (1.f / 255.f);
            o[j] = v[j] * __expf(-tn * ad);
          }
          *(u32x2*)(p.FILT + (size_t)col * TS + row0) = mk2(pack2(o[0], o[1]), pack2(o[2], o[3]));
        });
        }
        if constexpr (COOP) if (ph + 1 < ph_hi) xcd_barrier_impl(xb.bar, xb.x, xb.st, (int)tid_local(), (unsigned)nb);
      }
      if (PHON(2) && ph_lo <= 2 && 2 < ph_hi) { const int ph = 2; (void)ph;
        PH_IDS
        for (int rep_ = 0; rep_ < REP_GEMM; ++rep_) {
        gemm_phase(p.ABUF0, DM, p.WT_EVIN, DM, TS, 5120, DM, smem, bid, nb, [&](int row0, int col, f32x4 v) {
          float4 o;
          if (col < 3072) { o.x = v[0]; o.y = v[1]; o.z = v[2]; o.w = v[3]; }
          else { o.x = gelu_f(v[0]); o.y = gelu_f(v[1]); o.z = gelu_f(v[2]); o.w = gelu_f(v[3]); }
          *(float4*)(p.PROJT + (size_t)col * TS + row0) = o;
        });
        }
        if constexpr (COOP) if (ph + 1 < ph_hi) xcd_barrier_impl(xb.bar, xb.x, xb.st, (int)tid_local(), (unsigned)nb);
      }
      if (PHON(3) && ph_lo <= 3 && 3 < ph_hi) { const int ph = 3; (void)ph;
        PH_IDS
        for (int rep_ = 0; rep_ < REP_P3; ++rep_) {
        const bool conv_first = ((bid / (nb >> 1)) & 1) != 0;
#define LATE_PREP() { ph_tables(p, bid, nb); __syncthreads(); ph_ada(p, smem, bid, nb, 1); \
          transpose_job(p.od_w_in, p.WT_ODIN, 2048, 3072, 1, smem, bid, nb); \
          transpose_job(p.od_w_out, p.WT_ODOUT, 2048, 2048, 1, smem, bid, nb); \
          transpose_job(p.peer_q + (size_t)DM * DM, p.WT_PQ + (size_t)DM * DM, 2048, 2048, 1, smem, bid, nb); \
          transpose_job(p.pool_w, p.WTPOOL, 256, 256, 4, smem, bid, nb); __syncthreads(); }
        if (conv_first) LATE_PREP()
        for (int item = bid; item < 2048 + 528; item += nb) {
          if (item < 1024) hyena_item<0>(p, smem, item);
          else if (item < 2048) hyena_item<1>(p, smem, item - 1024);
          else gmlp_item(p, smem, (item - 2048) >> 3, (item - 2048) & 7);
        }
        if (!conv_first) LATE_PREP()
        }
        if constexpr (COOP) if (ph + 1 < ph_hi) xcd_barrier_impl(xb.bar, xb.x, xb.st, (int)tid_local(), (unsigned)nb);
      }
      if (PHON(4) && ph_lo <= 4 && 4 < ph_hi) { const int ph = 4; (void)ph;
        PH_IDS
        for (int rep_ = 0; rep_ < REP_GEMM; ++rep_) {
        gemm_phase(p.ABUF1, DM, p.WT_EVOUT, DM, TS, DM, DM, smem, bid, nb, [&](int row0, int col, f32x4 v) {
#pragma unroll
          for (int j = 0; j < 4; ++j) {
            const int row = row0 + j;
            const float base = row < TX ? p.x[(size_t)row * DM + col] : p.ctx[(size_t)(row - TX) * DM + col];
            const float g = p.MOD[(size_t)(row < TX ? 0 : 1) * 12288 + 2 * DM + col];
            p.XA[(size_t)row * DM + col] = base + g * v[j];
          }
        });
        }
        if constexpr (COOP) if (ph + 1 < ph_hi) xcd_barrier_impl(xb.bar, xb.x, xb.st, (int)tid_local(), (unsigned)nb);
      }
      if (PHON(5) && ph_lo <= 5 && 5 < ph_hi) { const int ph = 5; (void)ph;
        PH_IDS
        ph_norm(p.XA, p.XA + (size_t)TX * DM, TS, p.norm_ffn, p.MOD, p.MOD + 12288, 3, 4, p.ABUF0, bid, nb);
        if constexpr (COOP) if (ph + 1 < ph_hi) xcd_barrier_impl(xb.bar, xb.x, xb.st, (int)tid_local(), (unsigned)nb);
      }
      if (PHON(6) && ph_lo <= 6 && 6 < ph_hi) { const int ph = 6; (void)ph;
        ph_qscores(p, 0, TS, smem, bid, nb);
        if constexpr (COOP) if (ph + 1 < ph_hi) xcd_barrier_impl(xb.bar, xb.x, xb.st, (int)tid_local(), (unsigned)nb);
      }
      if (PHON(8) && ph_lo <= 8 && 8 < ph_hi) { const int ph = 8; (void)ph;
        PH_IDS
        ph_peer<0>(p, 0, TS, smem, bid, nb);
        if constexpr (COOP) if (ph + 1 < ph_hi) xcd_barrier_impl(xb.bar, xb.x, xb.st, (int)tid_local(), (unsigned)nb);
      }
      if (PHON(9) && ph_lo <= 9 && 9 < ph_hi) { const int ph = 9; (void)ph;
        PH_IDS
        for (int rep_ = 0; rep_ < REP_GEMM; ++rep_) {
        gemm_phase(p.ABUF1, DM, p.WT_ODIN, DM, TS, 3072, DM, smem, bid, nb, [&](int row0, int col, f32x4 v) {
#pragma unroll
          for (int j = 0; j < 4; ++j) p.PROJ1[(size_t)(row0 + j) * 3072 + col] = (col < 1024) ? gelu_f(v[j]) : v[j];
        });
        }
        if constexpr (COOP) if (ph + 1 < ph_hi) xcd_barrier_impl(xb.bar, xb.x, xb.st, (int)tid_local(), (unsigned)nb);
      }
      if (PHON(10) && ph_lo <= 10 && 10 < ph_hi) { const int ph = 10; (void)ph;
        PH_IDS
        for (int rep_ = 0; rep_ < REP_L1S; ++rep_) {
        for (int idx = bid * 256 + tid; idx < TS * 256; idx += nb * 256) {
          const int t = idx >> 8, c4 = (idx & 255) * 4;
          const int lo = t < TX ? 0 : TX, hi = t < TX ? TX : TS;
          float4 a = *(const float4*)(p.od_conv_b + c4);
#pragma unroll
          for (int k = 0; k < 4; ++k) {
            const int tt = t + k - 1;
            if (tt >= lo && tt < hi) {
              const float4 xv = *(const float4*)(p.PROJ1 + (size_t)tt * 3072 + 1024 + c4);
              const float4 wv = *(const float4*)(p.od_conv_w + k * 1024 + c4);
              a.x += wv.x * xv.x; a.y += wv.y * xv.y; a.z += wv.z * xv.z; a.w += wv.w * xv.w;
            }
          }
          *(float4*)(p.XR + (size_t)t * 1024 + c4) = a;
          *(u32x2*)(p.XRB + (size_t)t * 1024 + c4) = mk2(pack2(a.x, a.y), pack2(a.z, a.w));
        }
        for (int idx = bid * 256 + tid; idx < TX * 256; idx += nb * 256) {
          const int t = idx >> 8, c4 = (idx & 255) * 4;
          const int half = 1 << (c4 >> 8);
          const int lo = (t - half) < 0 ? 0 : (t - half);
          const int hi = (t + half) > TX ? TX : (t + half);
          float4 s = make_float4(0.f, 0.f, 0.f, 0.f);
          for (int q = lo; q < hi; ++q) {
            const float4 xv = *(const float4*)(p.PROJ1 + (size_t)q * 3072 + 2048 + c4);
            s.x += xv.x; s.y += xv.y; s.z += xv.z; s.w += xv.w;
          }
          const float inv = 1.f / (float)(hi - lo);
          const float4 x0 = *(const float4*)(p.PROJ1 + (size_t)t * 3072 + 2048 + c4);
          *(u32x2*)(p.PD + (size_t)t * 1024 + c4) = mk2(pack2(s.x * inv - x0.x, s.y * inv - x0.y), pack2(s.z * inv - x0.z, s.w * inv - x0.w));
        }
        }
        if constexpr (COOP) if (ph + 1 < ph_hi) xcd_barrier_impl(xb.bar, xb.x, xb.st, (int)tid_local(), (unsigned)nb);
      }
      if (PHON(11) && ph_lo <= 11 && 11 < ph_hi) { const int ph = 11; (void)ph;
        PH_IDS
        for (int rep_ = 0; rep_ < REP_L1S; ++rep_) {
        bf16_t* sA = (bf16_t*)smem;
        bf16_t* sB = sA + 128 * LDS_S;
        for (int id = bid; id < 2112 + 512; id += nb) {
          f32x4 acc[4][4];
          if (id < 2112) {
            const int mt = id % 66, g = id / 66, dir = g >> 4, hh = g & 15, h = hh >> 1, half = hh & 1;
            gemm_core(acc, p.XRB + (size_t)mt * 128 * 1024 + h * 128, 1024, p.WG + (size_t)(dir * 16 + hh) * 128 * 128, 128, 128, sA, sB);
#pragma unroll
            for (int gq = 0; gq < 2; ++gq) {
              const int c = h * 128 + half * 64 + (wc * 2 + gq) * 16 + (lane & 15);
              const float ba = p.lru_ba[dir * 1024 + c], bx = p.lru_bx[dir * 1024 + c];
              const float sp = log1pf(expf(-p.lru_lam[dir * 1024 + c]));
#pragma unroll
              for (int mi = 0; mi < 4; ++mi)
#pragma unroll
                for (int j = 0; j < 4; ++j) {
                  const int t = mt * 128 + wr * 64 + mi * 16 + (lane >> 4) * 4 + j;
                  const float r = sigmoid_f(acc[mi][2 * gq][j] + ba);
                  const float ii = sigmoid_f(acc[mi][2 * gq + 1][j] + bx);
                  const float la = -8.f * r * sp;
                  const float a = expf(la);
                  const float b = sqrtf(-expm1f(2.f * la)) * ii * p.XR[(size_t)t * 1024 + c];
                  p.ABA[((size_t)dir * TS + t) * 1024 + c] = a;
                  p.ABB[((size_t)dir * TS + t) * 1024 + c] = b;
                }
            }
          } else {
            const int id2 = id - 2112, mt = id2 & 63, rest = id2 >> 6, g = rest >> 1, nh = rest & 1;
            gemm_core(acc, p.PD + (size_t)mt * 128 * 1024 + g * 256, 1024, p.WTPOOL + (size_t)g * 256 * 256 + (size_t)nh * 128 * 256, 256, 256, sA, sB);
#pragma unroll
            for (int mi = 0; mi < 4; ++mi)
#pragma unroll
              for (int ni = 0; ni < 4; ++ni) {
                const int cc = g * 256 + nh * 128 + wc * 64 + ni * 16 + (lane & 15);
                const float pb = p.pool_b[cc], ps = p.pool_scale[cc];
#pragma unroll
                for (int j = 0; j < 4; ++j) {
                  const int t = mt * 128 + wr * 64 + mi * 16 + (lane >> 4) * 4 + j;
                  p.ABUF0[(size_t)t * DM + 1024 + cc] = f2bf((acc[mi][ni][j] + pb) * ps);
                }
              }
          }
        }
        }
        if constexpr (COOP) if (ph + 1 < ph_hi) xcd_barrier_impl(xb.bar, xb.x, xb.st, (int)tid_local(), (unsigned)nb);
      }
      if (PHON(12) && ph_lo <= 12 && 12 < ph_hi) { const int ph = 12; (void)ph;
        PH_IDS
        for (int rep_ = 0; rep_ < REP_L1S; ++rep_) {
        for (int item = bid; item < 2 * 132 * 4; item += nb) {
          const int dir = item / 528, rem = item % 528, k = rem >> 2, c = (rem & 3) * 256 + tid;
          const float* pa = p.ABA + (size_t)dir * TS * 1024 + c;
          const float* pb = p.ABB + (size_t)dir * TS * 1024 + c;
          float Pp = 1.f, H = 0.f;
#pragma unroll 8
          for (int s = 0; s < 64; ++s) {
            const int t = dir ? (k * 64 + 63 - s) : (k * 64 + s);
            const float a = pa[(size_t)t * 1024], b = pb[(size_t)t * 1024];
            H = a * H + b; Pp *= a;
          }
          p.AGG[(size_t)(dir * 132 + k) * 1024 + c] = make_float2(Pp, H);
        }
        }
        if constexpr (COOP) if (ph + 1 < ph_hi) xcd_barrier_impl(xb.bar, xb.x, xb.st, (int)tid_local(), (unsigned)nb);
      }
      if (PHON(13) && ph_lo <= 13 && 13 < ph_hi) { const int ph = 13; (void)ph;
        PH_IDS
        for (int rep_ = 0; rep_ < REP_L1S; ++rep_) {
        float* hf = (float*)smem;
        for (int item = bid; item < 1024; item += nb) {
          const int k = item >> 3, cb = item & 7, cl = tid & 127, c = cb * 128 + cl, dir = tid >> 7;
          const float2* ag = p.AGG + (size_t)dir * 132 * 1024 + c;
          const int npre = 4 + (dir ? (127 - k) : k);
          float h = 0.f;
#pragma unroll 8
          for (int v = 0; v < npre; ++v) {
            const int q = dir ? (v < 4 ? 131 - v : 131 - v) : (v < 4 ? 128 + v : v - 4);
            const float2 g = ag[(size_t)q * 1024];
            h = g.x * h + g.y;
          }
          const float* pa = p.ABA + (size_t)dir * TS * 1024 + c;
          const float* pb = p.ABB + (size_t)dir * TS * 1024 + c;
          if (dir == 0) {
#pragma unroll 8
            for (int s = 0; s < 64; ++s) {
              const int t = k * 64 + s;
              h = pa[(size_t)t * 1024] * h + pb[(size_t)t * 1024];
              hf[s * 128 + cl] = h;
            }
          }
          __syncthreads();
          if (dir == 1) {
#pragma unroll 8
            for (int s = 63; s >= 0; --s) {
              const int t = k * 64 + s;
              h = pa[(size_t)t * 1024] * h + pb[(size_t)t * 1024];
              const float y = p.PROJ1[(size_t)t * 3072 + c] * (hf[s * 128 + cl] + h);
              p.ABUF0[(size_t)t * DM + c] = f2bf(y);
            }
          }
          __syncthreads();
        }
        }
        if constexpr (COOP) if (ph + 1 < ph_hi) xcd_barrier_impl(xb.bar, xb.x, xb.st, (int)tid_local(), (unsigned)nb);
      }
      if (PHON(14) && ph_lo <= 14 && 14 < ph_hi) { const int ph = 14; (void)ph;
        PH_IDS
        gemm_phase(p.ABUF0, DM, p.WT_ODOUT, DM, TX, DM, DM, smem, bid, nb, [&](int row0, int col, f32x4 v) {
          const float g = p.MOD[(size_t)2 * 12288 + 2 * DM + col];
#pragma unroll
          for (int j = 0; j < 4; ++j) {
            float* d = p.XA + (size_t)(row0 + j) * DM + col;
            *d = *d + g * v[j];
          }
        });
        if constexpr (COOP) if (ph + 1 < ph_hi) xcd_barrier_impl(xb.bar, xb.x, xb.st, (int)tid_local(), (unsigned)nb);
      }
      if (PHON(15) && ph_lo <= 15 && 15 < ph_hi) { const int ph = 15; (void)ph;
        PH_IDS
        ph_norm(p.XA, p.XA + (size_t)TX * DM, TX, p.norm_ffn + DM, p.MOD + 2 * 12288, p.MOD + 3 * 12288, 3, 4, p.ABUF1, bid, nb);
        if constexpr (COOP) if (ph + 1 < ph_hi) xcd_barrier_impl(xb.bar, xb.x, xb.st, (int)tid_local(), (unsigned)nb);
      }
      if (PHON(16) && ph_lo <= 16 && 16 < ph_hi) { const int ph = 16; (void)ph;
        ph_qscores(p, 1, TX, smem, bid, nb);
        if constexpr (COOP) if (ph + 1 < ph_hi) xcd_barrier_impl(xb.bar, xb.x, xb.st, (int)tid_local(), (unsigned)nb);
      }
      if (PHON(18) && ph_lo <= 18 && 18 < ph_hi) { const int ph = 18; (void)ph;
        PH_IDS
        for (int rep_ = 0; rep_ < REP_P18; ++rep_) {
        ph_peer<1>(p, 1, TX, smem, bid, nb);
        }
        if constexpr (COOP) if (ph + 1 < ph_hi) xcd_barrier_impl(xb.bar, xb.x, xb.st, (int)tid_local(), (unsigned)nb);
      }
    }
  }
}

extern "C" void kernel_launch(void* const* d_in, const int* in_sizes, int n_in, void* d_out, int out_size, void* d_ws,
                              size_t ws_size, hipStream_t stream) {
  P p{};
  const float** pin = (const float**)&p;
  for (int i = 0; i < 40; ++i) pin[i] = (const float*)d_in[i];
  p.out = (float*)d_out;
  char* ws = (char*)d_ws;
  size_t off = 0;
  auto alloc = [&](size_t bytes) { char* r = ws + off; off += (bytes + 255) & ~(size_t)255; return r; };
  p.MOD = (float*)alloc(4 * 12288 * 4);
  p.H2B = (bf16_t*)alloc((size_t)TS * 64 * 2);
  p.W3T = (bf16_t*)alloc((size_t)4096 * 64 * 2);
  p.WT_EVIN = (bf16_t*)alloc((size_t)5120 * 2048 * 2);
  p.WT_EVOUT = (bf16_t*)alloc((size_t)2048 * 2048 * 2);
  p.WT_ODIN = (bf16_t*)alloc((size_t)3072 * 2048 * 2);
  p.WT_ODOUT = (bf16_t*)alloc((size_t)2048 * 2048 * 2);
  p.WT_PQ = (bf16_t*)alloc((size_t)2 * 2048 * 2048 * 2);
  p.WG = (bf16_t*)alloc((size_t)2 * 16 * 128 * 128 * 2);
  p.KEYB = (bf16_t*)alloc((size_t)2 * 16 * 128 * 128 * 2);
  p.GMWS = (bf16_t*)alloc((size_t)8 * 128 * 128 * 2);
  p.WTPOOL = (bf16_t*)alloc((size_t)4 * 256 * 256 * 2);
  p.UB = (unsigned char*)alloc((size_t)2 * 16384 * 2048);
  p.VB = (unsigned char*)alloc((size_t)2 * 16384 * 2048);
  p.SU = (float*)alloc((size_t)2 * 16384 * 4);
  p.SV = (float*)alloc((size_t)2 * 16384 * 4);
  p.ABUF0 = (bf16_t*)alloc((size_t)TS * DM * 2);
  p.ABUF1 = (bf16_t*)alloc((size_t)TS * DM * 2);
  {
    char* r1 = alloc((size_t)5120 * TS * 4);
    p.PROJT = (float*)r1;
    p.PROJ1 = (float*)r1;
    p.XR = (float*)(r1 + (size_t)TS * 3072 * 4);
    p.XRB = (bf16_t*)(r1 + (size_t)TS * 3072 * 4 + (size_t)TS * 1024 * 4);
    p.PD = (bf16_t*)(r1 + (size_t)TS * 3072 * 4 + (size_t)TS * 1024 * 4 + (size_t)TS * 1024 * 2);
  }
  {
    char* r2 = alloc((size_t)2 * 2 * TS * 1024 * 4);
    p.FILT = (bf16_t*)r2;
    p.Z1 = (float*)(r2 + (size_t)4096 * TS * 2);
    p.ABA = (float*)r2;
    p.ABB = (float*)(r2 + (size_t)2 * TS * 1024 * 4);
  }
  p.XA = (float*)alloc((size_t)TS * DM * 4);
  p.QB = (bf16_t*)alloc((size_t)TS * DM * 2);
  p.SC = (float*)alloc((size_t)TS * DM * 4);
  p.AGG = (float2*)alloc((size_t)2 * 132 * 1024 * 8);
  p.BAR = (unsigned*)alloc(XCD_BAR_WORDS * 4);
  if (off > ws_size) { fprintf(stderr, "workspace too small: need %zu have %zu\n", off, ws_size); return; }

#if ONE_LAUNCH
  static int grid_blocks = 0;
  if (!grid_blocks) {
    int dev = 0, cus = 0, per_cu = 0;
    hipGetDevice(&dev);
    hipDeviceGetAttribute(&cus, hipDeviceAttributeMultiprocessorCount, dev);
    hipOccupancyMaxActiveBlocksPerMultiprocessor(&per_cu, mega<true>, 256, 0);
    if (per_cu > 2) per_cu = 2;
    grid_blocks = cus * per_cu;
  }
  int lo = 0, hi = NPH;
  void* args[] = {&p, &lo, &hi};
  hipMemsetAsync(p.BAR, 0, XCD_BAR_WORDS * 4, stream);
  hipError_t e = hipLaunchCooperativeKernel((void*)mega<true>, dim3(grid_blocks), dim3(256), args, 0, stream);
  if (e != hipSuccess) fprintf(stderr, "cooperative launch failed: %s (grid %d)\n", hipGetErrorString(e), grid_blocks);
#else
  for (int ph = 0; ph < NPH; ++ph) mega<false><<<512, 256, 0, stream>>>(p, ph, ph + 1);
#endif
}
```

```cpp
#include <hip/hip_runtime.h>
#include <hip/hip_cooperative_groups.h>
#include <stdint.h>
#include <cstdio>
namespace cg = cooperative_groups;

#ifndef ONE_LAUNCH
#define ONE_LAUNCH 1
#endif

typedef unsigned short bf16_t;
using bf16x8 = __attribute__((ext_vector_type(8))) short;
using f32x4 = __attribute__((ext_vector_type(4))) float;
using u32x4 = __attribute__((ext_vector_type(4))) unsigned int;
using u32x2 = __attribute__((ext_vector_type(2))) unsigned int;
__device__ __forceinline__ u32x4 mk4(unsigned a, unsigned b, unsigned c, unsigned d) { u32x4 r; r.x = a; r.y = b; r.z = c; r.w = d; return r; }
__device__ __forceinline__ u32x2 mk2(unsigned a, unsigned b) { u32x2 r; r.x = a; r.y = b; return r; }

#define TS 8448
#define TX 8192
#define DM 2048
#define NPH 19
#ifndef ONLY_PH
#define ONLY_PH -1
#endif
#define PHON(k) (ONLY_PH < 0 || ONLY_PH == (k))
#ifndef REP_P0
#define REP_P0 1
#endif
#ifndef REP_GEMM
#define REP_GEMM 1
#endif
#ifndef REP_P3
#define REP_P3 1
#endif
#ifndef REP_P18
#define REP_P18 1
#endif
#ifndef REP_TOPK
#define REP_TOPK 1
#endif
#ifndef REP_L1S
#define REP_L1S 1
#endif

struct P {
  const float *x, *c, *ctx, *cctx, *ada_w, *ada_b, *norm_mix, *norm_ffn, *norm_final;
  const float *ev_w_in, *ev_conv_w, *ev_conv_b, *hy_w1, *hy_b1, *hy_w2, *hy_b2, *hy_w3, *hy_freq, *hy_deltas, *hy_bias;
  const float *gm_norm, *gm_ws, *gm_bs, *ev_w_out;
  const float *od_w_in, *od_conv_w, *od_conv_b, *lru_wa, *lru_ba, *lru_wx, *lru_bx, *lru_lam, *pool_w, *pool_b, *pool_scale, *od_w_out;
  const float *peer_q, *peer_keys, *peer_u, *peer_v;
  float* out;
  float* MOD;
  bf16_t* H2B;
  bf16_t* W3T;
  bf16_t* WT_EVIN;
  bf16_t* WT_EVOUT;
  bf16_t* WT_ODIN;
  bf16_t* WT_ODOUT;
  bf16_t* WT_PQ;
  bf16_t* WG;
  bf16_t* KEYB;
  bf16_t* GMWS;
  bf16_t* WTPOOL;
  unsigned char* UB;
  unsigned char* VB;
  float* SU;
  float* SV;
  bf16_t* ABUF0;
  bf16_t* ABUF1;
  float* PROJT;
  float* PROJ1;
  float* XR;
  bf16_t* XRB;
  bf16_t* PD;
  bf16_t* FILT;
  float* Z1;
  float* ABA;
  float* ABB;
  float* XA;
  bf16_t* QB;
  float* SC;
  float2* AGG;
  unsigned* BAR;
};

__device__ __forceinline__ int tid_local() { int t_ = (int)threadIdx.x; asm volatile("" : "+v"(t_)); return t_; }
__device__ __forceinline__ bf16_t f2bf(float f) {
  uint32_t u = __float_as_uint(f);
  u += 0x7FFFu + ((u >> 16) & 1u);
  return (bf16_t)(u >> 16);
}
__device__ __forceinline__ float bf2f(bf16_t b) { return __uint_as_float(((uint32_t)b) << 16); }
__device__ __forceinline__ uint32_t pack2(float a, float b) { return (uint32_t)f2bf(a) | ((uint32_t)f2bf(b) << 16); }
__device__ __forceinline__ float bflo(uint32_t u) { return __uint_as_float(u << 16); }
__device__ __forceinline__ float bfhi(uint32_t u) { return __uint_as_float(u & 0xFFFF0000u); }
__device__ __forceinline__ float gelu_f(float x) {
  float u = 0.7978845608028654f * (x + 0.044715f * x * x * x);
  return x / (1.f + __expf(-2.f * u));
}
__device__ __forceinline__ float sigmoid_f(float x) { return 1.f / (1.f + __expf(-x)); }
__device__ __forceinline__ float wave_sum(float v) {
#pragma unroll
  for (int o = 32; o >= 1; o >>= 1) v += __shfl_xor(v, o);
  return v;
}
__device__ __forceinline__ uint32_t wave_max_u32(uint32_t v) {
#pragma unroll
  for (int o = 32; o >= 1; o >>= 1) { uint32_t t = (uint32_t)__shfl_xor((int)v, o); v = v > t ? v : t; }
  return v;
}
__device__ __forceinline__ uint32_t fkey(float f) { uint32_t u = __float_as_uint(f); return (u & 0x80000000u) ? ~u : (u | 0x80000000u); }
__device__ __forceinline__ float funkey(uint32_t k) { uint32_t u = (k & 0x80000000u) ? (k & 0x7FFFFFFFu) : ~k; return __uint_as_float(u); }

#define LDS_S 72
template <int NI>
__device__ __forceinline__ void gemm_core_t(f32x4 (&acc)[4][NI], const bf16_t* __restrict__ A, int lda,
                                            const bf16_t* __restrict__ Bt, int ldb, int K, bf16_t* sA, bf16_t* sB) {
  const int tid = tid_local(), lane = tid & 63, wid = tid >> 6, wr = wid >> 1, wc = wid & 1;
  const int lr = tid >> 3, lc = (tid & 7) * 8;
#pragma unroll
  for (int i = 0; i < 4; ++i)
#pragma unroll
    for (int j = 0; j < NI; ++j) acc[i][j] = (f32x4){0.f, 0.f, 0.f, 0.f};
  u32x4 ra[4], rb[NI];
#pragma unroll
  for (int i = 0; i < 4; ++i) ra[i] = *(const u32x4*)(A + (size_t)(lr + 32 * i) * lda + lc);
#pragma unroll
  for (int i = 0; i < NI; ++i) rb[i] = *(const u32x4*)(Bt + (size_t)(lr + 32 * i) * ldb + lc);
  const int nk = K >> 6;
  for (int kt = 0; kt < nk; ++kt) {
    __syncthreads();
#pragma unroll
    for (int i = 0; i < 4; ++i) *(u32x4*)(sA + (lr + 32 * i) * LDS_S + lc) = ra[i];
#pragma unroll
    for (int i = 0; i < NI; ++i) *(u32x4*)(sB + (lr + 32 * i) * LDS_S + lc) = rb[i];
    __syncthreads();
    if (kt + 1 < nk) {
      const int ko = (kt + 1) * 64;
#pragma unroll
      for (int i = 0; i < 4; ++i) ra[i] = *(const u32x4*)(A + (size_t)(lr + 32 * i) * lda + ko + lc);
#pragma unroll
      for (int i = 0; i < NI; ++i) rb[i] = *(const u32x4*)(Bt + (size_t)(lr + 32 * i) * ldb + ko + lc);
    }
    __builtin_amdgcn_sched_barrier(0);
    bf16x8 af[2][4], bfr[2][NI];
#pragma unroll
    for (int ks = 0; ks < 2; ++ks) {
#pragma unroll
      for (int mi = 0; mi < 4; ++mi)
        af[ks][mi] = *(const bf16x8*)(sA + (wr * 64 + mi * 16 + (lane & 15)) * LDS_S + ks * 32 + (lane >> 4) * 8);
#pragma unroll
      for (int ni = 0; ni < NI; ++ni)
        bfr[ks][ni] = *(const bf16x8*)(sB + (wc * 16 * NI + ni * 16 + (lane & 15)) * LDS_S + ks * 32 + (lane >> 4) * 8);
    }
#pragma unroll
    for (int ks = 0; ks < 2; ++ks)
#pragma unroll
      for (int mi = 0; mi < 4; ++mi)
#pragma unroll
        for (int ni = 0; ni < NI; ++ni)
          acc[mi][ni] = __builtin_amdgcn_mfma_f32_16x16x32_bf16(af[ks][mi], bfr[ks][ni], acc[mi][ni], 0, 0, 0);
  }
}
__device__ __forceinline__ void gemm_core(f32x4 (&acc)[4][4], const bf16_t* __restrict__ A, int lda,
                                          const bf16_t* __restrict__ Bt, int ldb, int K, bf16_t* sA, bf16_t* sB) {
  gemm_core_t<4>(acc, A, lda, Bt, ldb, K, sA, sB);
}

template <class Epi>
__device__ __forceinline__ void gemm_phase(const bf16_t* A, int lda, const bf16_t* Bt, int ldb, int M, int N, int K,
                                           char* smem, int bid, int nb, Epi epi) {
  const int numM = M >> 7, numN = N >> 7;
  bf16_t* sA = (bf16_t*)smem;
  bf16_t* sB = sA + 128 * LDS_S;
  const int lane = tid_local() & 63, wid = tid_local() >> 6, wr = wid >> 1, wc = wid & 1;
  const int total = numM * numN;
  const int full = (total / nb) * nb;
  const int vb = ((nb & 7) == 0) ? (bid & 7) * (nb >> 3) + (bid >> 3) : bid;
  auto tile_of = [&](int id, int& mt, int& nt) {
    const int gsz = 8 * numN, g = id / gsz, fm = g * 8;
    const int rows = (numM - fm) < 8 ? (numM - fm) : 8;
    const int r = id - g * gsz;
    mt = fm + r % rows; nt = r / rows;
  };
  for (int id = vb; id < full; id += nb) {
    int mt, nt;
    tile_of(id, mt, nt);
    f32x4 acc[4][4];
    gemm_core_t<4>(acc, A + (size_t)mt * 128 * lda, lda, Bt + (size_t)nt * 128 * ldb, ldb, K, sA, sB);
#pragma unroll
    for (int mi = 0; mi < 4; ++mi)
#pragma unroll
      for (int ni = 0; ni < 4; ++ni)
        epi(mt * 128 + wr * 64 + mi * 16 + (lane >> 4) * 4, nt * 128 + wc * 64 + ni * 16 + (lane & 15), acc[mi][ni]);
  }
  for (int u = vb; u < (total - full) * 4; u += nb) {
    const int id = full + (u >> 2), qd = u & 3;
    int mt, nt;
    tile_of(id, mt, nt);
    f32x4 acc[4][1];
    gemm_core_t<1>(acc, A + (size_t)mt * 128 * lda, lda, Bt + (size_t)(nt * 128 + qd * 32) * ldb, ldb, K, sA, sB);
#pragma unroll
    for (int mi = 0; mi < 4; ++mi)
      epi(mt * 128 + wr * 64 + mi * 16 + (lane >> 4) * 4, nt * 128 + qd * 32 + wc * 16 + (lane & 15), acc[mi][0]);
  }
}

__device__ __forceinline__ void ph_ada(const P& p, char* smem, int bid, int nb, int layer) {
  float* sc = (float*)smem;
  float* sx = sc + 2048;
  float* red = sx + 2048;
  const int tid = tid_local();
  bool loaded = false;
  for (int item0 = bid; item0 < 384; item0 += nb) {
    const int item = item0 + layer * 384;
    if (!loaded) {
      for (int i = tid; i < 2048; i += 256) {
        float v = p.c[i]; sc[i] = v * sigmoid_f(v);
        float w = p.cctx[i]; sx[i] = w * sigmoid_f(w);
      }
      __syncthreads();
      loaded = true;
    }
    const int l = item / 384, cgp = item % 384;
    const int col = cgp * 32 + (tid & 31), kg = tid >> 5;
    const float* w = p.ada_w + (size_t)l * 2048 * 12288 + col;
    float a0 = 0.f, a1 = 0.f;
#pragma unroll 16
    for (int k = kg; k < 2048; k += 8) {
      float wv = w[(size_t)k * 12288];
      a0 += sc[k] * wv; a1 += sx[k] * wv;
    }
    red[(kg * 32 + (tid & 31)) * 2 + 0] = a0;
    red[(kg * 32 + (tid & 31)) * 2 + 1] = a1;
    __syncthreads();
    if (tid < 64) {
      const int cc = tid & 31, which = tid >> 5;
      float s = 0.f;
#pragma unroll
      for (int g = 0; g < 8; ++g) s += red[(g * 32 + cc) * 2 + which];
      const int colo = cgp * 32 + cc;
      p.MOD[(size_t)(l * 2 + which) * 12288 + colo] = s + p.ada_b[l * 12288 + colo];
    }
    __syncthreads();
  }
  __syncthreads();
}

__device__ __forceinline__ void ph_h2(const P& p, char* smem, int bid, int nb) {
  float* feats = (float*)smem;
  float* h1 = feats + 160;
  float* w1s = feats + 512;
  float* w2s = w1s + 33 * 64;
  const int tid = tid_local(), r = tid >> 6, j = tid & 63;
  if (bid < 2112) {
    for (int i = tid; i < 33 * 64; i += 256) w1s[i] = p.hy_w1[i];
    for (int i = tid; i < 64 * 64; i += 256) w2s[i] = p.hy_w2[i];
  }
  const float b1 = p.hy_b1[j], b2 = p.hy_b2[j], fr = p.hy_freq[j];
  __syncthreads();
  for (int item = bid; item < 2112; item += nb) {
    const int row = item * 4 + r;
    const int L = row < TX ? TX : 256;
    const int t = row < TX ? row : row - TX;
    if (j < 33) {
      const float tn = (float)t / (float)(L - 1);
      float f;
      if (j == 0) f = tn;
      else {
        const int bi = (j - 1) & 15;
        const float band = 1e-4f + (float)bi * ((15.f - 1e-4f) / 15.f);
        const float ang = (6.283185307179586f / (float)L) * (float)t * band;
        f = (j <= 16) ? cosf(ang) : -sinf(ang);
      }
      feats[r * 36 + j] = f;
    }
    __syncthreads();
    float a = b1;
#pragma unroll
    for (int i = 0; i < 33; ++i) a += feats[r * 36 + i] * w1s[i * 64 + j];
    h1[r * 64 + j] = sinf(fr * a);
    __syncthreads();
    float a2 = b2;
#pragma unroll 16
    for (int i = 0; i < 64; ++i) a2 += h1[r * 64 + i] * w2s[i * 64 + j];
    p.H2B[(size_t)row * 64 + j] = f2bf(sinf(fr * a2));
  }
  __syncthreads();
}

using f32x2 = __attribute__((ext_vector_type(2))) float;
#ifndef FP6_ORDER
#define FP6_ORDER 1
#endif
using v16f = __attribute__((ext_vector_type(16))) float;
using v32f = __attribute__((ext_vector_type(32))) float;
using v6u = __attribute__((ext_vector_type(6))) unsigned int;
#define ROWB 1536
__device__ __forceinline__ void ph_tables(const P& p, int bid, int nb) {
  const int lane = tid_local() & 63, w = tid_local() >> 6;
  for (int r = bid * 4 + w; r < 65536; r += nb * 4) {
    const int tb = r >> 15, row = r & 32767;
    const float* src = (tb ? p.peer_v : p.peer_u) + (size_t)row * 2048 + lane * 32;
    unsigned char* dst = (tb ? p.VB : p.UB) + (size_t)row * ROWB;
    f32x4 v[8];
    float amax = 0.f;
#pragma unroll
    for (int q = 0; q < 8; ++q) {
      v[q] = *(const f32x4*)(src + q * 4);
      amax = fmaxf(amax, fmaxf(fmaxf(fabsf(v[q].x), fabsf(v[q].y)), fmaxf(fabsf(v[q].z), fabsf(v[q].w))));
    }
#pragma unroll
    for (int o = 32; o >= 1; o >>= 1) amax = fmaxf(amax, __shfl_xor(amax, o));
    const float sc = (amax > 0.f) ? exp2f(floorf(log2f(7.5f / amax))) : 1.f;
    v16f a, b;
#pragma unroll
    for (int k = 0; k < 16; ++k) {
#if FP6_ORDER == 0
      const int ia = k, ib = 16 + k;
#else
      const int ia = 2 * k, ib = 2 * k + 1;
#endif
      a[k] = v[ia >> 2][ia & 3] * sc;
      b[k] = v[ib >> 2][ib & 3] * sc;
    }
    const v6u pk = __builtin_amdgcn_cvt_scalef32_2xpk16_fp6_f32(a, b, 1.0f);
#pragma unroll
    for (int jc = 0; jc < 3; ++jc) *(u32x2*)(dst + jc * 512 + lane * 8) = mk2(pk[2 * jc], pk[2 * jc + 1]);
    if (lane == 0) (tb ? p.SV : p.SU)[row] = 1.f / sc;
  }
}

__device__ __forceinline__ void transpose_job(const float* src, bf16_t* dst, int K, int N, int batch, char* smem, int bid, int nb) {
  float* s = (float*)smem;
  const int tid = tid_local();
  const int tK = K >> 6, tN = N >> 6, per = tK * tN, total = batch * per;
  for (int item = bid; item < total; item += nb) {
    const int b = item / per, rem = item % per, tk = rem / tN, tn = rem % tN;
    const float* sp = src + (size_t)b * K * N + (size_t)(tk * 64) * N + tn * 64;
#pragma unroll
    for (int i = 0; i < 4; ++i) {
      const int row = (tid >> 4) + 16 * i, c4 = (tid & 15) * 4;
      float4 v = *(const float4*)(sp + (size_t)row * N + c4);
      s[row * 65 + c4 + 0] = v.x; s[row * 65 + c4 + 1] = v.y; s[row * 65 + c4 + 2] = v.z; s[row * 65 + c4 + 3] = v.w;
    }
    __syncthreads();
    const int n = tid >> 2, kq = tid & 3;
    uint32_t w[8];
#pragma unroll
    for (int e = 0; e < 8; ++e) w[e] = pack2(s[(kq * 16 + 2 * e) * 65 + n], s[(kq * 16 + 2 * e + 1) * 65 + n]);
    bf16_t* d = dst + (size_t)b * N * K + (size_t)(tn * 64 + n) * K + tk * 64 + kq * 16;
    *(u32x4*)d = mk4(w[0], w[1], w[2], w[3]);
    *(u32x4*)(d + 8) = mk4(w[4], w[5], w[6], w[7]);
    __syncthreads();
  }
}

__device__ __forceinline__ void ph_small_convert(const P& p, int bid, int nb) {
  const int gt = bid * 256 + tid_local(), gs = nb * 256;
  for (int i = gt; i < 2 * 16 * 128 * 128; i += gs) {
    const int k = i & 127, n = (i >> 7) & 127, hh = (i >> 14) & 15, dir = i >> 18;
    const int wc = n >> 6, ni = (n >> 4) & 3, l = n & 15;
    const int type = ni & 1, cl = (wc * 2 + (ni >> 1)) * 16 + l;
    const int h = hh >> 1, half = hh & 1, j = half * 64 + cl;
    const float* src = type ? p.lru_wx : p.lru_wa;
    p.WG[i] = f2bf(src[((size_t)(dir * 8 + h) * 128 + k) * 128 + j]);
  }
  for (int i = gt; i < 2 * 16 * 128 * 128; i += gs) p.KEYB[i] = f2bf(p.peer_keys[i]);
  for (int i = gt; i < 8 * 128 * 128; i += gs) p.GMWS[i] = f2bf(p.gm_ws[i]);
}

__device__ __forceinline__ void ph_norm(const float* srcx, const float* srcc, int nrows, const float* gnorm, const float* modx,
                        const float* modc, int shIdx, int scIdx, bf16_t* dst, int bid, int nb) {
  const int lane = tid_local() & 63, w = tid_local() >> 6;
  for (int row = bid * 4 + w; row < nrows; row += nb * 4) {
    const float* s = row < TX ? srcx + (size_t)row * DM : srcc + (size_t)(row - TX) * DM;
    const float* md = row < TX ? modx : modc;
    float4 v[8];
    float ss = 0.f;
#pragma unroll
    for (int i = 0; i < 8; ++i) {
      v[i] = ((const float4*)s)[i * 64 + lane];
      ss += v[i].x * v[i].x + v[i].y * v[i].y + v[i].z * v[i].z + v[i].w * v[i].w;
    }
    ss = wave_sum(ss);
    const float rstd = rsqrtf(ss * (1.f / DM) + 1e-6f);
#pragma unroll
    for (int i = 0; i < 8; ++i) {
      const int d = (i * 64 + lane) * 4;
      const float4 g = *(const float4*)(gnorm + d);
      const float4 sc = *(const float4*)(md + scIdx * DM + d);
      const float4 sh = *(const float4*)(md + shIdx * DM + d);
      const float y0 = v[i].x * rstd * g.x * (1.f + sc.x) + sh.x;
      const float y1 = v[i].y * rstd * g.y * (1.f + sc.y) + sh.y;
      const float y2 = v[i].z * rstd * g.z * (1.f + sc.z) + sh.z;
      const float y3 = v[i].w * rstd * g.w * (1.f + sc.w) + sh.w;
      *(u32x2*)(dst + (size_t)row * DM + d) = mk2(pack2(y0, y1), pack2(y2, y3));
    }
  }
}

__device__ __forceinline__ float conv3_at(const P& p, int part, int ch, int toff, int L, int s) {
  const int c = part * 1024 + ch;
  const float* row = p.PROJT + (size_t)c * TS + toff;
  float v = p.ev_conv_b[c] + p.ev_conv_w[3072 + c] * row[s];
  if (s > 0) v += p.ev_conv_w[c] * row[s - 1];
  if (s < L - 1) v += p.ev_conv_w[2 * 3072 + c] * row[s + 1];
  return v;
}

__device__ __forceinline__ float4 conv3_vec4(const P& p, int part, int ch, int toff, int L, int s0) {
  const int c = part * 1024 + ch;
  const float* row = p.PROJT + (size_t)c * TS + toff;
  const float4 m = *(const float4*)(row + s0);
  const float l = (s0 > 0) ? row[s0 - 1] : 0.f;
  const float r = (s0 + 4 < L) ? row[s0 + 4] : 0.f;
  const float b = p.ev_conv_b[c], w0 = p.ev_conv_w[c], w1 = p.ev_conv_w[3072 + c], w2 = p.ev_conv_w[2 * 3072 + c];
  float4 o;
  o.x = b + w0 * l + w1 * m.x + w2 * m.y;
  o.y = b + w0 * m.x + w1 * m.y + w2 * m.z;
  o.z = b + w0 * m.y + w1 * m.z + w2 * m.w;
  o.w = b + w0 * m.z + w1 * m.w + w2 * r;
  return o;
}

#define C3_LOAD(M, Lf, Rt, part, s0) { const float* row_ = p.PROJT + (size_t)((part) * 1024 + ch) * TS + toff; \
    M = *(const f32x4*)(row_ + (s0)); Lf = ((s0) > 0) ? row_[(s0) - 1] : 0.f; Rt = ((s0) + 4 < L) ? row_[(s0) + 4] : 0.f; }
__device__ __forceinline__ f32x4 c3_eval(f32x4 m, float l, float r, float b, float w0, float w1, float w2) {
  f32x4 o;
  o.x = b + w0 * l + w1 * m.x + w2 * m.y;
  o.y = b + w0 * m.x + w1 * m.y + w2 * m.z;
  o.z = b + w0 * m.y + w1 * m.z + w2 * m.w;
  o.w = b + w0 * m.z + w1 * m.w + w2 * r;
  return o;
}

template <int SEQ>
__device__ __forceinline__ void hyena_item(const P& p, char* smem, int ch) {
  constexpr int L = SEQ ? 256 : TX;
  constexpr int toff = SEQ ? TX : 0;
  constexpr int nB = L >> 7;
  constexpr int NT = SEQ ? 1 : 4;
  bf16_t* KK = (bf16_t*)smem;
  float* ybuf = (float*)smem;
  bf16_t* UP = (bf16_t*)(smem + 34816);
  bf16_t* CP = (bf16_t*)(smem + 51712);
  float* red = (float*)(smem + 59904);
  const int tid = tid_local(), lane = tid & 63, w = tid >> 6;
  for (int n = 0; n < 2; ++n) {
    const bf16_t* ff = p.FILT + (size_t)(n * 1024 + ch) * TS + toff;
    const bf16_t* fb = p.FILT + (size_t)(2048 + n * 1024 + ch) * TS + toff;
    float sabs = 0.f;
    {
      constexpr int NKK = ((2 * L) / 8 + 255) / 256;
      u32x4 kv[NKK];
#pragma unroll
      for (int k = 0; k < NKK; ++k) {
        const int idx = (tid + 256 * k) * 8;
        kv[k] = mk4(0u, 0u, 0u, 0u);
        if (idx < 2 * L) kv[k] = (idx >= L) ? *(const u32x4*)(ff + (idx - L)) : *(const u32x4*)(fb + (L - 8 - idx));
      }
#pragma unroll
      for (int k = 0; k < NKK; ++k) {
        const int idx = (tid + 256 * k) * 8;
        if (idx < 2 * L) {
          u32x4 v = kv[k];
          if (idx < L) {
            const u32x4 r = v;
            v.x = (r.w >> 16) | (r.w << 16); v.y = (r.z >> 16) | (r.z << 16); v.z = (r.y >> 16) | (r.y << 16); v.w = (r.x >> 16) | (r.x << 16);
          }
          sabs += fabsf(bflo(v.x)) + fabsf(bfhi(v.x)) + fabsf(bflo(v.y)) + fabsf(bfhi(v.y)) + fabsf(bflo(v.z)) + fabsf(bfhi(v.z)) + fabsf(bflo(v.w)) + fabsf(bfhi(v.w));
          *(u32x4*)(KK + (idx >> 7) * 136 + (idx & 127)) = v;
        }
      }
    }
    sabs = wave_sum(sabs);
    if (lane == 0) red[w] = sabs;
    const float cb0 = p.ev_conv_b[ch], cw00 = p.ev_conv_w[ch], cw01 = p.ev_conv_w[3072 + ch], cw02 = p.ev_conv_w[2 * 3072 + ch];
    {
      constexpr int NUP = ((L + 256) / 4 + 255) / 256;
      if (n == 0) {
        constexpr int CH = SEQ ? 1 : 3;
#pragma unroll 1
        for (int k0 = 0; k0 < NUP; k0 += CH) {
          f32x4 cm[CH]; float cl[CH], cr[CH];
#pragma unroll
          for (int k = 0; k < CH; ++k) {
            const int s0 = (tid + 256 * (k0 + k)) * 4 - 128;
            cm[k] = (f32x4){0.f, 0.f, 0.f, 0.f}; cl[k] = 0.f; cr[k] = 0.f;
            if (s0 >= 0 && s0 < L) C3_LOAD(cm[k], cl[k], cr[k], 0, s0)
          }
#pragma unroll
          for (int k = 0; k < CH; ++k) {
            const int iv = tid + 256 * (k0 + k), s0 = iv * 4 - 128;
            if (iv < (L + 256) / 4) {
              f32x4 u = (f32x4){0.f, 0.f, 0.f, 0.f};
              if (s0 >= 0 && s0 < L) u = c3_eval(cm[k], cl[k], cr[k], cb0, cw00, cw01, cw02);
              *(u32x2*)(UP + iv * 4) = mk2(pack2(u.x, u.y), pack2(u.z, u.w));
            }
          }
        }
      } else {
        f32x4 zv[NUP];
#pragma unroll
        for (int k = 0; k < NUP; ++k) {
          const int s0 = (tid + 256 * k) * 4 - 128;
          zv[k] = (f32x4){0.f, 0.f, 0.f, 0.f};
          if (s0 >= 0 && s0 < L) zv[k] = *(const f32x4*)(p.Z1 + (size_t)ch * TS + toff + s0);
        }
#pragma unroll
        for (int k = 0; k < NUP; ++k) {
          const int iv = tid + 256 * k;
          if (iv < (L + 256) / 4) *(u32x2*)(UP + iv * 4) = mk2(pack2(zv[k].x, zv[k].y), pack2(zv[k].z, zv[k].w));
        }
      }
    }
    __syncthreads();
    const float invS = 1.f / (red[0] + red[1] + red[2] + red[3]);

    f32x4 acc[2][NT];
#pragma unroll
    for (int a = 0; a < 2; ++a)
#pragma unroll
      for (int b = 0; b < NT; ++b) acc[a][b] = (f32x4){0.f, 0.f, 0.f, 0.f};

    const unsigned hy_cp_off = (unsigned)(unsigned long long)((__attribute__((address_space(3))) char*)CP) +
                               (unsigned)(((7 - (2 * w + 1)) * 256 + 120 + 8 * (lane >> 4) - 8 * (lane & 15)) * 2);
    const unsigned hy_kk_off = (unsigned)(unsigned long long)((__attribute__((address_space(3))) char*)KK) +
                               (unsigned)((((lane & 15) + nB) * 136 + 8 * (lane >> 4)) * 2);
    auto build_window = [&](int c, int buf) {
      const int sg = tid >> 5, y0 = (tid & 31) * 8;
      uint32_t wv[4] = {0u, 0u, 0u, 0u};
      if (y0 < 248) {
        const int base = (c + 1) * 128 - 1 - y0 - sg + 128;
#pragma unroll
        for (int e = 0; e < 4; ++e) wv[e] = (uint32_t)UP[base - 2 * e] | ((uint32_t)UP[base - 2 * e - 1] << 16);
      }
      *(u32x4*)(CP + buf * 2048 + sg * 256 + y0) = mk4(wv[0], wv[1], wv[2], wv[3]);
    };
    build_window(0, 0);
    __syncthreads();
    for (int c = 0; c <= nB; ++c) {
      const int buf = c & 1;
      if (c < nB) build_window(c + 1, buf ^ 1);
      if constexpr (SEQ == 0) {
        const unsigned aB = hy_cp_off + (unsigned)buf * 4096u;
        const unsigned bB = hy_kk_off - (unsigned)c * 272u;
        bf16x8 a0s0, a1s0, b0s0, b1s0, b2s0, b3s0, a0s1, a1s1, b0s1, b1s1, b2s1, b3s1;
#define HY_LOADS(a0, a1, b0, b1, b2, b3, JS) \
        asm volatile("ds_read_b128 %0, %6 offset:%8\n\tds_read_b128 %1, %6 offset:%9\n\t" \
                     "ds_read_b128 %2, %7 offset:%10\n\tds_read_b128 %3, %7 offset:%11\n\t" \
                     "ds_read_b128 %4, %7 offset:%12\n\tds_read_b128 %5, %7 offset:%13" \
                     : "=&v"(a0), "=&v"(a1), "=&v"(b0), "=&v"(b1), "=&v"(b2), "=&v"(b3) \
                     : "v"(aB), "v"(bB), "i"(512 + 64 * (JS)), "i"(64 * (JS)), "i"(64 * (JS)), "i"(4352 + 64 * (JS)), \
                       "i"(8704 + 64 * (JS)), "i"(13056 + 64 * (JS)) : "memory")
#define HY_WAIT(N, a0, a1, b0, b1, b2, b3) \
        asm volatile("s_waitcnt lgkmcnt(" #N ")" : "+v"(a0), "+v"(a1), "+v"(b0), "+v"(b1), "+v"(b2), "+v"(b3))
#define HY_MMA(a0, a1, b0, b1, b2, b3) { \
          acc[0][0] = __builtin_amdgcn_mfma_f32_16x16x32_bf16(a0, b0, acc[0][0], 0, 0, 0); \
          acc[1][0] = __builtin_amdgcn_mfma_f32_16x16x32_bf16(a1, b0, acc[1][0], 0, 0, 0); \
          acc[0][1] = __builtin_amdgcn_mfma_f32_16x16x32_bf16(a0, b1, acc[0][1], 0, 0, 0); \
          acc[1][1] = __builtin_amdgcn_mfma_f32_16x16x32_bf16(a1, b1, acc[1][1], 0, 0, 0); \
          acc[0][2] = __builtin_amdgcn_mfma_f32_16x16x32_bf16(a0, b2, acc[0][2], 0, 0, 0); \
          acc[1][2] = __builtin_amdgcn_mfma_f32_16x16x32_bf16(a1, b2, acc[1][2], 0, 0, 0); \
          acc[0][3] = __builtin_amdgcn_mfma_f32_16x16x32_bf16(a0, b3, acc[0][3], 0, 0, 0); \
          acc[1][3] = __builtin_amdgcn_mfma_f32_16x16x32_bf16(a1, b3, acc[1][3], 0, 0, 0); }
        HY_LOADS(a0s0, a1s0, b0s0, b1s0, b2s0, b3s0, 0);
        HY_LOADS(a0s1, a1s1, b0s1, b1s1, b2s1, b3s1, 1);
        HY_WAIT(6, a0s0, a1s0, b0s0, b1s0, b2s0, b3s0);
        HY_MMA(a0s0, a1s0, b0s0, b1s0, b2s0, b3s0)
        HY_LOADS(a0s0, a1s0, b0s0, b1s0, b2s0, b3s0, 2);
        HY_WAIT(6, a0s1, a1s1, b0s1, b1s1, b2s1, b3s1);
        HY_MMA(a0s1, a1s1, b0s1, b1s1, b2s1, b3s1)
        HY_LOADS(a0s1, a1s1, b0s1, b1s1, b2s1, b3s1, 3);
        HY_WAIT(6, a0s0, a1s0, b0s0, b1s0, b2s0, b3s0);
        HY_MMA(a0s0, a1s0, b0s0, b1s0, b2s0, b3s0)
        HY_WAIT(0, a0s1, a1s1, b0s1, b1s1, b2s1, b3s1);
        HY_MMA(a0s1, a1s1, b0s1, b1s1, b2s1, b3s1)
      } else {
      const bf16_t* cp = CP + buf * 2048;
      bf16x8 aF[2][2], bF[2][NT];
      const bf16_t* kbase[NT];
#pragma unroll
      for (int nt = 0; nt < NT; ++nt) {
        int e = nt * 16 + (lane & 15);
        if (e > nB - 1) e = nB - 1;
        kbase[nt] = KK + (e - c + nB) * 136 + 8 * (lane >> 4);
      }
      const bf16_t* abase = cp + 120 + 8 * (lane >> 4) - 8 * (lane & 15);
#pragma unroll
      for (int mi = 0; mi < 2; ++mi) aF[0][mi] = *(const bf16x8*)(abase + (7 - (2 * w + mi)) * 256);
#pragma unroll
      for (int nt = 0; nt < NT; ++nt) bF[0][nt] = *(const bf16x8*)(kbase[nt]);
#pragma unroll
      for (int js = 0; js < 4; ++js) {
        if (js < 3) {
#pragma unroll
          for (int mi = 0; mi < 2; ++mi) aF[(js + 1) & 1][mi] = *(const bf16x8*)(abase + (7 - (2 * w + mi)) * 256 + 32 * (js + 1));
#pragma unroll
          for (int nt = 0; nt < NT; ++nt) bF[(js + 1) & 1][nt] = *(const bf16x8*)(kbase[nt] + 32 * (js + 1));
        }
#pragma unroll
        for (int nt = 0; nt < NT; ++nt)
#pragma unroll
          for (int mi = 0; mi < 2; ++mi)
            acc[mi][nt] = __builtin_amdgcn_mfma_f32_16x16x32_bf16(aF[js & 1][mi], bF[js & 1][nt], acc[mi][nt], 0, 0, 0);
      }
      }
      __syncthreads();
    }
#pragma unroll
    for (int mi = 0; mi < 2; ++mi)
#pragma unroll
      for (int nt = 0; nt < NT; ++nt) {
        const int e = nt * 16 + (lane & 15);
        if (e < nB) {
#pragma unroll
          for (int j = 0; j < 4; ++j) {
            const int rho = (lane >> 4) * 4 + j;
            const int tau = (2 * w + mi) + 8 * rho;
            ybuf[e * 128 + tau] = acc[mi][nt][j] * invS;
          }
        }
      }
    __syncthreads();
    const float bias = p.hy_bias[n * 1024 + ch];
    {
      constexpr int NE = (L / 4 + 255) / 256;
      const int pa = (n == 0) ? 1 : 2;
      const float pb = p.ev_conv_b[pa * 1024 + ch], pw0 = p.ev_conv_w[pa * 1024 + ch], pw1 = p.ev_conv_w[3072 + pa * 1024 + ch], pw2 = p.ev_conv_w[2 * 3072 + pa * 1024 + ch];
      constexpr int CE = SEQ ? 1 : 4;
#pragma unroll 1
      for (int k0 = 0; k0 < NE; k0 += CE) {
        f32x4 am[CE], bm[CE];
        float al[CE], ar[CE], bl[CE], br[CE];
#pragma unroll
        for (int k = 0; k < CE; ++k) {
          const int t0 = (tid + 256 * (k0 + k)) * 4;
          am[k] = (f32x4){0.f, 0.f, 0.f, 0.f}; bm[k] = am[k]; al[k] = 0.f; ar[k] = 0.f; bl[k] = 0.f; br[k] = 0.f;
          if (t0 < L) {
            C3_LOAD(am[k], al[k], ar[k], pa, t0)
            if (n == 0) C3_LOAD(bm[k], bl[k], br[k], 0, t0)
            else bm[k] = *(const f32x4*)(p.Z1 + (size_t)ch * TS + toff + t0);
          }
        }
#pragma unroll
        for (int k = 0; k < CE; ++k) {
          const int t0 = (tid + 256 * (k0 + k)) * 4;
          if (t0 < L) {
            const f32x4 y = *(const f32x4*)(ybuf + t0);
            const f32x4 xm = c3_eval(am[k], al[k], ar[k], pb, pw0, pw1, pw2);
            if (n == 0) {
              const f32x4 v = c3_eval(bm[k], bl[k], br[k], cb0, cw00, cw01, cw02);
              f32x4 z;
              z.x = xm.x * (y.x + bias * v.x); z.y = xm.y * (y.y + bias * v.y); z.z = xm.z * (y.z + bias * v.z); z.w = xm.w * (y.w + bias * v.w);
              *(f32x4*)(p.Z1 + (size_t)ch * TS + toff + t0) = z;
            } else {
              const f32x4 z1 = bm[k];
              bf16_t* o = p.ABUF1 + (size_t)(toff + t0) * DM + ch;
              o[0] = f2bf(xm.x * (y.x + bias * z1.x));
              o[DM] = f2bf(xm.y * (y.y + bias * z1.y));
              o[2 * DM] = f2bf(xm.z * (y.z + bias * z1.z));
              o[3 * DM] = f2bf(xm.w * (y.w + bias * z1.w));
            }
          }
        }
      }
    }
    __threadfence_block();
    __syncthreads();
  }
}

__device__ __forceinline__ void gmlp_item(const P& p, char* smem, int n, int h) {
  bf16_t* Bt = (bf16_t*)smem;
  float* rs = (float*)(smem + 34816);
  const int tid = tid_local(), lane = tid & 63, w = tid >> 6;
  const float* VG = p.PROJT + (size_t)4096 * TS + n * 128;
  {
    const int c8 = tid >> 5, q4 = (tid & 31) * 4;
    float4 s4 = make_float4(0.f, 0.f, 0.f, 0.f);
#pragma unroll 16
    for (int c = c8; c < 1024; c += 8) {
      const float4 v = *(const float4*)(VG + (size_t)c * TS + q4);
      s4.x += v.x * v.x; s4.y += v.y * v.y; s4.z += v.z * v.z; s4.w += v.w * v.w;
    }
    float* rs8 = rs + 128;
    *(float4*)(rs8 + c8 * 128 + q4) = s4;
  }
  __syncthreads();
  if (tid < 128) {
    float a = 0.f;
#pragma unroll
    for (int g = 0; g < 8; ++g) a += rs[128 + g * 128 + tid];
    rs[tid] = rsqrtf(a * (1.f / 1024.f) + 1e-6f);
  }
  __syncthreads();
  {
    const int c = tid >> 1, q0 = (tid & 1) * 64;
    const float g = p.gm_norm[h * 128 + c];
    const float* src = VG + (size_t)(h * 128 + c) * TS + q0;
#pragma unroll 4
    for (int i = 0; i < 16; ++i) {
      const float4 v = *(const float4*)(src + 4 * i);
      const int q = q0 + 4 * i;
      *(u32x2*)(Bt + c * 136 + q) = mk2(pack2(v.x * rs[q] * g, v.y * rs[q + 1] * g), pack2(v.z * rs[q + 2] * g, v.w * rs[q + 3] * g));
    }
  }
  __syncthreads();
  f32x4 acc[2][8];
#pragma unroll
  for (int a = 0; a < 2; ++a)
#pragma unroll
    for (int b = 0; b < 8; ++b) acc[a][b] = (f32x4){0.f, 0.f, 0.f, 0.f};
  const bf16_t* Aw = p.GMWS + (size_t)h * 128 * 128;
  bf16x8 afA[4][2];
#pragma unroll
  for (int ks = 0; ks < 4; ++ks)
#pragma unroll
    for (int mi = 0; mi < 2; ++mi)
      afA[ks][mi] = *(const bf16x8*)(Aw + (32 * w + 16 * mi + (lane & 15)) * 128 + ks * 32 + (lane >> 4) * 8);
#pragma unroll
  for (int ks = 0; ks < 4; ++ks) {
    bf16x8 bB[8];
#pragma unroll
    for (int ni = 0; ni < 8; ++ni) bB[ni] = *(const bf16x8*)(Bt + (ni * 16 + (lane & 15)) * 136 + ks * 32 + (lane >> 4) * 8);
#pragma unroll
    for (int ni = 0; ni < 8; ++ni)
#pragma unroll
      for (int mi = 0; mi < 2; ++mi)
        acc[mi][ni] = __builtin_amdgcn_mfma_f32_16x16x32_bf16(afA[ks][mi], bB[ni], acc[mi][ni], 0, 0, 0);
  }
#pragma unroll
  for (int mi = 0; mi < 2; ++mi)
#pragma unroll
    for (int ni = 0; ni < 8; ++ni) {
      const int c = ni * 16 + (lane & 15);
      const int p0 = 32 * w + 16 * mi + (lane >> 4) * 4;
      const float4 u = *(const float4*)(p.PROJT + (size_t)(3072 + h * 128 + c) * TS + n * 128 + p0);
      const float uu[4] = {u.x, u.y, u.z, u.w};
#pragma unroll
      for (int j = 0; j < 4; ++j) {
        const int pp = p0 + j;
        const float s = acc[mi][ni][j] + p.gm_bs[h * 128 + pp];
        p.ABUF1[(size_t)(n * 128 + pp) * DM + 1024 + h * 128 + c] = f2bf(uu[j] * s);
      }
    }
  __syncthreads();
}

#define BF8(dst, o, q) dst[o + 0] = bflo(q.x); dst[o + 1] = bfhi(q.x); dst[o + 2] = bflo(q.y); dst[o + 3] = bfhi(q.y); \
                       dst[o + 4] = bflo(q.z); dst[o + 5] = bfhi(q.z); dst[o + 6] = bflo(q.w); dst[o + 7] = bfhi(q.w);
template <int LAST>
__device__ __forceinline__ void ph_peer(const P& p, int layer, int ntok, char* smem, int bid, int nb) {
  const int tid = tid_local();
  const int lane = tid & 63, w = tid >> 6;
  int* sExp = (int*)smem + w * 32;
  float* sGate = (float*)(smem + 512) + w * 32;
  uint32_t* LL = (uint32_t*)(smem + 1024) + w * 128;
  float* sPart = (float*)(smem + 4096);
  float* sRed = (float*)(smem + 4096 + 32768);
  const unsigned char* UBl = p.UB + (size_t)layer * 16384 * ROWB;
  const unsigned char* VBl = p.VB + (size_t)layer * 16384 * ROWB;
  const float* SUl = p.SU + layer * 16384;
  const float* SVl = p.SV + layer * 16384;
  const bf16_t* HP = LAST ? p.ABUF1 : p.ABUF0;
  int pi_ = 0, pj_ = 0;
  {
    int rem = lane;
    bool found = false;
#pragma unroll
    for (int ii = 0; ii < 16; ++ii) {
      const int nn = 16 / (ii + 1);
      if (!found && rem < nn) { pi_ = ii; pj_ = rem; found = true; }
      if (!found) rem -= nn;
    }
  }
  const bool pvalid_ = lane < 50;
  float scv[8];
  if (bid < ntok) {
    const float* sp = p.SC + (size_t)bid * DM + w * 512 + lane;
#pragma unroll
    for (int k = 0; k < 8; ++k) scv[k] = sp[k * 64];
  }
  for (int t = bid; t < ntok; t += nb) {
    for (int rep_ = 0; rep_ < REP_TOPK; ++rep_) {
      uint32_t key[4][2], prefix[4];
      int need[4];
#pragma unroll
      for (int g = 0; g < 4; ++g) {
        key[g][0] = (((fkey(scv[g * 2 + 0]) + 0x2000u) >> 14) << 7) | (uint32_t)lane;
        key[g][1] = (((fkey(scv[g * 2 + 1]) + 0x2000u) >> 14) << 7) | (uint32_t)(lane + 64);
        prefix[g] = 0u; need[g] = 16;
      }
#pragma unroll 4
      for (int bit = 24; bit >= 0; --bit) {
        const uint32_t mh = ~((1u << bit) - 1u);
#pragma unroll
        for (int g = 0; g < 4; ++g) {
          const uint32_t cand = prefix[g] | (1u << bit);
          const int c = __popcll(__ballot((key[g][0] & mh) == cand)) + __popcll(__ballot((key[g][1] & mh) == cand));
          const bool ge_ = c >= need[g];
          prefix[g] = ge_ ? cand : prefix[g];
          need[g] = ge_ ? need[g] : need[g] - c;
        }
      }
#pragma unroll
      for (int g = 0; g < 4; ++g) {
        const bool q0 = key[g][0] >= prefix[g], q1 = key[g][1] >= prefix[g];
        const unsigned long long b0 = __ballot(q0), b1 = __ballot(q1);
        const int r0 = __builtin_amdgcn_mbcnt_hi((unsigned)(b0 >> 32), __builtin_amdgcn_mbcnt_lo((unsigned)b0, 0u));
        const int r1 = __popcll(b0) + __builtin_amdgcn_mbcnt_hi((unsigned)(b1 >> 32), __builtin_amdgcn_mbcnt_lo((unsigned)b1, 0u));
        uint32_t* Ls = LL + (g >> 1) * 48 + (g & 1) * 16;
        if (q0) Ls[r0 & 15] = key[g][0];
        if (q1) Ls[r1 & 15] = key[g][1];
      }
      {
        uint32_t* Lg = LL + (lane >> 5) * 48 + ((lane >> 4) & 1) * 16;
        const uint32_t my = Lg[lane & 15];
        int rk = 0;
#pragma unroll
        for (int k = 0; k < 16; ++k) rk += (Lg[k] > my) ? 1 : 0;
        Lg[rk] = my;
      }
      uint32_t pk[2], cpre[2];
      int cneed[2];
#pragma unroll
      for (int hh = 0; hh < 2; ++hh) {
        const float s0 = funkey((LL[hh * 48 + pi_] >> 7) << 14);
        const float s1 = funkey((LL[hh * 48 + 16 + pj_] >> 7) << 14);
        pk[hh] = pvalid_ ? ((((fkey(s0 + s1) + 0x2000u) >> 14) << 8) | (uint32_t)(pi_ * 16 + pj_)) : 0u;
        cpre[hh] = 0u; cneed[hh] = 16;
      }
#pragma unroll 4
      for (int bit = 25; bit >= 0; --bit) {
        const uint32_t mh = ~((1u << bit) - 1u);
#pragma unroll
        for (int hh = 0; hh < 2; ++hh) {
          const uint32_t cand = cpre[hh] | (1u << bit);
          const int c = __popcll(__ballot((pk[hh] & mh) == cand));
          const bool ge_ = c >= cneed[hh];
          cpre[hh] = ge_ ? cand : cpre[hh];
          cneed[hh] = ge_ ? cneed[hh] : cneed[hh] - c;
        }
      }
#pragma unroll
      for (int hh = 0; hh < 2; ++hh) {
        uint32_t* L0 = LL + hh * 48;
        uint32_t* L1 = L0 + 16;
        uint32_t* L2 = L0 + 32;
        {
          const bool q = pk[hh] >= cpre[hh] && pk[hh] != 0u;
          const unsigned long long bq = __ballot(q);
          const int r = __builtin_amdgcn_mbcnt_hi((unsigned)(bq >> 32), __builtin_amdgcn_mbcnt_lo((unsigned)bq, 0u));
          if (q) L2[r & 15] = pk[hh];
        }
        const uint32_t mine = L2[lane & 15];
        const int cidx = (int)(mine & 255u);
        const float cv = funkey((mine >> 8) << 14);
        const int ia = (int)(L0[(cidx >> 4) & 15] & 127u);
        const int ib = (int)(L1[cidx & 15] & 127u);
        float mx = cv;
#pragma unroll
        for (int o = 8; o >= 1; o >>= 1) mx = fmaxf(mx, __shfl_xor(mx, o));
        const float ev = __expf(cv - mx);
        float sum = ev;
#pragma unroll
        for (int o = 8; o >= 1; o >>= 1) sum += __shfl_xor(sum, o);
        if (lane < 16) {
          sExp[hh * 16 + lane] = ia * 128 + ib;
          sGate[hh * 16 + lane] = ev / sum;
        }
      }
    }
    if (t + nb < ntok) {
      const float* sp = p.SC + (size_t)(t + nb) * DM + w * 512 + lane;
#pragma unroll
      for (int k = 0; k < 8; ++k) scv[k] = sp[k * 64];
    }
    u32x4 xq[4];
    {
      const u32x4* xr = (const u32x4*)(HP + (size_t)t * DM) + lane * 4;
#pragma unroll
      for (int q = 0; q < 4; ++q) xq[q] = xr[q];
    }
    float acc[32];
#pragma unroll
    for (int i = 0; i < 32; ++i) acc[i] = 0.f;
    u32x2 ub[2][3], vb[2][3];
    int ex[2], exn[2];
#pragma unroll
    for (int e = 0; e < 2; ++e) {
      exn[e] = __builtin_amdgcn_readfirstlane(sExp[e]);
      const u32x2* ur = (const u32x2*)(UBl + (size_t)exn[e] * ROWB) + lane;
#pragma unroll
      for (int jc = 0; jc < 3; ++jc) ub[e][jc] = ur[jc * 64];
    }
#pragma unroll 1
    for (int eb = 0; eb < 32; eb += 2) {
      float d[2];
#pragma unroll
      for (int e = 0; e < 2; ++e) {
        ex[e] = exn[e];
        v6u pk;
        pk[0] = ub[e][0].x; pk[1] = ub[e][0].y; pk[2] = ub[e][1].x; pk[3] = ub[e][1].y; pk[4] = ub[e][2].x; pk[5] = ub[e][2].y;
        const v32f uu = __builtin_amdgcn_cvt_scalef32_pk32_f32_fp6(pk, 1.0f);
        float sdot = 0.f;
#pragma unroll
        for (int q = 0; q < 4; ++q) {
          sdot += bflo(xq[q].x) * uu[q * 8 + 0] + bfhi(xq[q].x) * uu[q * 8 + 1] + bflo(xq[q].y) * uu[q * 8 + 2] + bfhi(xq[q].y) * uu[q * 8 + 3] +
                  bflo(xq[q].z) * uu[q * 8 + 4] + bfhi(xq[q].z) * uu[q * 8 + 5] + bflo(xq[q].w) * uu[q * 8 + 6] + bfhi(xq[q].w) * uu[q * 8 + 7];
        }
        d[e] = sdot;
        __builtin_amdgcn_sched_barrier(0);
      }
#pragma unroll
      for (int e = 0; e < 2; ++e) {
        const u32x2* vr = (const u32x2*)(VBl + (size_t)ex[e] * ROWB) + lane;
#pragma unroll
        for (int jc = 0; jc < 3; ++jc) vb[e][jc] = vr[jc * 64];
      }
      if (eb + 2 < 32) {
#pragma unroll
        for (int e = 0; e < 2; ++e) {
          exn[e] = __builtin_amdgcn_readfirstlane(sExp[eb + 2 + e]);
          const u32x2* ur = (const u32x2*)(UBl + (size_t)exn[e] * ROWB) + lane;
#pragma unroll
          for (int jc = 0; jc < 3; ++jc) ub[e][jc] = ur[jc * 64];
        }
      }
#pragma unroll
      for (int o = 32; o >= 1; o >>= 1) {
#pragma unroll
        for (int e = 0; e < 2; ++e) d[e] += __shfl_xor(d[e], o);
      }
#pragma unroll
      for (int e = 0; e < 2; ++e) {
        const float wg = sGate[eb + e] * gelu_f(d[e] * SUl[ex[e]]) * SVl[ex[e]];
        v6u pk;
        pk[0] = vb[e][0].x; pk[1] = vb[e][0].y; pk[2] = vb[e][1].x; pk[3] = vb[e][1].y; pk[4] = vb[e][2].x; pk[5] = vb[e][2].y;
        const v32f vv = __builtin_amdgcn_cvt_scalef32_pk32_f32_fp6(pk, 1.0f);
#pragma unroll
        for (int k = 0; k < 32; ++k) acc[k] += wg * vv[k];
        __builtin_amdgcn_sched_barrier(0);
      }
    }
    {
      float* dst = sPart + w * 2048 + lane * 32;
#pragma unroll
      for (int q = 0; q < 8; ++q) *(float4*)(dst + q * 4) = make_float4(acc[q * 4 + 0], acc[q * 4 + 1], acc[q * 4 + 2], acc[q * 4 + 3]);
    }
    __syncthreads();
    const int d0 = tid * 8;
    float r[8];
    {
      float4 a = *(const float4*)(sPart + d0), b = *(const float4*)(sPart + d0 + 4);
#pragma unroll
      for (int ww = 1; ww < 4; ++ww) {
        const float4 a2 = *(const float4*)(sPart + ww * 2048 + d0), b2 = *(const float4*)(sPart + ww * 2048 + d0 + 4);
        a.x += a2.x; a.y += a2.y; a.z += a2.z; a.w += a2.w; b.x += b2.x; b.y += b2.y; b.z += b2.z; b.w += b2.w;
      }
      r[0] = a.x; r[1] = a.y; r[2] = a.z; r[3] = a.w; r[4] = b.x; r[5] = b.y; r[6] = b.z; r[7] = b.w;
    }
    const int which = (t < TX) ? 0 : 1;
    const float* md = p.MOD + (size_t)(layer * 2 + which) * 12288;
    float* xrow = p.XA + (size_t)t * DM;
    float ss = 0.f;
#pragma unroll
    for (int hq = 0; hq < 2; ++hq) {
      const float4 xv = *(const float4*)(xrow + d0 + hq * 4);
      const float4 g2 = *(const float4*)(md + 5 * DM + d0 + hq * 4);
      float4 o;
      o.x = xv.x + g2.x * r[hq * 4 + 0]; o.y = xv.y + g2.y * r[hq * 4 + 1];
      o.z = xv.z + g2.z * r[hq * 4 + 2]; o.w = xv.w + g2.w * r[hq * 4 + 3];
      r[hq * 4 + 0] = o.x; r[hq * 4 + 1] = o.y; r[hq * 4 + 2] = o.z; r[hq * 4 + 3] = o.w;
      ss += o.x * o.x + o.y * o.y + o.z * o.z + o.w * o.w;
      if (!LAST) *(float4*)(xrow + d0 + hq * 4) = o;
    }
    ss = wave_sum(ss);
    if (lane == 0) sRed[w] = ss;
    __syncthreads();
    const float rstd = rsqrtf((sRed[0] + sRed[1] + sRed[2] + sRed[3]) * (1.f / DM) + 1e-6f);
    if (LAST) {
      float* orow = p.out + (size_t)t * DM;
#pragma unroll
      for (int hq = 0; hq < 2; ++hq) {
        const float4 g = *(const float4*)(p.norm_final + d0 + hq * 4);
        float4 o;
        o.x = r[hq * 4 + 0] * rstd * g.x; o.y = r[hq * 4 + 1] * rstd * g.y; o.z = r[hq * 4 + 2] * rstd * g.z; o.w = r[hq * 4 + 3] * rstd * g.w;
        *(float4*)(orow + d0 + hq * 4) = o;
      }
    } else {
      const float* md1 = p.MOD + (size_t)(2 + which) * 12288;
      const float* gn = p.norm_mix + DM;
      uint32_t o[4];
#pragma unroll
      for (int hq = 0; hq < 2; ++hq) {
        const float4 g = *(const float4*)(gn + d0 + hq * 4);
        const float4 sh = *(const float4*)(md1 + 0 * DM + d0 + hq * 4);
        const float4 sc = *(const float4*)(md1 + 1 * DM + d0 + hq * 4);
        const float y0 = r[hq * 4 + 0] * rstd * g.x * (1.f + sc.x) + sh.x;
        const float y1 = r[hq * 4 + 1] * rstd * g.y * (1.f + sc.y) + sh.y;
        const float y2 = r[hq * 4 + 2] * rstd * g.z * (1.f + sc.z) + sh.z;
        const float y3 = r[hq * 4 + 3] * rstd * g.w * (1.f + sc.w) + sh.w;
        o[hq * 2 + 0] = pack2(y0, y1); o[hq * 2 + 1] = pack2(y2, y3);
      }
      *(u32x4*)(p.ABUF1 + (size_t)t * DM + d0) = mk4(o[0], o[1], o[2], o[3]);
    }
    __syncthreads();
  }
}

__device__ __forceinline__ void ph_scores(const P& p, int ph, char* smem, int bid, int nb) {
  const int tid = tid_local(), lane = tid & 63, wid = tid >> 6, wr = wid >> 1, wc = wid & 1;
        const int layer = (ph == 7) ? 0 : 1;
        const int numM = (ph == 7) ? 66 : 64;
        bf16_t* sA = (bf16_t*)smem;
        bf16_t* sB = sA + 128 * LDS_S;
        for (int id = bid; id < numM * 16; id += nb) {
          const int mt = id % numM, hs = id / numM;
          f32x4 acc[4][4];
          gemm_core(acc, p.QB + (size_t)mt * 128 * DM + hs * 128, DM, p.KEYB + (size_t)(layer * 16 + hs) * 128 * 128, 128, 128, sA, sB);
#pragma unroll
          for (int mi = 0; mi < 4; ++mi)
#pragma unroll
            for (int ni = 0; ni < 4; ++ni)
#pragma unroll
              for (int j = 0; j < 4; ++j) {
                const int row = mt * 128 + wr * 64 + mi * 16 + (lane >> 4) * 4 + j;
                const int col = wc * 64 + ni * 16 + (lane & 15);
                p.SC[(size_t)row * DM + hs * 128 + col] = acc[mi][ni][j];
              }
        }
}

__device__ __forceinline__ void ph_qscores(const P& p, int layer, int M, char* smem, int bid, int nb) {
  const int tid = tid_local(), lane = tid & 63, wid = tid >> 6, wr = wid >> 1, wc = wid & 1;
  bf16_t* sA = (bf16_t*)smem;
  bf16_t* sB = sA + 128 * LDS_S;
  bf16_t* sQ = (bf16_t*)smem;
  const bf16_t* A = layer ? p.ABUF1 : p.ABUF0;
  const bf16_t* W = p.WT_PQ + (size_t)layer * DM * DM;
  const int numM = M >> 7, numN = 16, total = numM * numN;
  const int vb = ((nb & 7) == 0) ? (bid & 7) * (nb >> 3) + (bid >> 3) : bid;
  for (int id = vb; id < total; id += nb) {
    const int gsz = 8 * numN, g = id / gsz, fm = g * 8;
    const int rows = (numM - fm) < 8 ? (numM - fm) : 8;
    const int r = id - g * gsz;
    const int mt = fm + r % rows, nt = r / rows;
    f32x4 acc[4][4];
    gemm_core_t<4>(acc, A + (size_t)mt * 128 * DM, DM, W + (size_t)nt * 128 * DM, DM, DM, sA, sB);
    __syncthreads();
#pragma unroll
    for (int mi = 0; mi < 4; ++mi)
#pragma unroll
      for (int ni = 0; ni < 4; ++ni)
#pragma unroll
        for (int j = 0; j < 4; ++j)
          sQ[(wr * 64 + mi * 16 + (lane >> 4) * 4 + j) * 136 + wc * 64 + ni * 16 + (lane & 15)] = f2bf(acc[mi][ni][j]);
    __syncthreads();
    const bf16_t* Kb = p.KEYB + (size_t)(layer * 16 + nt) * 128 * 128;
    f32x4 acc2[4][4];
#pragma unroll
    for (int mi = 0; mi < 4; ++mi)
#pragma unroll
      for (int ni = 0; ni < 4; ++ni) acc2[mi][ni] = (f32x4){0.f, 0.f, 0.f, 0.f};
#pragma unroll
    for (int ks = 0; ks < 4; ++ks) {
      bf16x8 af[4], bk[4];
#pragma unroll
      for (int mi = 0; mi < 4; ++mi) af[mi] = *(const bf16x8*)(sQ + (wr * 64 + mi * 16 + (lane & 15)) * 136 + ks * 32 + (lane >> 4) * 8);
#pragma unroll
      for (int ni = 0; ni < 4; ++ni) bk[ni] = *(const bf16x8*)(Kb + (wc * 64 + ni * 16 + (lane & 15)) * 128 + ks * 32 + (lane >> 4) * 8);
#pragma unroll
      for (int mi = 0; mi < 4; ++mi)
#pragma unroll
        for (int ni = 0; ni < 4; ++ni)
          acc2[mi][ni] = __builtin_amdgcn_mfma_f32_16x16x32_bf16(af[mi], bk[ni], acc2[mi][ni], 0, 0, 0);
    }
#pragma unroll
    for (int mi = 0; mi < 4; ++mi)
#pragma unroll
      for (int ni = 0; ni < 4; ++ni)
#pragma unroll
        for (int j = 0; j < 4; ++j)
          p.SC[(size_t)(mt * 128 + wr * 64 + mi * 16 + (lane >> 4) * 4 + j) * DM + nt * 128 + wc * 64 + ni * 16 + (lane & 15)] = acc2[mi][ni][j];
  }
}

#define XB_TMO      128
#define XB_XCNT(j)  (256  + 64 * (j))
#define XB_XSUB(j)  (1280 + 64 * (j))
#define XB_XGEN(j)  (2304 + 64 * (j))
#define XB_TOP      3328
#define XB_TOPGEN   3392
#define XCD_BAR_WORDS 3456
#define XB_SPIN_CAP (1u << 22)
#define LAS __attribute__((address_space(3)))
__device__ __forceinline__ unsigned xb_ld(unsigned* p)              { return __hip_atomic_load(p, __ATOMIC_RELAXED, __HIP_MEMORY_SCOPE_AGENT); }
__device__ __forceinline__ unsigned xb_add(unsigned* p, unsigned v) { return __hip_atomic_fetch_add(p, v, __ATOMIC_RELAXED, __HIP_MEMORY_SCOPE_AGENT); }
__device__ __forceinline__ unsigned xb_xcc_id() { return (unsigned)__builtin_amdgcn_s_getreg((3 << 11) | 20) & 0xFu; }
#define XB_SPIN(cond, bar) do { unsigned _sp = 0; while (cond) { __builtin_amdgcn_s_sleep(1); \
    if ((++_sp & 255u) == 0u) { if (xb_ld(&(bar)[XB_TMO])) break; if (_sp > XB_SPIN_CAP) { atomicAdd(&(bar)[XB_TMO], 1u); break; } } } } while (0)
struct XcdBarrier { unsigned* bar; unsigned x; volatile LAS unsigned* st; };
__device__ __forceinline__ XcdBarrier xcd_barrier_post(unsigned* bar, volatile LAS unsigned* st) {
  XcdBarrier b; b.bar = bar; b.x = xb_xcc_id(); b.st = st;
  if (tid_local() == 0) (void)xb_add(&bar[XB_XCNT(b.x)], 1u);
  return b;
}
__device__ __forceinline__ void xcd_barrier_complete(unsigned* bar, unsigned x, unsigned& nloc, unsigned& nx, unsigned G) {
  unsigned sum, cnt, mine, sp = 0u;
  for (;;) {
    sum = 0u; cnt = 0u; mine = 0u;
#pragma unroll
    for (unsigned j = 0; j < 16; ++j) { const unsigned c = xb_ld(&bar[XB_XCNT(j)]); sum += c; cnt += (c > 0u) ? 1u : 0u; mine = (j == x) ? c : mine; }
    if (sum == G) break;
    __builtin_amdgcn_s_sleep(1);
    if ((++sp & 255u) == 0u) { if (xb_ld(&bar[XB_TMO])) break; if (sp > XB_SPIN_CAP) { atomicAdd(&bar[XB_TMO], 1u); break; } }
  }
  nloc = mine > 0u ? mine : 1u; nx = cnt > 0u ? cnt : 1u;
}
__device__ __forceinline__ void xcd_barrier_impl(unsigned* bar, unsigned x, volatile LAS unsigned* st, int tid_, unsigned G_) {
  asm volatile("s_waitcnt vmcnt(0)" ::: "memory");
  __syncthreads();
  if (tid_ == 0) {
    __builtin_amdgcn_s_waitcnt(0);
    const unsigned nloc = st[0], nx = st[1];
    const unsigned old = xb_add(&bar[XB_XSUB(x)], 1u);
    const unsigned gen = old / nloc;
    if (old + 1u == (gen + 1u) * nloc) {
      __builtin_amdgcn_fence(__ATOMIC_RELEASE, "agent");
      asm volatile("s_waitcnt vmcnt(0)" ::: "memory");
      const unsigned og = xb_add(&bar[XB_TOP], 1u);
      const unsigned tg = og / nx;
      if (og + 1u == (tg + 1u) * nx) xb_add(&bar[XB_TOPGEN], 1u);
      else XB_SPIN(xb_ld(&bar[XB_TOPGEN]) == tg, bar);
      __builtin_amdgcn_fence(__ATOMIC_ACQUIRE, "agent");
      xb_add(&bar[XB_XGEN(x)], 1u);
      asm volatile("s_waitcnt vmcnt(0)" ::: "memory");
    } else {
      XB_SPIN(xb_ld(&bar[XB_XGEN(x)]) == gen, bar);
      __builtin_amdgcn_fence(__ATOMIC_ACQUIRE, "agent");
      asm volatile("s_waitcnt vmcnt(0)" ::: "memory");
    }
  }
  __syncthreads();
}

template <bool COOP>
__global__ void __launch_bounds__(256, 2) mega(P p, int ph_lo, int ph_hi) {
  __shared__ __attribute__((aligned(16))) char smem[61424];
  const int bid = blockIdx.x, nb = gridDim.x;
  const int tid0 = tid_local();
#define PH_IDS int tid = tid_local(); const int lane = tid & 63, wid = tid >> 6, wr = wid >> 1, wc = wid & 1; (void)lane; (void)wr; (void)wc;
  if constexpr (COOP) { if (ph_hi < 0) cg::this_grid().sync(); }
  __shared__ uint4 xb_words;
  XcdBarrier xb;
  xb.bar = p.BAR; xb.x = 0u; xb.st = (volatile LAS unsigned*)&xb_words;
  if constexpr (COOP) {
    if (tid0 == 0) { xb.st[0] = 0u; xb.st[1] = 0u; }
    __syncthreads();
    xb = xcd_barrier_post(p.BAR, (volatile LAS unsigned*)&xb_words);
    if (tid0 == 0) {
      unsigned nloc = 1u, nx = 1u;
      xcd_barrier_complete(p.BAR, xb.x, nloc, nx, (unsigned)nb);
      xb.st[0] = nloc; xb.st[1] = nx;
    }
    __syncthreads();
  }
  {
    {
      if (PHON(0) && ph_lo <= 0 && 0 < ph_hi) { const int ph = 0; (void)ph;
        PH_IDS
        for (int rep_ = 0; rep_ < REP_P0; ++rep_) {
        ph_ada(p, smem, bid, nb, 0);
        ph_h2(p, smem, bid, nb);
        transpose_job(p.hy_w3, p.W3T, 64, 4096, 1, smem, bid, nb);
        transpose_job(p.ev_w_in, p.WT_EVIN, 2048, 5120, 1, smem, bid, nb);
        transpose_job(p.ev_w_out, p.WT_EVOUT, 2048, 2048, 1, smem, bid, nb);
        transpose_job(p.peer_q, p.WT_PQ, 2048, 2048, 1, smem, bid, nb);
        ph_small_convert(p, bid, nb);
        }
        if constexpr (COOP) if (ph + 1 < ph_hi) xcd_barrier_impl(xb.bar, xb.x, xb.st, (int)tid_local(), (unsigned)nb);
      }
      if (PHON(1) && ph_lo <= 1 && 1 < ph_hi) { const int ph = 1; (void)ph;
        PH_IDS
        for (int rep_ = 0; rep_ < REP_GEMM; ++rep_) {
        ph_norm(p.x, p.ctx, TS, p.norm_mix, p.MOD, p.MOD + 12288, 0, 1, p.ABUF0, bid, nb);
        gemm_phase(p.H2B, 64, p.W3T, 64, TS, 4096, 64, smem, bid, nb, [&](int row0, int col, f32x4 v) {
          const float ad = fabsf(p.hy_deltas[col]);
          float o[4];
#pragma unroll
          for (int j = 0; j < 4; ++j) {
            const int row = row0 + j;
            const float tn = row < TX ? (float)row * (1.f / 8191.f) : (float)(row - TX) * (1.f / 255.f);
            o[j] = v[j] * __expf(-tn * ad);
          }
          *(u32x2*)(p.FILT + (size_t)col * TS + row0) = mk2(pack2(o[0], o[1]), pack2(o[2], o[3]));
        });
        }
        if constexpr (COOP) if (ph + 1 < ph_hi) xcd_barrier_impl(xb.bar, xb.x, xb.st, (int)tid_local(), (unsigned)nb);
      }
      if (PHON(2) && ph_lo <= 2 && 2 < ph_hi) { const int ph = 2; (void)ph;
        PH_IDS
        for (int rep_ = 0; rep_ < REP_GEMM; ++rep_) {
        gemm_phase(p.ABUF0, DM, p.WT_EVIN, DM, TS, 5120, DM, smem, bid, nb, [&](int row0, int col, f32x4 v) {
          float4 o;
          if (col < 3072) { o.x = v[0]; o.y = v[1]; o.z = v[2]; o.w = v[3]; }
          else { o.x = gelu_f(v[0]); o.y = gelu_f(v[1]); o.z = gelu_f(v[2]); o.w = gelu_f(v[3]); }
          *(float4*)(p.PROJT + (size_t)col * TS + row0) = o;
        });
        }
        if constexpr (COOP) if (ph + 1 < ph_hi) xcd_barrier_impl(xb.bar, xb.x, xb.st, (int)tid_local(), (unsigned)nb);
      }
      if (PHON(3) && ph_lo <= 3 && 3 < ph_hi) { const int ph = 3; (void)ph;
        PH_IDS
        for (int rep_ = 0; rep_ < REP_P3; ++rep_) {
        const bool conv_first = ((bid / (nb >> 1)) & 1) != 0;
#define LATE_PREP() { ph_tables(p, bid, nb); __syncthreads(); ph_ada(p, smem, bid, nb, 1); \
          transpose_job(p.od_w_in, p.WT_ODIN, 2048, 3072, 1, smem, bid, nb); \
          transpose_job(p.od_w_out, p.WT_ODOUT, 2048, 2048, 1, smem, bid, nb); \
          transpose_job(p.peer_q + (size_t)DM * DM, p.WT_PQ + (size_t)DM * DM, 2048, 2048, 1, smem, bid, nb); \
          transpose_job(p.pool_w, p.WTPOOL, 256, 256, 4, smem, bid, nb); __syncthreads(); }
        if (conv_first) LATE_PREP()
        for (int item = bid; item < 2048 + 528; item += nb) {
          if (item < 1024) hyena_item<0>(p, smem, item);
          else if (item < 2048) hyena_item<1>(p, smem, item - 1024);
          else gmlp_item(p, smem, (item - 2048) >> 3, (item - 2048) & 7);
        }
        if (!conv_first) LATE_PREP()
        }
        if constexpr (COOP) if (ph + 1 < ph_hi) xcd_barrier_impl(xb.bar, xb.x, xb.st, (int)tid_local(), (unsigned)nb);
      }
      if (PHON(4) && ph_lo <= 4 && 4 < ph_hi) { const int ph = 4; (void)ph;
        PH_IDS
        for (int rep_ = 0; rep_ < REP_GEMM; ++rep_) {
        gemm_phase(p.ABUF1, DM, p.WT_EVOUT, DM, TS, DM, DM, smem, bid, nb, [&](int row0, int col, f32x4 v) {
#pragma unroll
          for (int j = 0; j < 4; ++j) {
            const int row = row0 + j;
            const float base = row < TX ? p.x[(size_t)row * DM + col] : p.ctx[(size_t)(row - TX) * DM + col];
            const float g = p.MOD[(size_t)(row < TX ? 0 : 1) * 12288 + 2 * DM + col];
            p.XA[(size_t)row * DM + col] = base + g * v[j];
          }
        });
        }
        if constexpr (COOP) if (ph + 1 < ph_hi) xcd_barrier_impl(xb.bar, xb.x, xb.st, (int)tid_local(), (unsigned)nb);
      }
      if (PHON(5) && ph_lo <= 5 && 5 < ph_hi) { const int ph = 5; (void)ph;
        PH_IDS
        ph_norm(p.XA, p.XA + (size_t)TX * DM, TS, p.norm_ffn, p.MOD, p.MOD + 12288, 3, 4, p.ABUF0, bid, nb);
        if constexpr (COOP) if (ph + 1 < ph_hi) xcd_barrier_impl(xb.bar, xb.x, xb.st, (int)tid_local(), (unsigned)nb);
      }
      if (PHON(6) && ph_lo <= 6 && 6 < ph_hi) { const int ph = 6; (void)ph;
        ph_qscores(p, 0, TS, smem, bid, nb);
        if constexpr (COOP) if (ph + 1 < ph_hi) xcd_barrier_impl(xb.bar, xb.x, xb.st, (int)tid_local(), (unsigned)nb);
      }
      if (PHON(8) && ph_lo <= 8 && 8 < ph_hi) { const int ph = 8; (void)ph;
        PH_IDS
        ph_peer<0>(p, 0, TS, smem, bid, nb);
        if constexpr (COOP) if (ph + 1 < ph_hi) xcd_barrier_impl(xb.bar, xb.x, xb.st, (int)tid_local(), (unsigned)nb);
      }
      if (PHON(9) && ph_lo <= 9 && 9 < ph_hi) { const int ph = 9; (void)ph;
        PH_IDS
        for (int rep_ = 0; rep_ < REP_GEMM; ++rep_) {
        gemm_phase(p.ABUF1, DM, p.WT_ODIN, DM, TS, 3072, DM, smem, bid, nb, [&](int row0, int col, f32x4 v) {
#pragma unroll
          for (int j = 0; j < 4; ++j) p.PROJ1[(size_t)(row0 + j) * 3072 + col] = (col < 1024) ? gelu_f(v[j]) : v[j];
        });
        }
        if constexpr (COOP) if (ph + 1 < ph_hi) xcd_barrier_impl(xb.bar, xb.x, xb.st, (int)tid_local(), (unsigned)nb);
      }
      if (PHON(10) && ph_lo <= 10 && 10 < ph_hi) { const int ph = 10; (void)ph;
        PH_IDS
        for (int rep_ = 0; rep_ < REP_L1S; ++rep_) {
        for (int idx = bid * 256 + tid; idx < TS * 256; idx += nb * 256) {
          const int t = idx >> 8, c4 = (idx & 255) * 4;
          const int lo = t < TX ? 0 : TX, hi = t < TX ? TX : TS;
          float4 a = *(const float4*)(p.od_conv_b + c4);
#pragma unroll
          for (int k = 0; k < 4; ++k) {
            const int tt = t + k - 1;
            if (tt >= lo && tt < hi) {
              const float4 xv = *(const float4*)(p.PROJ1 + (size_t)tt * 3072 + 1024 + c4);
              const float4 wv = *(const float4*)(p.od_conv_w + k * 1024 + c4);
              a.x += wv.x * xv.x; a.y += wv.y * xv.y; a.z += wv.z * xv.z; a.w += wv.w * xv.w;
            }
          }
          *(float4*)(p.XR + (size_t)t * 1024 + c4) = a;
          *(u32x2*)(p.XRB + (size_t)t * 1024 + c4) = mk2(pack2(a.x, a.y), pack2(a.z, a.w));
        }
        for (int idx = bid * 256 + tid; idx < TX * 256; idx += nb * 256) {
          const int t = idx >> 8, c4 = (idx & 255) * 4;
          const int half = 1 << (c4 >> 8);
          const int lo = (t - half) < 0 ? 0 : (t - half);
          const int hi = (t + half) > TX ? TX : (t + half);
          float4 s = make_float4(0.f, 0.f, 0.f, 0.f);
          for (int q = lo; q < hi; ++q) {
            const float4 xv = *(const float4*)(p.PROJ1 + (size_t)q * 3072 + 2048 + c4);
            s.x += xv.x; s.y += xv.y; s.z += xv.z; s.w += xv.w;
          }
          const float inv = 1.f / (float)(hi - lo);
          const float4 x0 = *(const float4*)(p.PROJ1 + (size_t)t * 3072 + 2048 + c4);
          *(u32x2*)(p.PD + (size_t)t * 1024 + c4) = mk2(pack2(s.x * inv - x0.x, s.y * inv - x0.y), pack2(s.z * inv - x0.z, s.w * inv - x0.w));
        }
        }
        if constexpr (COOP) if (ph + 1 < ph_hi) xcd_barrier_impl(xb.bar, xb.x, xb.st, (int)tid_local(), (unsigned)nb);
      }
      if (PHON(11) && ph_lo <= 11 && 11 < ph_hi) { const int ph = 11; (void)ph;
        PH_IDS
        for (int rep_ = 0; rep_ < REP_L1S; ++rep_) {
        bf16_t* sA = (bf16_t*)smem;
        bf16_t* sB = sA + 128 * LDS_S;
        for (int id = bid; id < 2112 + 512; id += nb) {
          f32x4 acc[4][4];
          if (id < 2112) {
            const int mt = id % 66, g = id / 66, dir = g >> 4, hh = g & 15, h = hh >> 1, half = hh & 1;
            gemm_core(acc, p.XRB + (size_t)mt * 128 * 1024 + h * 128, 1024, p.WG + (size_t)(dir * 16 + hh) * 128 * 128, 128, 128, sA, sB);
#pragma unroll
            for (int gq = 0; gq < 2; ++gq) {
              const int c = h * 128 + half * 64 + (wc * 2 + gq) * 16 + (lane & 15);
              const float ba = p.lru_ba[dir * 1024 + c], bx = p.lru_bx[dir * 1024 + c];
              const float sp = log1pf(expf(-p.lru_lam[dir * 1024 + c]));
#pragma unroll
              for (int mi = 0; mi < 4; ++mi)
#pragma unroll
                for (int j = 0; j < 4; ++j) {
                  const int t = mt * 128 + wr * 64 + mi * 16 + (lane >> 4) * 4 + j;
                  const float r = sigmoid_f(acc[mi][2 * gq][j] + ba);
                  const float ii = sigmoid_f(acc[mi][2 * gq + 1][j] + bx);
                  const float la = -8.f * r * sp;
                  const float a = expf(la);
                  const float b = sqrtf(-expm1f(2.f * la)) * ii * p.XR[(size_t)t * 1024 + c];
                  p.ABA[((size_t)dir * TS + t) * 1024 + c] = a;
                  p.ABB[((size_t)dir * TS + t) * 1024 + c] = b;
                }
            }
          } else {
            const int id2 = id - 2112, mt = id2 & 63, rest = id2 >> 6, g = rest >> 1, nh = rest & 1;
            gemm_core(acc, p.PD + (size_t)mt * 128 * 1024 + g * 256, 1024, p.WTPOOL + (size_t)g * 256 * 256 + (size_t)nh * 128 * 256, 256, 256, sA, sB);
#pragma unroll
            for (int mi = 0; mi < 4; ++mi)
#pragma unroll
              for (int ni = 0; ni < 4; ++ni) {
                const int cc = g * 256 + nh * 128 + wc * 64 + ni * 16 + (lane & 15);
                const float pb = p.pool_b[cc], ps = p.pool_scale[cc];
#pragma unroll
                for (int j = 0; j < 4; ++j) {
                  const int t = mt * 128 + wr * 64 + mi * 16 + (lane >> 4) * 4 + j;
                  p.ABUF0[(size_t)t * DM + 1024 + cc] = f2bf((acc[mi][ni][j] + pb) * ps);
                }
              }
          }
        }
        }
        if constexpr (COOP) if (ph + 1 < ph_hi) xcd_barrier_impl(xb.bar, xb.x, xb.st, (int)tid_local(), (unsigned)nb);
      }
      if (PHON(12) && ph_lo <= 12 && 12 < ph_hi) { const int ph = 12; (void)ph;
        PH_IDS
        for (int rep_ = 0; rep_ < REP_L1S; ++rep_) {
        for (int item = bid; item < 2 * 132 * 4; item += nb) {
          const int dir = item / 528, rem = item % 528, k = rem >> 2, c = (rem & 3) * 256 + tid;
          const float* pa = p.ABA + (size_t)dir * TS * 1024 + c;
          const float* pb = p.ABB + (size_t)dir * TS * 1024 + c;
          float Pp = 1.f, H = 0.f;
#pragma unroll 8
          for (int s = 0; s < 64; ++s) {
            const int t = dir ? (k * 64 + 63 - s) : (k * 64 + s);
            const float a = pa[(size_t)t * 1024], b = pb[(size_t)t * 1024];
            H = a * H + b; Pp *= a;
          }
          p.AGG[(size_t)(dir * 132 + k) * 1024 + c] = make_float2(Pp, H);
        }
        }
        if constexpr (COOP) if (ph + 1 < ph_hi) xcd_barrier_impl(xb.bar, xb.x, xb.st, (int)tid_local(), (unsigned)nb);
      }
      if (PHON(13) && ph_lo <= 13 && 13 < ph_hi) { const int ph = 13; (void)ph;
        PH_IDS
        for (int rep_ = 0; rep_ < REP_L1S; ++rep_) {
        float* hf = (float*)smem;
        for (int item = bid; item < 1024; item += nb) {
          const int k = item >> 3, cb = item & 7, cl = tid & 127, c = cb * 128 + cl, dir = tid >> 7;
          const float2* ag = p.AGG + (size_t)dir * 132 * 1024 + c;
          const int npre = 4 + (dir ? (127 - k) : k);
          float h = 0.f;
#pragma unroll 8
          for (int v = 0; v < npre; ++v) {
            const int q = dir ? (v < 4 ? 131 - v : 131 - v) : (v < 4 ? 128 + v : v - 4);
            const float2 g = ag[(size_t)q * 1024];
            h = g.x * h + g.y;
          }
          const float* pa = p.ABA + (size_t)dir * TS * 1024 + c;
          const float* pb = p.ABB + (size_t)dir * TS * 1024 + c;
          if (dir == 0) {
#pragma unroll 8
            for (int s = 0; s < 64; ++s) {
              const int t = k * 64 + s;
              h = pa[(size_t)t * 1024] * h + pb[(size_t)t * 1024];
              hf[s * 128 + cl] = h;
            }
          }
          __syncthreads();
          if (dir == 1) {
#pragma unroll 8
            for (int s = 63; s >= 0; --s) {
              const int t = k * 64 + s;
              h = pa[(size_t)t * 1024] * h + pb[(size_t)t * 1024];
              const float y = p.PROJ1[(size_t)t * 3072 + c] * (hf[s * 128 + cl] + h);
              p.ABUF0[(size_t)t * DM + c] = f2bf(y);
            }
          }
          __syncthreads();
        }
        }
        if constexpr (COOP) if (ph + 1 < ph_hi) xcd_barrier_impl(xb.bar, xb.x, xb.st, (int)tid_local(), (unsigned)nb);
      }
      if (PHON(14) && ph_lo <= 14 && 14 < ph_hi) { const int ph = 14; (void)ph;
        PH_IDS
        gemm_phase(p.ABUF0, DM, p.WT_ODOUT, DM, TX, DM, DM, smem, bid, nb, [&](int row0, int col, f32x4 v) {
          const float g = p.MOD[(size_t)2 * 12288 + 2 * DM + col];
#pragma unroll
          for (int j = 0; j < 4; ++j) {
            float* d = p.XA + (size_t)(row0 + j) * DM + col;
            *d = *d + g * v[j];
          }
        });
        if constexpr (COOP) if (ph + 1 < ph_hi) xcd_barrier_impl(xb.bar, xb.x, xb.st, (int)tid_local(), (unsigned)nb);
      }
      if (PHON(15) && ph_lo <= 15 && 15 < ph_hi) { const int ph = 15; (void)ph;
        PH_IDS
        ph_norm(p.XA, p.XA + (size_t)TX * DM, TX, p.norm_ffn + DM, p.MOD + 2 * 12288, p.MOD + 3 * 12288, 3, 4, p.ABUF1, bid, nb);
        if constexpr (COOP) if (ph + 1 < ph_hi) xcd_barrier_impl(xb.bar, xb.x, xb.st, (int)tid_local(), (unsigned)nb);
      }
      if (PHON(16) && ph_lo <= 16 && 16 < ph_hi) { const int ph = 16; (void)ph;
        ph_qscores(p, 1, TX, smem, bid, nb);
        if constexpr (COOP) if (ph + 1 < ph_hi) xcd_barrier_impl(xb.bar, xb.x, xb.st, (int)tid_local(), (unsigned)nb);
      }
      if (PHON(18) && ph_lo <= 18 && 18 < ph_hi) { const int ph = 18; (void)ph;
        PH_IDS
        for (int rep_ = 0; rep_ < REP_P18; ++rep_) {
        ph_peer<1>(p, 1, TX, smem, bid, nb);
        }
        if constexpr (COOP) if (ph + 1 < ph_hi) xcd_barrier_impl(xb.bar, xb.x, xb.st, (int)tid_local(), (unsigned)nb);
      }
    }
  }
}

extern "C" void kernel_launch(void* const* d_in, const int* in_sizes, int n_in, void* d_out, int out_size, void* d_ws,
                              size_t ws_size, hipStream_t stream) {
  P p{};
  const float** pin = (const float**)&p;
  for (int i = 0; i < 40; ++i) pin[i] = (const float*)d_in[i];
  p.out = (float*)d_out;
  char* ws = (char*)d_ws;
  size_t off = 0;
  auto alloc = [&](size_t bytes) { char* r = ws + off; off += (bytes + 255) & ~(size_t)255; return r; };
  p.MOD = (float*)alloc(4 * 12288 * 4);
  p.H2B = (bf16_t*)alloc((size_t)TS * 64 * 2);
  p.W3T = (bf16_t*)alloc((size_t)4096 * 64 * 2);
  p.WT_EVIN = (bf16_t*)alloc((size_t)5120 * 2048 * 2);
  p.WT_EVOUT = (bf16_t*)alloc((size_t)2048 * 2048 * 2);
  p.WT_ODIN = (bf16_t*)alloc((size_t)3072 * 2048 * 2);
  p.WT_ODOUT = (bf16_t*)alloc((size_t)2048 * 2048 * 2);
  p.WT_PQ = (bf16_t*)alloc((size_t)2 * 2048 * 2048 * 2);
  p.WG = (bf16_t*)alloc((size_t)2 * 16 * 128 * 128 * 2);
  p.KEYB = (bf16_t*)alloc((size_t)2 * 16 * 128 * 128 * 2);
  p.GMWS = (bf16_t*)alloc((size_t)8 * 128 * 128 * 2);
  p.WTPOOL = (bf16_t*)alloc((size_t)4 * 256 * 256 * 2);
  p.UB = (unsigned char*)alloc((size_t)2 * 16384 * 2048);
  p.VB = (unsigned char*)alloc((size_t)2 * 16384 * 2048);
  p.SU = (float*)alloc((size_t)2 * 16384 * 4);
  p.SV = (float*)alloc((size_t)2 * 16384 * 4);
  p.ABUF0 = (bf16_t*)alloc((size_t)TS * DM * 2);
  p.ABUF1 = (bf16_t*)alloc((size_t)TS * DM * 2);
  {
    char* r1 = alloc((size_t)5120 * TS * 4);
    p.PROJT = (float*)r1;
    p.PROJ1 = (float*)r1;
    p.XR = (float*)(r1 + (size_t)TS * 3072 * 4);
    p.XRB = (bf16_t*)(r1 + (size_t)TS * 3072 * 4 + (size_t)TS * 1024 * 4);
    p.PD = (bf16_t*)(r1 + (size_t)TS * 3072 * 4 + (size_t)TS * 1024 * 4 + (size_t)TS * 1024 * 2);
  }
  {
    char* r2 = alloc((size_t)2 * 2 * TS * 1024 * 4);
    p.FILT = (bf16_t*)r2;
    p.Z1 = (float*)(r2 + (size_t)4096 * TS * 2);
    p.ABA = (float*)r2;
    p.ABB = (float*)(r2 + (size_t)2 * TS * 1024 * 4);
  }
  p.XA = (float*)alloc((size_t)TS * DM * 4);
  p.QB = (bf16_t*)alloc((size_t)TS * DM * 2);
  p.SC = (float*)alloc((size_t)TS * DM * 4);
  p.AGG = (float2*)alloc((size_t)2 * 132 * 1024 * 8);
  p.BAR = (unsigned*)alloc(XCD_BAR_WORDS * 4);
  if (off > ws_size) { fprintf(stderr, "workspace too small: need %zu have %zu\n", off, ws_size); return; }

#if ONE_LAUNCH
  static int grid_blocks = 0;
  if (!grid_blocks) {
    int dev = 0, cus = 0, per_cu = 0;
    hipGetDevice(&dev);
    hipDeviceGetAttribute(&cus, hipDeviceAttributeMultiprocessorCount, dev);
    hipOccupancyMaxActiveBlocksPerMultiprocessor(&per_cu, mega<true>, 256, 0);
    if (per_cu > 2) per_cu = 2;
    grid_blocks = cus * per_cu;
  }
  int lo = 0, hi = NPH;
  void* args[] = {&p, &lo, &hi};
  hipMemsetAsync(p.BAR, 0, XCD_BAR_WORDS * 4, stream);
  hipError_t e = hipLaunchCooperativeKernel((void*)mega<true>, dim3(grid_blocks), dim3(256), args, 0, stream);
  if (e != hipSuccess) fprintf(stderr, "cooperative launch failed: %s (grid %d)\n", hipGetErrorString(e), grid_blocks);
#else
  for (int ph = 0; ph < NPH; ++ph) mega<false><<<512, 256, 0, stream>>>(p, ph, ph + 1);
#endif
}
```

```cpp
#include <hip/hip_runtime.h>
#include <hip/hip_cooperative_groups.h>
#include <stdint.h>
#include <cstdio>
namespace cg = cooperative_groups;

#ifndef ONE_LAUNCH
#define ONE_LAUNCH 1
#endif

typedef unsigned short bf16_t;
using bf16x8 = __attribute__((ext_vector_type(8))) short;
using f32x4 = __attribute__((ext_vector_type(4))) float;
using u32x4 = __attribute__((ext_vector_type(4))) unsigned int;
using u32x2 = __attribute__((ext_vector_type(2))) unsigned int;
__device__ __forceinline__ u32x4 mk4(unsigned a, unsigned b, unsigned c, unsigned d) { u32x4 r; r.x = a; r.y = b; r.z = c; r.w = d; return r; }
__device__ __forceinline__ u32x2 mk2(unsigned a, unsigned b) { u32x2 r; r.x = a; r.y = b; return r; }

#define TS 8448
#define TX 8192
#define DM 2048
#define NPH 19
#ifndef ONLY_PH
#define ONLY_PH -1
#endif
#define PHON(k) (ONLY_PH < 0 || ONLY_PH == (k))
#ifndef REP_P0
#define REP_P0 1
#endif
#ifndef REP_GEMM
#define REP_GEMM 1
#endif
#ifndef REP_P3
#define REP_P3 1
#endif
#ifndef REP_P18
#define REP_P18 1
#endif
#ifndef REP_TOPK
#define REP_TOPK 1
#endif
#ifndef REP_L1S
#define REP_L1S 1
#endif

struct P {
  const float *x, *c, *ctx, *cctx, *ada_w, *ada_b, *norm_mix, *norm_ffn, *norm_final;
  const float *ev_w_in, *ev_conv_w, *ev_conv_b, *hy_w1, *hy_b1, *hy_w2, *hy_b2, *hy_w3, *hy_freq, *hy_deltas, *hy_bias;
  const float *gm_norm, *gm_ws, *gm_bs, *ev_w_out;
  const float *od_w_in, *od_conv_w, *od_conv_b, *lru_wa, *lru_ba, *lru_wx, *lru_bx, *lru_lam, *pool_w, *pool_b, *pool_scale, *od_w_out;
  const float *peer_q, *peer_keys, *peer_u, *peer_v;
  float* out;
  float* MOD;
  bf16_t* H2B;
  bf16_t* W3T;
  bf16_t* WT_EVIN;
  bf16_t* WT_EVOUT;
  bf16_t* WT_ODIN;
  bf16_t* WT_ODOUT;
  bf16_t* WT_PQ;
  bf16_t* WG;
  bf16_t* KEYB;
  bf16_t* GMWS;
  bf16_t* WTPOOL;
  unsigned char* UB;
  unsigned char* VB;
  float* SU;
  float* SV;
  bf16_t* ABUF0;
  bf16_t* ABUF1;
  float* PROJT;
  float* PROJ1;
  float* XR;
  bf16_t* XRB;
  bf16_t* PD;
  bf16_t* FILT;
  float* Z1;
  float* ABA;
  float* ABB;
  float* XA;
  bf16_t* QB;
  float* SC;
  float2* AGG;
  unsigned* BAR;
};

__device__ __forceinline__ int tid_local() { int t_ = (int)threadIdx.x; asm volatile("" : "+v"(t_)); return t_; }
__device__ __forceinline__ bf16_t f2bf(float f) {
  uint32_t u = __float_as_uint(f);
  u += 0x7FFFu + ((u >> 16) & 1u);
  return (bf16_t)(u >> 16);
}
__device__ __forceinline__ float bf2f(bf16_t b) { return __uint_as_float(((uint32_t)b) << 16); }
__device__ __forceinline__ uint32_t pack2(float a, float b) { return (uint32_t)f2bf(a) | ((uint32_t)f2bf(b) << 16); }
__device__ __forceinline__ float bflo(uint32_t u) { return __uint_as_float(u << 16); }
__device__ __forceinline__ float bfhi(uint32_t u) { return __uint_as_float(u & 0xFFFF0000u); }
__device__ __forceinline__ float gelu_f(float x) {
  float u = 0.7978845608028654f * (x + 0.044715f * x * x * x);
  return x / (1.f + __expf(-2.f * u));
}
__device__ __forceinline__ float sigmoid_f(float x) { return 1.f / (1.f + __expf(-x)); }
__device__ __forceinline__ float wave_sum(float v) {
#pragma unroll
  for (int o = 32; o >= 1; o >>= 1) v += __shfl_xor(v, o);
  return v;
}
__device__ __forceinline__ uint32_t wave_max_u32(uint32_t v) {
#pragma unroll
  for (int o = 32; o >= 1; o >>= 1) { uint32_t t = (uint32_t)__shfl_xor((int)v, o); v = v > t ? v : t; }
  return v;
}
__device__ __forceinline__ uint32_t fkey(float f) { uint32_t u = __float_as_uint(f); return (u & 0x80000000u) ? ~u : (u | 0x80000000u); }
__device__ __forceinline__ float funkey(uint32_t k) { uint32_t u = (k & 0x80000000u) ? (k & 0x7FFFFFFFu) : ~k; return __uint_as_float(u); }

#define LDS_S 72
template <int NI>
__device__ __forceinline__ void gemm_core_t(f32x4 (&acc)[4][NI], const bf16_t* __restrict__ A, int lda,
                                            const bf16_t* __restrict__ Bt, int ldb, int K, bf16_t* sA, bf16_t* sB) {
  const int tid = tid_local(), lane = tid & 63, wid = tid >> 6, wr = wid >> 1, wc = wid & 1;
  const int lr = tid >> 3, lc = (tid & 7) * 8;
#pragma unroll
  for (int i = 0; i < 4; ++i)
#pragma unroll
    for (int j = 0; j < NI; ++j) acc[i][j] = (f32x4){0.f, 0.f, 0.f, 0.f};
  u32x4 ra[4], rb[NI];
#pragma unroll
  for (int i = 0; i < 4; ++i) ra[i] = *(const u32x4*)(A + (size_t)(lr + 32 * i) * lda + lc);
#pragma unroll
  for (int i = 0; i < NI; ++i) rb[i] = *(const u32x4*)(Bt + (size_t)(lr + 32 * i) * ldb + lc);
  const int nk = K >> 6;
  for (int kt = 0; kt < nk; ++kt) {
    __syncthreads();
#pragma unroll
    for (int i = 0; i < 4; ++i) *(u32x4*)(sA + (lr + 32 * i) * LDS_S + lc) = ra[i];
#pragma unroll
    for (int i = 0; i < NI; ++i) *(u32x4*)(sB + (lr + 32 * i) * LDS_S + lc) = rb[i];
    __syncthreads();
    if (kt + 1 < nk) {
      const int ko = (kt + 1) * 64;
#pragma unroll
      for (int i = 0; i < 4; ++i) ra[i] = *(const u32x4*)(A + (size_t)(lr + 32 * i) * lda + ko + lc);
#pragma unroll
      for (int i = 0; i < NI; ++i) rb[i] = *(const u32x4*)(Bt + (size_t)(lr + 32 * i) * ldb + ko + lc);
    }
    __builtin_amdgcn_sched_barrier(0);
    bf16x8 af[2][4], bfr[2][NI];
#pragma unroll
    for (int ks = 0; ks < 2; ++ks) {
#pragma unroll
      for (int mi = 0; mi < 4; ++mi)
        af[ks][mi] = *(const bf16x8*)(sA + (wr * 64 + mi * 16 + (lane & 15)) * LDS_S + ks * 32 + (lane >> 4) * 8);
#pragma unroll
      for (int ni = 0; ni < NI; ++ni)
        bfr[ks][ni] = *(const bf16x8*)(sB + (wc * 16 * NI + ni * 16 + (lane & 15)) * LDS_S + ks * 32 + (lane >> 4) * 8);
    }
#pragma unroll
    for (int ks = 0; ks < 2; ++ks)
#pragma unroll
      for (int mi = 0; mi < 4; ++mi)
#pragma unroll
        for (int ni = 0; ni < NI; ++ni)
          acc[mi][ni] = __builtin_amdgcn_mfma_f32_16x16x32_bf16(af[ks][mi], bfr[ks][ni], acc[mi][ni], 0, 0, 0);
  }
}
__device__ __forceinline__ void gemm_core(f32x4 (&acc)[4][4], const bf16_t* __restrict__ A, int lda,
                                          const bf16_t* __restrict__ Bt, int ldb, int K, bf16_t* sA, bf16_t* sB) {
  gemm_core_t<4>(acc, A, lda, Bt, ldb, K, sA, sB);
}

template <class Epi>
__device__ __forceinline__ void gemm_phase(const bf16_t* A, int lda, const bf16_t* Bt, int ldb, int M, int N, int K,
                                           char* smem, int bid, int nb, Epi epi) {
  const int numM = M >> 7, numN = N >> 7;
  bf16_t* sA = (bf16_t*)smem;
  bf16_t* sB = sA + 128 * LDS_S;
  const int lane = tid_local() & 63, wid = tid_local() >> 6, wr = wid >> 1, wc = wid & 1;
  const int total = numM * numN;
  const int full = (total / nb) * nb;
  const int vb = ((nb & 7) == 0) ? (bid & 7) * (nb >> 3) + (bid >> 3) : bid;
  auto tile_of = [&](int id, int& mt, int& nt) {
    const int gsz = 8 * numN, g = id / gsz, fm = g * 8;
    const int rows = (numM - fm) < 8 ? (numM - fm) : 8;
    const int r = id - g * gsz;
    mt = fm + r % rows; nt = r / rows;
  };
  for (int id = vb; id < full; id += nb) {
    int mt, nt;
    tile_of(id, mt, nt);
    f32x4 acc[4][4];
    gemm_core_t<4>(acc, A + (size_t)mt * 128 * lda, lda, Bt + (size_t)nt * 128 * ldb, ldb, K, sA, sB);
#pragma unroll
    for (int mi = 0; mi < 4; ++mi)
#pragma unroll
      for (int ni = 0; ni < 4; ++ni)
        epi(mt * 128 + wr * 64 + mi * 16 + (lane >> 4) * 4, nt * 128 + wc * 64 + ni * 16 + (lane & 15), acc[mi][ni]);
  }
  for (int u = vb; u < (total - full) * 4; u += nb) {
    const int id = full + (u >> 2), qd = u & 3;
    int mt, nt;
    tile_of(id, mt, nt);
    f32x4 acc[4][1];
    gemm_core_t<1>(acc, A + (size_t)mt * 128 * lda, lda, Bt + (size_t)(nt * 128 + qd * 32) * ldb, ldb, K, sA, sB);
#pragma unroll
    for (int mi = 0; mi < 4; ++mi)
      epi(mt * 128 + wr * 64 + mi * 16 + (lane >> 4) * 4, nt * 128 + qd * 32 + wc * 16 + (lane & 15), acc[mi][0]);
  }
}

__device__ __forceinline__ void ph_ada(const P& p, char* smem, int bid, int nb, int layer) {
  float* sc = (float*)smem;
  float* sx = sc + 2048;
  float* red = sx + 2048;
  const int tid = tid_local();
  bool loaded = false;
  for (int item0 = bid; item0 < 384; item0 += nb) {
    const int item = item0 + layer * 384;
    if (!loaded) {
      for (int i = tid; i < 2048; i += 256) {
        float v = p.c[i]; sc[i] = v * sigmoid_f(v);
        float w = p.cctx[i]; sx[i] = w * sigmoid_f(w);
      }
      __syncthreads();
      loaded = true;
    }
    const int l = item / 384, cgp = item % 384;
    const int col = cgp * 32 + (tid & 31), kg = tid >> 5;
    const float* w = p.ada_w + (size_t)l * 2048 * 12288 + col;
    float a0 = 0.f, a1 = 0.f;
#pragma unroll 16
    for (int k = kg; k < 2048; k += 8) {
      float wv = w[(size_t)k * 12288];
      a0 += sc[k] * wv; a1 += sx[k] * wv;
    }
    red[(kg * 32 + (tid & 31)) * 2 + 0] = a0;
    red[(kg * 32 + (tid & 31)) * 2 + 1] = a1;
    __syncthreads();
    if (tid < 64) {
      const int cc = tid & 31, which = tid >> 5;
      float s = 0.f;
#pragma unroll
      for (int g = 0; g < 8; ++g) s += red[(g * 32 + cc) * 2 + which];
      const int colo = cgp * 32 + cc;
      p.MOD[(size_t)(l * 2 + which) * 12288 + colo] = s + p.ada_b[l * 12288 + colo];
    }
    __syncthreads();
  }
  __syncthreads();
}

__device__ __forceinline__ void ph_h2(const P& p, char* smem, int bid, int nb) {
  float* feats = (float*)smem;
  float* h1 = feats + 160;
  float* w1s = feats + 512;
  float* w2s = w1s + 33 * 64;
  const int tid = tid_local(), r = tid >> 6, j = tid & 63;
  if (bid < 2112) {
    for (int i = tid; i < 33 * 64; i += 256) w1s[i] = p.hy_w1[i];
    for (int i = tid; i < 64 * 64; i += 256) w2s[i] = p.hy_w2[i];
  }
  const float b1 = p.hy_b1[j], b2 = p.hy_b2[j], fr = p.hy_freq[j];
  __syncthreads();
  for (int item = bid; item < 2112; item += nb) {
    const int row = item * 4 + r;
    const int L = row < TX ? TX : 256;
    const int t = row < TX ? row : row - TX;
    if (j < 33) {
      const float tn = (float)t / (float)(L - 1);
      float f;
      if (j == 0) f = tn;
      else {
        const int bi = (j - 1) & 15;
        const float band = 1e-4f + (float)bi * ((15.f - 1e-4f) / 15.f);
        const float ang = (6.283185307179586f / (float)L) * (float)t * band;
        f = (j <= 16) ? cosf(ang) : -sinf(ang);
      }
      feats[r * 36 + j] = f;
    }
    __syncthreads();
    float a = b1;
#pragma unroll
    for (int i = 0; i < 33; ++i) a += feats[r * 36 + i] * w1s[i * 64 + j];
    h1[r * 64 + j] = sinf(fr * a);
    __syncthreads();
    float a2 = b2;
#pragma unroll 16
    for (int i = 0; i < 64; ++i) a2 += h1[r * 64 + i] * w2s[i * 64 + j];
    p.H2B[(size_t)row * 64 + j] = f2bf(sinf(fr * a2));
  }
  __syncthreads();
}

using f32x2 = __attribute__((ext_vector_type(2))) float;
#ifndef FP6_ORDER
#define FP6_ORDER 1
#endif
using v16f = __attribute__((ext_vector_type(16))) float;
using v32f = __attribute__((ext_vector_type(32))) float;
using v6u = __attribute__((ext_vector_type(6))) unsigned int;
#define ROWB 1536
__device__ __forceinline__ void ph_tables(const P& p, int bid, int nb) {
  const int lane = tid_local() & 63, w = tid_local() >> 6;
  for (int r = bid * 4 + w; r < 65536; r += nb * 4) {
    const int tb = r >> 15, row = r & 32767;
    const float* src = (tb ? p.peer_v : p.peer_u) + (size_t)row * 2048 + lane * 32;
    unsigned char* dst = (tb ? p.VB : p.UB) + (size_t)row * ROWB;
    f32x4 v[8];
    float amax = 0.f;
#pragma unroll
    for (int q = 0; q < 8; ++q) {
      v[q] = *(const f32x4*)(src + q * 4);
      amax = fmaxf(amax, fmaxf(fmaxf(fabsf(v[q].x), fabsf(v[q].y)), fmaxf(fabsf(v[q].z), fabsf(v[q].w))));
    }
#pragma unroll
    for (int o = 32; o >= 1; o >>= 1) amax = fmaxf(amax, __shfl_xor(amax, o));
    const float sc = (amax > 0.f) ? exp2f(floorf(log2f(7.5f / amax))) : 1.f;
    v16f a, b;
#pragma unroll
    for (int k = 0; k < 16; ++k) {
#if FP6_ORDER == 0
      const int ia = k, ib = 16 + k;
#else
      const int ia = 2 * k, ib = 2 * k + 1;
#endif
      a[k] = v[ia >> 2][ia & 3] * sc;
      b[k] = v[ib >> 2][ib & 3] * sc;
    }
    const v6u pk = __builtin_amdgcn_cvt_scalef32_2xpk16_fp6_f32(a, b, 1.0f);
#pragma unroll
    for (int jc = 0; jc < 3; ++jc) *(u32x2*)(dst + jc * 512 + lane * 8) = mk2(pk[2 * jc], pk[2 * jc + 1]);
    if (lane == 0) (tb ? p.SV : p.SU)[row] = 1.f / sc;
  }
}

__device__ __forceinline__ void transpose_job(const float* src, bf16_t* dst, int K, int N, int batch, char* smem, int bid, int nb) {
  float* s = (float*)smem;
  const int tid = tid_local();
  const int tK = K >> 6, tN = N >> 6, per = tK * tN, total = batch * per;
  for (int item = bid; item < total; item += nb) {
    const int b = item / per, rem = item % per, tk = rem / tN, tn = rem % tN;
    const float* sp = src + (size_t)b * K * N + (size_t)(tk * 64) * N + tn * 64;
#pragma unroll
    for (int i = 0; i < 4; ++i) {
      const int row = (tid >> 4) + 16 * i, c4 = (tid & 15) * 4;
      float4 v = *(const float4*)(sp + (size_t)row * N + c4);
      s[row * 65 + c4 + 0] = v.x; s[row * 65 + c4 + 1] = v.y; s[row * 65 + c4 + 2] = v.z; s[row * 65 + c4 + 3] = v.w;
    }
    __syncthreads();
    const int n = tid >> 2, kq = tid & 3;
    uint32_t w[8];
#pragma unroll
    for (int e = 0; e < 8; ++e) w[e] = pack2(s[(kq * 16 + 2 * e) * 65 + n], s[(kq * 16 + 2 * e + 1) * 65 + n]);
    bf16_t* d = dst + (size_t)b * N * K + (size_t)(tn * 64 + n) * K + tk * 64 + kq * 16;
    *(u32x4*)d = mk4(w[0], w[1], w[2], w[3]);
    *(u32x4*)(d + 8) = mk4(w[4], w[5], w[6], w[7]);
    __syncthreads();
  }
}

__device__ __forceinline__ void ph_small_convert(const P& p, int bid, int nb) {
  const int gt = bid * 256 + tid_local(), gs = nb * 256;
  for (int i = gt; i < 2 * 16 * 128 * 128; i += gs) {
    const int k = i & 127, n = (i >> 7) & 127, hh = (i >> 14) & 15, dir = i >> 18;
    const int wc = n >> 6, ni = (n >> 4) & 3, l = n & 15;
    const int type = ni & 1, cl = (wc * 2 + (ni >> 1)) * 16 + l;
    const int h = hh >> 1, half = hh & 1, j = half * 64 + cl;
    const float* src = type ? p.lru_wx : p.lru_wa;
    p.WG[i] = f2bf(src[((size_t)(dir * 8 + h) * 128 + k) * 128 + j]);
  }
  for (int i = gt; i < 2 * 16 * 128 * 128; i += gs) p.KEYB[i] = f2bf(p.peer_keys[i]);
  for (int i = gt; i < 8 * 128 * 128; i += gs) p.GMWS[i] = f2bf(p.gm_ws[i]);
}

__device__ __forceinline__ void ph_norm(const float* srcx, const float* srcc, int nrows, const float* gnorm, const float* modx,
                        const float* modc, int shIdx, int scIdx, bf16_t* dst, int bid, int nb) {
  const int lane = tid_local() & 63, w = tid_local() >> 6;
  for (int row = bid * 4 + w; row < nrows; row += nb * 4) {
    const float* s = row < TX ? srcx + (size_t)row * DM : srcc + (size_t)(row - TX) * DM;
    const float* md = row < TX ? modx : modc;
    float4 v[8];
    float ss = 0.f;
#pragma unroll
    for (int i = 0; i < 8; ++i) {
      v[i] = ((const float4*)s)[i * 64 + lane];
      ss += v[i].x * v[i].x + v[i].y * v[i].y + v[i].z * v[i].z + v[i].w * v[i].w;
    }
    ss = wave_sum(ss);
    const float rstd = rsqrtf(ss * (1.f / DM) + 1e-6f);
#pragma unroll
    for (int i = 0; i < 8; ++i) {
      const int d = (i * 64 + lane) * 4;
      const float4 g = *(const float4*)(gnorm + d);
      const float4 sc = *(const float4*)(md + scIdx * DM + d);
      const float4 sh = *(const float4*)(md + shIdx * DM + d);
      const float y0 = v[i].x * rstd * g.x * (1.f + sc.x) + sh.x;
      const float y1 = v[i].y * rstd * g.y * (1.f + sc.y) + sh.y;
      const float y2 = v[i].z * rstd * g.z * (1.f + sc.z) + sh.z;
      const float y3 = v[i].w * rstd * g.w * (1.f + sc.w) + sh.w;
      *(u32x2*)(dst + (size_t)row * DM + d) = mk2(pack2(y0, y1), pack2(y2, y3));
    }
  }
}

__device__ __forceinline__ float conv3_at(const P& p, int part, int ch, int toff, int L, int s) {
  const int c = part * 1024 + ch;
  const float* row = p.PROJT + (size_t)c * TS + toff;
  float v = p.ev_conv_b[c] + p.ev_conv_w[3072 + c] * row[s];
  if (s > 0) v += p.ev_conv_w[c] * row[s - 1];
  if (s < L - 1) v += p.ev_conv_w[2 * 3072 + c] * row[s + 1];
  return v;
}

__device__ __forceinline__ float4 conv3_vec4(const P& p, int part, int ch, int toff, int L, int s0) {
  const int c = part * 1024 + ch;
  const float* row = p.PROJT + (size_t)c * TS + toff;
  const float4 m = *(const float4*)(row + s0);
  const float l = (s0 > 0) ? row[s0 - 1] : 0.f;
  const float r = (s0 + 4 < L) ? row[s0 + 4] : 0.f;
  const float b = p.ev_conv_b[c], w0 = p.ev_conv_w[c], w1 = p.ev_conv_w[3072 + c], w2 = p.ev_conv_w[2 * 3072 + c];
  float4 o;
  o.x = b + w0 * l + w1 * m.x + w2 * m.y;
  o.y = b + w0 * m.x + w1 * m.y + w2 * m.z;
  o.z = b + w0 * m.y + w1 * m.z + w2 * m.w;
  o.w = b + w0 * m.z + w1 * m.w + w2 * r;
  return o;
}

#define C3_LOAD(M, Lf, Rt, part, s0) { const float* row_ = p.PROJT + (size_t)((part) * 1024 + ch) * TS + toff; \
    M = *(const f32x4*)(row_ + (s0)); Lf = ((s0) > 0) ? row_[(s0) - 1] : 0.f; Rt = ((s0) + 4 < L) ? row_[(s0) + 4] : 0.f; }
__device__ __forceinline__ f32x4 c3_eval(f32x4 m, float l, float r, float b, float w0, float w1, float w2) {
  f32x4 o;
  o.x = b + w0 * l + w1 * m.x + w2 * m.y;
  o.y = b + w0 * m.x + w1 * m.y + w2 * m.z;
  o.z = b + w0 * m.y + w1 * m.z + w2 * m.w;
  o.w = b + w0 * m.z + w1 * m.w + w2 * r;
  return o;
}

template <int SEQ>
__device__ __forceinline__ void hyena_item(const P& p, char* smem, int ch) {
  constexpr int L = SEQ ? 256 : TX;
  constexpr int toff = SEQ ? TX : 0;
  constexpr int nB = L >> 7;
  constexpr int NT = SEQ ? 1 : 4;
  bf16_t* KK = (bf16_t*)smem;
  float* ybuf = (float*)smem;
  bf16_t* UP = (bf16_t*)(smem + 34816);
  bf16_t* CP = (bf16_t*)(smem + 51712);
  float* red = (float*)(smem + 59904);
  const int tid = tid_local(), lane = tid & 63, w = tid >> 6;
  for (int n = 0; n < 2; ++n) {
    const bf16_t* ff = p.FILT + (size_t)(n * 1024 + ch) * TS + toff;
    const bf16_t* fb = p.FILT + (size_t)(2048 + n * 1024 + ch) * TS + toff;
    float sabs = 0.f;
    {
      constexpr int NKK = ((2 * L) / 8 + 255) / 256;
      u32x4 kv[NKK];
#pragma unroll
      for (int k = 0; k < NKK; ++k) {
        const int idx = (tid + 256 * k) * 8;
        kv[k] = mk4(0u, 0u, 0u, 0u);
        if (idx < 2 * L) kv[k] = (idx >= L) ? *(const u32x4*)(ff + (idx - L)) : *(const u32x4*)(fb + (L - 8 - idx));
      }
#pragma unroll
      for (int k = 0; k < NKK; ++k) {
        const int idx = (tid + 256 * k) * 8;
        if (idx < 2 * L) {
          u32x4 v = kv[k];
          if (idx < L) {
            const u32x4 r = v;
            v.x = (r.w >> 16) | (r.w << 16); v.y = (r.z >> 16) | (r.z << 16); v.z = (r.y >> 16) | (r.y << 16); v.w = (r.x >> 16) | (r.x << 16);
          }
          sabs += fabsf(bflo(v.x)) + fabsf(bfhi(v.x)) + fabsf(bflo(v.y)) + fabsf(bfhi(v.y)) + fabsf(bflo(v.z)) + fabsf(bfhi(v.z)) + fabsf(bflo(v.w)) + fabsf(bfhi(v.w));
          *(u32x4*)(KK + (idx >> 7) * 136 + (idx & 127)) = v;
        }
      }
    }
    sabs = wave_sum(sabs);
    if (lane == 0) red[w] = sabs;
    const float cb0 = p.ev_conv_b[ch], cw00 = p.ev_conv_w[ch], cw01 = p.ev_conv_w[3072 + ch], cw02 = p.ev_conv_w[2 * 3072 + ch];
    {
      constexpr int NUP = ((L + 256) / 4 + 255) / 256;
      if (n == 0) {
        constexpr int CH = SEQ ? 1 : 3;
#pragma unroll 1
        for (int k0 = 0; k0 < NUP; k0 += CH) {
          f32x4 cm[CH]; float cl[CH], cr[CH];
#pragma unroll
          for (int k = 0; k < CH; ++k) {
            const int s0 = (tid + 256 * (k0 + k)) * 4 - 128;
            cm[k] = (f32x4){0.f, 0.f, 0.f, 0.f}; cl[k] = 0.f; cr[k] = 0.f;
            if (s0 >= 0 && s0 < L) C3_LOAD(cm[k], cl[k], cr[k], 0, s0)
          }
#pragma unroll
          for (int k = 0; k < CH; ++k) {
            const int iv = tid + 256 * (k0 + k), s0 = iv * 4 - 128;
            if (iv < (L + 256) / 4) {
              f32x4 u = (f32x4){0.f, 0.f, 0.f, 0.f};
              if (s0 >= 0 && s0 < L) u = c3_eval(cm[k], cl[k], cr[k], cb0, cw00, cw01, cw02);
              *(u32x2*)(UP + iv * 4) = mk2(pack2(u.x, u.y), pack2(u.z, u.w));
            }
          }
        }
      } else {
        f32x4 zv[NUP];
#pragma unroll
        for (int k = 0; k < NUP; ++k) {
          const int s0 = (tid + 256 * k) * 4 - 128;
          zv[k] = (f32x4){0.f, 0.f, 0.f, 0.f};
          if (s0 >= 0 && s0 < L) zv[k] = *(const f32x4*)(p.Z1 + (size_t)ch * TS + toff + s0);
        }
#pragma unroll
        for (int k = 0; k < NUP; ++k) {
          const int iv = tid + 256 * k;
          if (iv < (L + 256) / 4) *(u32x2*)(UP + iv * 4) = mk2(pack2(zv[k].x, zv[k].y), pack2(zv[k].z, zv[k].w));
        }
      }
    }
    __syncthreads();
    const float invS = 1.f / (red[0] + red[1] + red[2] + red[3]);

    f32x4 acc[2][NT];
#pragma unroll
    for (int a = 0; a < 2; ++a)
#pragma unroll
      for (int b = 0; b < NT; ++b) acc[a][b] = (f32x4){0.f, 0.f, 0.f, 0.f};

    const unsigned hy_cp_off = (unsigned)(unsigned long long)((__attribute__((address_space(3))) char*)CP) +
                               (unsigned)(((7 - (2 * w + 1)) * 256 + 120 + 8 * (lane >> 4) - 8 * (lane & 15)) * 2);
    const unsigned hy_kk_off = (unsigned)(unsigned long long)((__attribute__((address_space(3))) char*)KK) +
                               (unsigned)((((lane & 15) + nB) * 136 + 8 * (lane >> 4)) * 2);
    auto build_window = [&](int c, int buf) {
      const int sg = tid >> 5, y0 = (tid & 31) * 8;
      uint32_t wv[4] = {0u, 0u, 0u, 0u};
      if (y0 < 248) {
        const int base = (c + 1) * 128 - 1 - y0 - sg + 128;
#pragma unroll
        for (int e = 0; e < 4; ++e) wv[e] = (uint32_t)UP[base - 2 * e] | ((uint32_t)UP[base - 2 * e - 1] << 16);
      }
      *(u32x4*)(CP + buf * 2048 + sg * 256 + y0) = mk4(wv[0], wv[1], wv[2], wv[3]);
    };
    bf16x8 a0s0, a1s0, b0s0, b1s0, b2s0, b3s0, a0s1, a1s1, b0s1, b1s1, b2s1, b3s1;
    build_window(0, 0);
    __syncthreads();
    for (int c = 0; c <= nB; ++c) {
      const int buf = c & 1;
      if (c < nB) build_window(c + 1, buf ^ 1);
      if constexpr (SEQ == 0) {
        const unsigned aB = hy_cp_off + (unsigned)buf * 4096u;
        const unsigned bB = hy_kk_off - (unsigned)c * 272u;
#define HY_LOADS(a0, a1, b0, b1, b2, b3, JS) \
        asm volatile("ds_read_b128 %0, %6 offset:%8\n\tds_read_b128 %1, %6 offset:%9\n\t" \
                     "ds_read_b128 %2, %7 offset:%10\n\tds_read_b128 %3, %7 offset:%11\n\t" \
                     "ds_read_b128 %4, %7 offset:%12\n\tds_read_b128 %5, %7 offset:%13" \
                     : "=&v"(a0), "=&v"(a1), "=&v"(b0), "=&v"(b1), "=&v"(b2), "=&v"(b3) \
                     : "v"(aB), "v"(bB), "i"(512 + 64 * (JS)), "i"(64 * (JS)), "i"(64 * (JS)), "i"(4352 + 64 * (JS)), \
                       "i"(8704 + 64 * (JS)), "i"(13056 + 64 * (JS)) : "memory")
#define HY_WAIT(N, a0, a1, b0, b1, b2, b3) \
        asm volatile("s_waitcnt lgkmcnt(" #N ")" : "+v"(a0), "+v"(a1), "+v"(b0), "+v"(b1), "+v"(b2), "+v"(b3))
#define HY_MMA(a0, a1, b0, b1, b2, b3) { \
          acc[0][0] = __builtin_amdgcn_mfma_f32_16x16x32_bf16(a0, b0, acc[0][0], 0, 0, 0); \
          acc[1][0] = __builtin_amdgcn_mfma_f32_16x16x32_bf16(a1, b0, acc[1][0], 0, 0, 0); \
          acc[0][1] = __builtin_amdgcn_mfma_f32_16x16x32_bf16(a0, b1, acc[0][1], 0, 0, 0); \
          acc[1][1] = __builtin_amdgcn_mfma_f32_16x16x32_bf16(a1, b1, acc[1][1], 0, 0, 0); \
          acc[0][2] = __builtin_amdgcn_mfma_f32_16x16x32_bf16(a0, b2, acc[0][2], 0, 0, 0); \
          acc[1][2] = __builtin_amdgcn_mfma_f32_16x16x32_bf16(a1, b2, acc[1][2], 0, 0, 0); \
          acc[0][3] = __builtin_amdgcn_mfma_f32_16x16x32_bf16(a0, b3, acc[0][3], 0, 0, 0); \
          acc[1][3] = __builtin_amdgcn_mfma_f32_16x16x32_bf16(a1, b3, acc[1][3], 0, 0, 0); }
#define HY_LOADA0(a0, a1) \
        asm volatile("ds_read_b128 %0, %2 offset:512\n\tds_read_b128 %1, %2" : "=&v"(a0), "=&v"(a1) : "v"(aB) : "memory")
#define HY_LOADB0(b0, b1, b2, b3, ADDR) \
        asm volatile("ds_read_b128 %0, %4\n\tds_read_b128 %1, %4 offset:4352\n\t" \
                     "ds_read_b128 %2, %4 offset:8704\n\tds_read_b128 %3, %4 offset:13056" \
                     : "=&v"(b0), "=&v"(b1), "=&v"(b2), "=&v"(b3) : "v"(ADDR) : "memory")
        if (c == 0) HY_LOADB0(b0s0, b1s0, b2s0, b3s0, bB);
        HY_LOADA0(a0s0, a1s0);
        HY_LOADS(a0s1, a1s1, b0s1, b1s1, b2s1, b3s1, 1);
        HY_WAIT(6, a0s0, a1s0, b0s0, b1s0, b2s0, b3s0);
        HY_MMA(a0s0, a1s0, b0s0, b1s0, b2s0, b3s0)
        HY_LOADS(a0s0, a1s0, b0s0, b1s0, b2s0, b3s0, 2);
        HY_WAIT(6, a0s1, a1s1, b0s1, b1s1, b2s1, b3s1);
        HY_MMA(a0s1, a1s1, b0s1, b1s1, b2s1, b3s1)
        HY_LOADS(a0s1, a1s1, b0s1, b1s1, b2s1, b3s1, 3);
        HY_WAIT(6, a0s0, a1s0, b0s0, b1s0, b2s0, b3s0);
        HY_MMA(a0s0, a1s0, b0s0, b1s0, b2s0, b3s0)
        HY_WAIT(0, a0s1, a1s1, b0s1, b1s1, b2s1, b3s1);
        if (c < nB) { const unsigned bBn = bB - 272u; HY_LOADB0(b0s0, b1s0, b2s0, b3s0, bBn); }
        HY_MMA(a0s1, a1s1, b0s1, b1s1, b2s1, b3s1)
      } else {
      const bf16_t* cp = CP + buf * 2048;
      bf16x8 aF[2][2], bF[2][NT];
      const bf16_t* kbase[NT];
#pragma unroll
      for (int nt = 0; nt < NT; ++nt) {
        int e = nt * 16 + (lane & 15);
        if (e > nB - 1) e = nB - 1;
        kbase[nt] = KK + (e - c + nB) * 136 + 8 * (lane >> 4);
      }
      const bf16_t* abase = cp + 120 + 8 * (lane >> 4) - 8 * (lane & 15);
#pragma unroll
      for (int mi = 0; mi < 2; ++mi) aF[0][mi] = *(const bf16x8*)(abase + (7 - (2 * w + mi)) * 256);
#pragma unroll
      for (int nt = 0; nt < NT; ++nt) bF[0][nt] = *(const bf16x8*)(kbase[nt]);
#pragma unroll
      for (int js = 0; js < 4; ++js) {
        if (js < 3) {
#pragma unroll
          for (int mi = 0; mi < 2; ++mi) aF[(js + 1) & 1][mi] = *(const bf16x8*)(abase + (7 - (2 * w + mi)) * 256 + 32 * (js + 1));
#pragma unroll
          for (int nt = 0; nt < NT; ++nt) bF[(js + 1) & 1][nt] = *(const bf16x8*)(kbase[nt] + 32 * (js + 1));
        }
#pragma unroll
        for (int nt = 0; nt < NT; ++nt)
#pragma unroll
          for (int mi = 0; mi < 2; ++mi)
            acc[mi][nt] = __builtin_amdgcn_mfma_f32_16x16x32_bf16(aF[js & 1][mi], bF[js & 1][nt], acc[mi][nt], 0, 0, 0);
      }
      }
      __syncthreads();
    }
#pragma unroll
    for (int mi = 0; mi < 2; ++mi)
#pragma unroll
      for (int nt = 0; nt < NT; ++nt) {
        const int e = nt * 16 + (lane & 15);
        if (e < nB) {
#pragma unroll
          for (int j = 0; j < 4; ++j) {
            const int rho = (lane >> 4) * 4 + j;
            const int tau = (2 * w + mi) + 8 * rho;
            ybuf[e * 128 + tau] = acc[mi][nt][j] * invS;
          }
        }
      }
    __syncthreads();
    const float bias = p.hy_bias[n * 1024 + ch];
    {
      constexpr int NE = (L / 4 + 255) / 256;
      const int pa = (n == 0) ? 1 : 2;
      const float pb = p.ev_conv_b[pa * 1024 + ch], pw0 = p.ev_conv_w[pa * 1024 + ch], pw1 = p.ev_conv_w[3072 + pa * 1024 + ch], pw2 = p.ev_conv_w[2 * 3072 + pa * 1024 + ch];
      constexpr int CE = SEQ ? 1 : 4;
#pragma unroll 1
      for (int k0 = 0; k0 < NE; k0 += CE) {
        f32x4 am[CE], bm[CE];
        float al[CE], ar[CE], bl[CE], br[CE];
#pragma unroll
        for (int k = 0; k < CE; ++k) {
          const int t0 = (tid + 256 * (k0 + k)) * 4;
          am[k] = (f32x4){0.f, 0.f, 0.f, 0.f}; bm[k] = am[k]; al[k] = 0.f; ar[k] = 0.f; bl[k] = 0.f; br[k] = 0.f;
          if (t0 < L) {
            C3_LOAD(am[k], al[k], ar[k], pa, t0)
            if (n == 0) C3_LOAD(bm[k], bl[k], br[k], 0, t0)
            else bm[k] = *(const f32x4*)(p.Z1 + (size_t)ch * TS + toff + t0);
          }
        }
#pragma unroll
        for (int k = 0; k < CE; ++k) {
          const int t0 = (tid + 256 * (k0 + k)) * 4;
          if (t0 < L) {
            const f32x4 y = *(const f32x4*)(ybuf + t0);
            const f32x4 xm = c3_eval(am[k], al[k], ar[k], pb, pw0, pw1, pw2);
            if (n == 0) {
              const f32x4 v = c3_eval(bm[k], bl[k], br[k], cb0, cw00, cw01, cw02);
              f32x4 z;
              z.x = xm.x * (y.x + bias * v.x); z.y = xm.y * (y.y + bias * v.y); z.z = xm.z * (y.z + bias * v.z); z.w = xm.w * (y.w + bias * v.w);
              *(f32x4*)(p.Z1 + (size_t)ch * TS + toff + t0) = z;
            } else {
              const f32x4 z1 = bm[k];
              bf16_t* o = p.ABUF1 + (size_t)(toff + t0) * DM + ch;
              o[0] = f2bf(xm.x * (y.x + bias * z1.x));
              o[DM] = f2bf(xm.y * (y.y + bias * z1.y));
              o[2 * DM] = f2bf(xm.z * (y.z + bias * z1.z));
              o[3 * DM] = f2bf(xm.w * (y.w + bias * z1.w));
            }
          }
        }
      }
    }
    __threadfence_block();
    __syncthreads();
  }
}

__device__ __forceinline__ void gmlp_item(const P& p, char* smem, int n, int h) {
  bf16_t* Bt = (bf16_t*)smem;
  float* rs = (float*)(smem + 34816);
  const int tid = tid_local(), lane = tid & 63, w = tid >> 6;
  const float* VG = p.PROJT + (size_t)4096 * TS + n * 128;
  {
    const int c8 = tid >> 5, q4 = (tid & 31) * 4;
    float4 s4 = make_float4(0.f, 0.f, 0.f, 0.f);
#pragma unroll 16
    for (int c = c8; c < 1024; c += 8) {
      const float4 v = *(const float4*)(VG + (size_t)c * TS + q4);
      s4.x += v.x * v.x; s4.y += v.y * v.y; s4.z += v.z * v.z; s4.w += v.w * v.w;
    }
    float* rs8 = rs + 128;
    *(float4*)(rs8 + c8 * 128 + q4) = s4;
  }
  __syncthreads();
  if (tid < 128) {
    float a = 0.f;
#pragma unroll
    for (int g = 0; g < 8; ++g) a += rs[128 + g * 128 + tid];
    rs[tid] = rsqrtf(a * (1.f / 1024.f) + 1e-6f);
  }
  __syncthreads();
  {
    const int c = tid >> 1, q0 = (tid & 1) * 64;
    const float g = p.gm_norm[h * 128 + c];
    const float* src = VG + (size_t)(h * 128 + c) * TS + q0;
#pragma unroll 4
    for (int i = 0; i < 16; ++i) {
      const float4 v = *(const float4*)(src + 4 * i);
      const int q = q0 + 4 * i;
      *(u32x2*)(Bt + c * 136 + q) = mk2(pack2(v.x * rs[q] * g, v.y * rs[q + 1] * g), pack2(v.z * rs[q + 2] * g, v.w * rs[q + 3] * g));
    }
  }
  __syncthreads();
  f32x4 acc[2][8];
#pragma unroll
  for (int a = 0; a < 2; ++a)
#pragma unroll
    for (int b = 0; b < 8; ++b) acc[a][b] = (f32x4){0.f, 0.f, 0.f, 0.f};
  const bf16_t* Aw = p.GMWS + (size_t)h * 128 * 128;
  bf16x8 afA[4][2];
#pragma unroll
  for (int ks = 0; ks < 4; ++ks)
#pragma unroll
    for (int mi = 0; mi < 2; ++mi)
      afA[ks][mi] = *(const bf16x8*)(Aw + (32 * w + 16 * mi + (lane & 15)) * 128 + ks * 32 + (lane >> 4) * 8);
#pragma unroll
  for (int ks = 0; ks < 4; ++ks) {
    bf16x8 bB[8];
#pragma unroll
    for (int ni = 0; ni < 8; ++ni) bB[ni] = *(const bf16x8*)(Bt + (ni * 16 + (lane & 15)) * 136 + ks * 32 + (lane >> 4) * 8);
#pragma unroll
    for (int ni = 0; ni < 8; ++ni)
#pragma unroll
      for (int mi = 0; mi < 2; ++mi)
        acc[mi][ni] = __builtin_amdgcn_mfma_f32_16x16x32_bf16(afA[ks][mi], bB[ni], acc[mi][ni], 0, 0, 0);
  }
#pragma unroll
  for (int mi = 0; mi < 2; ++mi)
#pragma unroll
    for (int ni = 0; ni < 8; ++ni) {
      const int c = ni * 16 + (lane & 15);
      const int p0 = 32 * w + 16 * mi + (lane >> 4) * 4;
      const float4 u = *(const float4*)(p.PROJT + (size_t)(3072 + h * 128 + c) * TS + n * 128 + p0);
      const float uu[4] = {u.x, u.y, u.z, u.w};
#pragma unroll
      for (int j = 0; j < 4; ++j) {
        const int pp = p0 + j;
        const float s = acc[mi][ni][j] + p.gm_bs[h * 128 + pp];
        p.ABUF1[(size_t)(n * 128 + pp) * DM + 1024 + h * 128 + c] = f2bf(uu[j] * s);
      }
    }
  __syncthreads();
}

#define BF8(dst, o, q) dst[o + 0] = bflo(q.x); dst[o + 1] = bfhi(q.x); dst[o + 2] = bflo(q.y); dst[o + 3] = bfhi(q.y); \
                       dst[o + 4] = bflo(q.z); dst[o + 5] = bfhi(q.z); dst[o + 6] = bflo(q.w); dst[o + 7] = bfhi(q.w);
template <int LAST>
__device__ __forceinline__ void ph_peer(const P& p, int layer, int ntok, char* smem, int bid, int nb) {
  const int tid = tid_local();
  const int lane = tid & 63, w = tid >> 6;
  int* sExp = (int*)smem + w * 32;
  float* sGate = (float*)(smem + 512) + w * 32;
  uint32_t* LL = (uint32_t*)(smem + 1024) + w * 128;
  float* sPart = (float*)(smem + 4096);
  float* sRed = (float*)(smem + 4096 + 32768);
  const unsigned char* UBl = p.UB + (size_t)layer * 16384 * ROWB;
  const unsigned char* VBl = p.VB + (size_t)layer * 16384 * ROWB;
  const float* SUl = p.SU + layer * 16384;
  const float* SVl = p.SV + layer * 16384;
  const bf16_t* HP = LAST ? p.ABUF1 : p.ABUF0;
  int pi_ = 0, pj_ = 0;
  {
    int rem = lane;
    bool found = false;
#pragma unroll
    for (int ii = 0; ii < 16; ++ii) {
      const int nn = 16 / (ii + 1);
      if (!found && rem < nn) { pi_ = ii; pj_ = rem; found = true; }
      if (!found) rem -= nn;
    }
  }
  const bool pvalid_ = lane < 50;
  float scv[8];
  if (bid < ntok) {
    const float* sp = p.SC + (size_t)bid * DM + w * 512 + lane;
#pragma unroll
    for (int k = 0; k < 8; ++k) scv[k] = sp[k * 64];
  }
  for (int t = bid; t < ntok; t += nb) {
    for (int rep_ = 0; rep_ < REP_TOPK; ++rep_) {
      uint32_t key[4][2], prefix[4];
      int need[4];
#pragma unroll
      for (int g = 0; g < 4; ++g) {
        key[g][0] = (((fkey(scv[g * 2 + 0]) + 0x2000u) >> 14) << 7) | (uint32_t)lane;
        key[g][1] = (((fkey(scv[g * 2 + 1]) + 0x2000u) >> 14) << 7) | (uint32_t)(lane + 64);
        prefix[g] = 0u; need[g] = 16;
      }
#pragma unroll 4
      for (int bit = 24; bit >= 0; --bit) {
        const uint32_t mh = ~((1u << bit) - 1u);
#pragma unroll
        for (int g = 0; g < 4; ++g) {
          const uint32_t cand = prefix[g] | (1u << bit);
          const int c = __popcll(__ballot((key[g][0] & mh) == cand)) + __popcll(__ballot((key[g][1] & mh) == cand));
          const bool ge_ = c >= need[g];
          prefix[g] = ge_ ? cand : prefix[g];
          need[g] = ge_ ? need[g] : need[g] - c;
        }
      }
#pragma unroll
      for (int g = 0; g < 4; ++g) {
        const bool q0 = key[g][0] >= prefix[g], q1 = key[g][1] >= prefix[g];
        const unsigned long long b0 = __ballot(q0), b1 = __ballot(q1);
        const int r0 = __builtin_amdgcn_mbcnt_hi((unsigned)(b0 >> 32), __builtin_amdgcn_mbcnt_lo((unsigned)b0, 0u));
        const int r1 = __popcll(b0) + __builtin_amdgcn_mbcnt_hi((unsigned)(b1 >> 32), __builtin_amdgcn_mbcnt_lo((unsigned)b1, 0u));
        uint32_t* Ls = LL + (g >> 1) * 48 + (g & 1) * 16;
        if (q0) Ls[r0 & 15] = key[g][0];
        if (q1) Ls[r1 & 15] = key[g][1];
      }
      {
        uint32_t* Lg = LL + (lane >> 5) * 48 + ((lane >> 4) & 1) * 16;
        const uint32_t my = Lg[lane & 15];
        int rk = 0;
#pragma unroll
        for (int k = 0; k < 16; ++k) rk += (Lg[k] > my) ? 1 : 0;
        Lg[rk] = my;
      }
      uint32_t pk[2], cpre[2];
      int cneed[2];
#pragma unroll
      for (int hh = 0; hh < 2; ++hh) {
        const float s0 = funkey((LL[hh * 48 + pi_] >> 7) << 14);
        const float s1 = funkey((LL[hh * 48 + 16 + pj_] >> 7) << 14);
        pk[hh] = pvalid_ ? ((((fkey(s0 + s1) + 0x2000u) >> 14) << 8) | (uint32_t)(pi_ * 16 + pj_)) : 0u;
        cpre[hh] = 0u; cneed[hh] = 16;
      }
#pragma unroll 4
      for (int bit = 25; bit >= 0; --bit) {
        const uint32_t mh = ~((1u << bit) - 1u);
#pragma unroll
        for (int hh = 0; hh < 2; ++hh) {
          const uint32_t cand = cpre[hh] | (1u << bit);
          const int c = __popcll(__ballot((pk[hh] & mh) == cand));
          const bool ge_ = c >= cneed[hh];
          cpre[hh] = ge_ ? cand : cpre[hh];
          cneed[hh] = ge_ ? cneed[hh] : cneed[hh] - c;
        }
      }
#pragma unroll
      for (int hh = 0; hh < 2; ++hh) {
        uint32_t* L0 = LL + hh * 48;
        uint32_t* L1 = L0 + 16;
        uint32_t* L2 = L0 + 32;
        {
          const bool q = pk[hh] >= cpre[hh] && pk[hh] != 0u;
          const unsigned long long bq = __ballot(q);
          const int r = __builtin_amdgcn_mbcnt_hi((unsigned)(bq >> 32), __builtin_amdgcn_mbcnt_lo((unsigned)bq, 0u));
          if (q) L2[r & 15] = pk[hh];
        }
        const uint32_t mine = L2[lane & 15];
        const int cidx = (int)(mine & 255u);
        const float cv = funkey((mine >> 8) << 14);
        const int ia = (int)(L0[(cidx >> 4) & 15] & 127u);
        const int ib = (int)(L1[cidx & 15] & 127u);
        float mx = cv;
#pragma unroll
        for (int o = 8; o >= 1; o >>= 1) mx = fmaxf(mx, __shfl_xor(mx, o));
        const float ev = __expf(cv - mx);
        float sum = ev;
#pragma unroll
        for (int o = 8; o >= 1; o >>= 1) sum += __shfl_xor(sum, o);
        if (lane < 16) {
          sExp[hh * 16 + lane] = ia * 128 + ib;
          sGate[hh * 16 + lane] = ev / sum;
        }
      }
    }
    if (t + nb < ntok) {
      const float* sp = p.SC + (size_t)(t + nb) * DM + w * 512 + lane;
#pragma unroll
      for (int k = 0; k < 8; ++k) scv[k] = sp[k * 64];
    }
    u32x4 xq[4];
    {
      const u32x4* xr = (const u32x4*)(HP + (size_t)t * DM) + lane * 4;
#pragma unroll
      for (int q = 0; q < 4; ++q) xq[q] = xr[q];
    }
    float acc[32];
#pragma unroll
    for (int i = 0; i < 32; ++i) acc[i] = 0.f;
    u32x2 ub[2][3], vb[2][3];
    int ex[2], exn[2];
#pragma unroll
    for (int e = 0; e < 2; ++e) {
      exn[e] = __builtin_amdgcn_readfirstlane(sExp[e]);
      const u32x2* ur = (const u32x2*)(UBl + (size_t)exn[e] * ROWB) + lane;
#pragma unroll
      for (int jc = 0; jc < 3; ++jc) ub[e][jc] = ur[jc * 64];
    }
#pragma unroll 1
    for (int eb = 0; eb < 32; eb += 2) {
      float d[2];
#pragma unroll
      for (int e = 0; e < 2; ++e) {
        ex[e] = exn[e];
        v6u pk;
        pk[0] = ub[e][0].x; pk[1] = ub[e][0].y; pk[2] = ub[e][1].x; pk[3] = ub[e][1].y; pk[4] = ub[e][2].x; pk[5] = ub[e][2].y;
        const v32f uu = __builtin_amdgcn_cvt_scalef32_pk32_f32_fp6(pk, 1.0f);
        float sdot = 0.f;
#pragma unroll
        for (int q = 0; q < 4; ++q) {
          sdot += bflo(xq[q].x) * uu[q * 8 + 0] + bfhi(xq[q].x) * uu[q * 8 + 1] + bflo(xq[q].y) * uu[q * 8 + 2] + bfhi(xq[q].y) * uu[q * 8 + 3] +
                  bflo(xq[q].z) * uu[q * 8 + 4] + bfhi(xq[q].z) * uu[q * 8 + 5] + bflo(xq[q].w) * uu[q * 8 + 6] + bfhi(xq[q].w) * uu[q * 8 + 7];
        }
        d[e] = sdot;
        __builtin_amdgcn_sched_barrier(0);
      }
#pragma unroll
      for (int e = 0; e < 2; ++e) {
        const u32x2* vr = (const u32x2*)(VBl + (size_t)ex[e] * ROWB) + lane;
#pragma unroll
        for (int jc = 0; jc < 3; ++jc) vb[e][jc] = vr[jc * 64];
      }
      if (eb + 2 < 32) {
#pragma unroll
        for (int e = 0; e < 2; ++e) {
          exn[e] = __builtin_amdgcn_readfirstlane(sExp[eb + 2 + e]);
          const u32x2* ur = (const u32x2*)(UBl + (size_t)exn[e] * ROWB) + lane;
#pragma unroll
          for (int jc = 0; jc < 3; ++jc) ub[e][jc] = ur[jc * 64];
        }
      }
#pragma unroll
      for (int o = 32; o >= 1; o >>= 1) {
#pragma unroll
        for (int e = 0; e < 2; ++e) d[e] += __shfl_xor(d[e], o);
      }
#pragma unroll
      for (int e = 0; e < 2; ++e) {
        const float wg = sGate[eb + e] * gelu_f(d[e] * SUl[ex[e]]) * SVl[ex[e]];
        v6u pk;
        pk[0] = vb[e][0].x; pk[1] = vb[e][0].y; pk[2] = vb[e][1].x; pk[3] = vb[e][1].y; pk[4] = vb[e][2].x; pk[5] = vb[e][2].y;
        const v32f vv = __builtin_amdgcn_cvt_scalef32_pk32_f32_fp6(pk, 1.0f);
#pragma unroll
        for (int k = 0; k < 32; ++k) acc[k] += wg * vv[k];
        __builtin_amdgcn_sched_barrier(0);
      }
    }
    {
      float* dst = sPart + w * 2048 + lane * 32;
#pragma unroll
      for (int q = 0; q < 8; ++q) *(float4*)(dst + q * 4) = make_float4(acc[q * 4 + 0], acc[q * 4 + 1], acc[q * 4 + 2], acc[q * 4 + 3]);
    }
    __syncthreads();
    const int d0 = tid * 8;
    float r[8];
    {
      float4 a = *(const float4*)(sPart + d0), b = *(const float4*)(sPart + d0 + 4);
#pragma unroll
      for (int ww = 1; ww < 4; ++ww) {
        const float4 a2 = *(const float4*)(sPart + ww * 2048 + d0), b2 = *(const float4*)(sPart + ww * 2048 + d0 + 4);
        a.x += a2.x; a.y += a2.y; a.z += a2.z; a.w += a2.w; b.x += b2.x; b.y += b2.y; b.z += b2.z; b.w += b2.w;
      }
      r[0] = a.x; r[1] = a.y; r[2] = a.z; r[3] = a.w; r[4] = b.x; r[5] = b.y; r[6] = b.z; r[7] = b.w;
    }
    const int which = (t < TX) ? 0 : 1;
    const float* md = p.MOD + (size_t)(layer * 2 + which) * 12288;
    float* xrow = p.XA + (size_t)t * DM;
    float ss = 0.f;
#pragma unroll
    for (int hq = 0; hq < 2; ++hq) {
      const float4 xv = *(const float4*)(xrow + d0 + hq * 4);
      const float4 g2 = *(const float4*)(md + 5 * DM + d0 + hq * 4);
      float4 o;
      o.x = xv.x + g2.x * r[hq * 4 + 0]; o.y = xv.y + g2.y * r[hq * 4 + 1];
      o.z = xv.z + g2.z * r[hq * 4 + 2]; o.w = xv.w + g2.w * r[hq * 4 + 3];
      r[hq * 4 + 0] = o.x; r[hq * 4 + 1] = o.y; r[hq * 4 + 2] = o.z; r[hq * 4 + 3] = o.w;
      ss += o.x * o.x + o.y * o.y + o.z * o.z + o.w * o.w;
      if (!LAST) *(float4*)(xrow + d0 + hq * 4) = o;
    }
    ss = wave_sum(ss);
    if (lane == 0) sRed[w] = ss;
    __syncthreads();
    const float rstd = rsqrtf((sRed[0] + sRed[1] + sRed[2] + sRed[3]) * (1.f / DM) + 1e-6f);
    if (LAST) {
      float* orow = p.out + (size_t)t * DM;
#pragma unroll
      for (int hq = 0; hq < 2; ++hq) {
        const float4 g = *(const float4*)(p.norm_final + d0 + hq * 4);
        float4 o;
        o.x = r[hq * 4 + 0] * rstd * g.x; o.y = r[hq * 4 + 1] * rstd * g.y; o.z = r[hq * 4 + 2] * rstd * g.z; o.w = r[hq * 4 + 3] * rstd * g.w;
        *(float4*)(orow + d0 + hq * 4) = o;
      }
    } else {
      const float* md1 = p.MOD + (size_t)(2 + which) * 12288;
      const float* gn = p.norm_mix + DM;
      uint32_t o[4];
#pragma unroll
      for (int hq = 0; hq < 2; ++hq) {
        const float4 g = *(const float4*)(gn + d0 + hq * 4);
        const float4 sh = *(const float4*)(md1 + 0 * DM + d0 + hq * 4);
        const float4 sc = *(const float4*)(md1 + 1 * DM + d0 + hq * 4);
        const float y0 = r[hq * 4 + 0] * rstd * g.x * (1.f + sc.x) + sh.x;
        const float y1 = r[hq * 4 + 1] * rstd * g.y * (1.f + sc.y) + sh.y;
        const float y2 = r[hq * 4 + 2] * rstd * g.z * (1.f + sc.z) + sh.z;
        const float y3 = r[hq * 4 + 3] * rstd * g.w * (1.f + sc.w) + sh.w;
        o[hq * 2 + 0] = pack2(y0, y1); o[hq * 2 + 1] = pack2(y2, y3);
      }
      *(u32x4*)(p.ABUF1 + (size_t)t * DM + d0) = mk4(o[0], o[1], o[2], o[3]);
    }
    __syncthreads();
  }
}

__device__ __forceinline__ void ph_scores(const P& p, int ph, char* smem, int bid, int nb) {
  const int tid = tid_local(), lane = tid & 63, wid = tid >> 6, wr = wid >> 1, wc = wid & 1;
        const int layer = (ph == 7) ? 0 : 1;
        const int numM = (ph == 7) ? 66 : 64;
        bf16_t* sA = (bf16_t*)smem;
        bf16_t* sB = sA + 128 * LDS_S;
        for (int id = bid; id < numM * 16; id += nb) {
          const int mt = id % numM, hs = id / numM;
          f32x4 acc[4][4];
          gemm_core(acc, p.QB + (size_t)mt * 128 * DM + hs * 128, DM, p.KEYB + (size_t)(layer * 16 + hs) * 128 * 128, 128, 128, sA, sB);
#pragma unroll
          for (int mi = 0; mi < 4; ++mi)
#pragma unroll
            for (int ni = 0; ni < 4; ++ni)
#pragma unroll
              for (int j = 0; j < 4; ++j) {
                const int row = mt * 128 + wr * 64 + mi * 16 + (lane >> 4) * 4 + j;
                const int col = wc * 64 + ni * 16 + (lane & 15);
                p.SC[(size_t)row * DM + hs * 128 + col] = acc[mi][ni][j];
              }
        }
}

__device__ __forceinline__ void ph_qscores(const P& p, int layer, int M, char* smem, int bid, int nb) {
  const int tid = tid_local(), lane = tid & 63, wid = tid >> 6, wr = wid >> 1, wc = wid & 1;
  bf16_t* sA = (bf16_t*)smem;
  bf16_t* sB = sA + 128 * LDS_S;
  bf16_t* sQ = (bf16_t*)smem;
  const bf16_t* A = layer ? p.ABUF1 : p.ABUF0;
  const bf16_t* W = p.WT_PQ + (size_t)layer * DM * DM;
  const int numM = M >> 7, numN = 16, total = numM * numN;
  const int vb = ((nb & 7) == 0) ? (bid & 7) * (nb >> 3) + (bid >> 3) : bid;
  for (int id = vb; id < total; id += nb) {
    const int gsz = 8 * numN, g = id / gsz, fm = g * 8;
    const int rows = (numM - fm) < 8 ? (numM - fm) : 8;
    const int r = id - g * gsz;
    const int mt = fm + r % rows, nt = r / rows;
    f32x4 acc[4][4];
    gemm_core_t<4>(acc, A + (size_t)mt * 128 * DM, DM, W + (size_t)nt * 128 * DM, DM, DM, sA, sB);
    __syncthreads();
#pragma unroll
    for (int mi = 0; mi < 4; ++mi)
#pragma unroll
      for (int ni = 0; ni < 4; ++ni)
#pragma unroll
        for (int j = 0; j < 4; ++j)
          sQ[(wr * 64 + mi * 16 + (lane >> 4) * 4 + j) * 136 + wc * 64 + ni * 16 + (lane & 15)] = f2bf(acc[mi][ni][j]);
    __syncthreads();
    const bf16_t* Kb = p.KEYB + (size_t)(layer * 16 + nt) * 128 * 128;
    f32x4 acc2[4][4];
#pragma unroll
    for (int mi = 0; mi < 4; ++mi)
#pragma unroll
      for (int ni = 0; ni < 4; ++ni) acc2[mi][ni] = (f32x4){0.f, 0.f, 0.f, 0.f};
#pragma unroll
    for (int ks = 0; ks < 4; ++ks) {
      bf16x8 af[4], bk[4];
#pragma unroll
      for (int mi = 0; mi < 4; ++mi) af[mi] = *(const bf16x8*)(sQ + (wr * 64 + mi * 16 + (lane & 15)) * 136 + ks * 32 + (lane >> 4) * 8);
#pragma unroll
      for (int ni = 0; ni < 4; ++ni) bk[ni] = *(const bf16x8*)(Kb + (wc * 64 + ni * 16 + (lane & 15)) * 128 + ks * 32 + (lane >> 4) * 8);
#pragma unroll
      for (int mi = 0; mi < 4; ++mi)
#pragma unroll
        for (int ni = 0; ni < 4; ++ni)
          acc2[mi][ni] = __builtin_amdgcn_mfma_f32_16x16x32_bf16(af[mi], bk[ni], acc2[mi][ni], 0, 0, 0);
    }
#pragma unroll
    for (int mi = 0; mi < 4; ++mi)
#pragma unroll
      for (int ni = 0; ni < 4; ++ni)
#pragma unroll
        for (int j = 0; j < 4; ++j)
          p.SC[(size_t)(mt * 128 + wr * 64 + mi * 16 + (lane >> 4) * 4 + j) * DM + nt * 128 + wc * 64 + ni * 16 + (lane & 15)] = acc2[mi][ni][j];
  }
}

#define XB_TMO      128
#define XB_XCNT(j)  (256  + 64 * (j))
#define XB_XSUB(j)  (1280 + 64 * (j))
#define XB_XGEN(j)  (2304 + 64 * (j))
#define XB_TOP      3328
#define XB_TOPGEN   3392
#define XCD_BAR_WORDS 3456
#define XB_SPIN_CAP (1u << 22)
#define LAS __attribute__((address_space(3)))
__device__ __forceinline__ unsigned xb_ld(unsigned* p)              { return __hip_atomic_load(p, __ATOMIC_RELAXED, __HIP_MEMORY_SCOPE_AGENT); }
__device__ __forceinline__ unsigned xb_add(unsigned* p, unsigned v) { return __hip_atomic_fetch_add(p, v, __ATOMIC_RELAXED, __HIP_MEMORY_SCOPE_AGENT); }
__device__ __forceinline__ unsigned xb_xcc_id() { return (unsigned)__builtin_amdgcn_s_getreg((3 << 11) | 20) & 0xFu; }
#define XB_SPIN(cond, bar) do { unsigned _sp = 0; while (cond) { __builtin_amdgcn_s_sleep(1); \
    if ((++_sp & 255u) == 0u) { if (xb_ld(&(bar)[XB_TMO])) break; if (_sp > XB_SPIN_CAP) { atomicAdd(&(bar)[XB_TMO], 1u); break; } } } } while (0)
struct XcdBarrier { unsigned* bar; unsigned x; volatile LAS unsigned* st; };
__device__ __forceinline__ XcdBarrier xcd_barrier_post(unsigned* bar, volatile LAS unsigned* st) {
  XcdBarrier b; b.bar = bar; b.x = xb_xcc_id(); b.st = st;
  if (tid_local() == 0) (void)xb_add(&bar[XB_XCNT(b.x)], 1u);
  return b;
}
__device__ __forceinline__ void xcd_barrier_complete(unsigned* bar, unsigned x, unsigned& nloc, unsigned& nx, unsigned G) {
  unsigned sum, cnt, mine, sp = 0u;
  for (;;) {
    sum = 0u; cnt = 0u; mine = 0u;
#pragma unroll
    for (unsigned j = 0; j < 16; ++j) { const unsigned c = xb_ld(&bar[XB_XCNT(j)]); sum += c; cnt += (c > 0u) ? 1u : 0u; mine = (j == x) ? c : mine; }
    if (sum == G) break;
    __builtin_amdgcn_s_sleep(1);
    if ((++sp & 255u) == 0u) { if (xb_ld(&bar[XB_TMO])) break; if (sp > XB_SPIN_CAP) { atomicAdd(&bar[XB_TMO], 1u); break; } }
  }
  nloc = mine > 0u ? mine : 1u; nx = cnt > 0u ? cnt : 1u;
}
__device__ __forceinline__ void xcd_barrier_impl(unsigned* bar, unsigned x, volatile LAS unsigned* st, int tid_, unsigned G_) {
  asm volatile("s_waitcnt vmcnt(0)" ::: "memory");
  __syncthreads();
  if (tid_ == 0) {
    __builtin_amdgcn_s_waitcnt(0);
    const unsigned nloc = st[0], nx = st[1];
    const unsigned old = xb_add(&bar[XB_XSUB(x)], 1u);
    const unsigned gen = old / nloc;
    if (old + 1u == (gen + 1u) * nloc) {
      __builtin_amdgcn_fence(__ATOMIC_RELEASE, "agent");
      asm volatile("s_waitcnt vmcnt(0)" ::: "memory");
      const unsigned og = xb_add(&bar[XB_TOP], 1u);
      const unsigned tg = og / nx;
      if (og + 1u == (tg + 1u) * nx) xb_add(&bar[XB_TOPGEN], 1u);
      else XB_SPIN(xb_ld(&bar[XB_TOPGEN]) == tg, bar);
      __builtin_amdgcn_fence(__ATOMIC_ACQUIRE, "agent");
      xb_add(&bar[XB_XGEN(x)], 1u);
      asm volatile("s_waitcnt vmcnt(0)" ::: "memory");
    } else {
      XB_SPIN(xb_ld(&bar[XB_XGEN(x)]) == gen, bar);
      __builtin_amdgcn_fence(__ATOMIC_ACQUIRE, "agent");
      asm volatile("s_waitcnt vmcnt(0)" ::: "memory");
    }
  }
  __syncthreads();
}

template <bool COOP>
__global__ void __launch_bounds__(256, 2) mega(P p, int ph_lo, int ph_hi) {
  __shared__ __attribute__((aligned(16))) char smem[61424];
  const int bid = blockIdx.x, nb = gridDim.x;
  const int tid0 = tid_local();
#define PH_IDS int tid = tid_local(); const int lane = tid & 63, wid = tid >> 6, wr = wid >> 1, wc = wid & 1; (void)lane; (void)wr; (void)wc;
  if constexpr (COOP) { if (ph_hi < 0) cg::this_grid().sync(); }
  __shared__ uint4 xb_words;
  XcdBarrier xb;
  xb.bar = p.BAR; xb.x = 0u; xb.st = (volatile LAS unsigned*)&xb_words;
  if constexpr (COOP) {
    if (tid0 == 0) { xb.st[0] = 0u; xb.st[1] = 0u; }
    __syncthreads();
    xb = xcd_barrier_post(p.BAR, (volatile LAS unsigned*)&xb_words);
    if (tid0 == 0) {
      unsigned nloc = 1u, nx = 1u;
      xcd_barrier_complete(p.BAR, xb.x, nloc, nx, (unsigned)nb);
      xb.st[0] = nloc; xb.st[1] = nx;
    }
    __syncthreads();
  }
  {
    {
      if (PHON(0) && ph_lo <= 0 && 0 < ph_hi) { const int ph = 0; (void)ph;
        PH_IDS
        for (int rep_ = 0; rep_ < REP_P0; ++rep_) {
        ph_ada(p, smem, bid, nb, 0);
        ph_h2(p, smem, bid, nb);
        transpose_job(p.hy_w3, p.W3T, 64, 4096, 1, smem, bid, nb);
        transpose_job(p.ev_w_in, p.WT_EVIN, 2048, 5120, 1, smem, bid, nb);
        transpose_job(p.ev_w_out, p.WT_EVOUT, 2048, 2048, 1, smem, bid, nb);
        transpose_job(p.peer_q, p.WT_PQ, 2048, 2048, 1, smem, bid, nb);
        ph_small_convert(p, bid, nb);
        }
        if constexpr (COOP) if (ph + 1 < ph_hi) xcd_barrier_impl(xb.bar, xb.x, xb.st, (int)tid_local(), (unsigned)nb);
      }
      if (PHON(1) && ph_lo <= 1 && 1 < ph_hi) { const int ph = 1; (void)ph;
        PH_IDS
        for (int rep_ = 0; rep_ < REP_GEMM; ++rep_) {
        ph_norm(p.x, p.ctx, TS, p.norm_mix, p.MOD, p.MOD + 12288, 0, 1, p.ABUF0, bid, nb);
        gemm_phase(p.H2B, 64, p.W3T, 64, TS, 4096, 64, smem, bid, nb, [&](int row0, int col, f32x4 v) {
          const float ad = fabsf(p.hy_deltas[col]);
          float o[4];
#pragma unroll
          for (int j = 0; j < 4; ++j) {
            const int row = row0 + j;
            const float tn = row < TX ? (float)row * (1.f / 8191.f) : (float)(row - TX) * (1.f / 255.f);
            o[j] = v[j] * __expf(-tn * ad);
          }
          *(u32x2*)(p.FILT + (size_t)col * TS + row0) = mk2(pack2(o[0], o[1]), pack2(o[2], o[3]));
        });
        }
        if constexpr (COOP) if (ph + 1 < ph_hi) xcd_barrier_impl(xb.bar, xb.x, xb.st, (int)tid_local(), (unsigned)nb);
      }
      if (PHON(2) && ph_lo <= 2 && 2 < ph_hi) { const int ph = 2; (void)ph;
        PH_IDS
        for (int rep_ = 0; rep_ < REP_GEMM; ++rep_) {
        gemm_phase(p.ABUF0, DM, p.WT_EVIN, DM, TS, 5120, DM, smem, bid, nb, [&](int row0, int col, f32x4 v) {
          float4 o;
          if (col < 3072) { o.x = v[0]; o.y = v[1]; o.z = v[2]; o.w = v[3]; }
          else { o.x = gelu_f(v[0]); o.y = gelu_f(v[1]); o.z = gelu_f(v[2]); o.w = gelu_f(v[3]); }
          *(float4*)(p.PROJT + (size_t)col * TS + row0) = o;
        });
        }
        if constexpr (COOP) if (ph + 1 < ph_hi) xcd_barrier_impl(xb.bar, xb.x, xb.st, (int)tid_local(), (unsigned)nb);
      }
      if (PHON(3) && ph_lo <= 3 && 3 < ph_hi) { const int ph = 3; (void)ph;
        PH_IDS
        for (int rep_ = 0; rep_ < REP_P3; ++rep_) {
        const bool conv_first = ((bid / (nb >> 1)) & 1) != 0;
#define LATE_PREP() { ph_tables(p, bid, nb); __syncthreads(); ph_ada(p, smem, bid, nb, 1); \
          transpose_job(p.od_w_in, p.WT_ODIN, 2048, 3072, 1, smem, bid, nb); \
          transpose_job(p.od_w_out, p.WT_ODOUT, 2048, 2048, 1, smem, bid, nb); \
          transpose_job(p.peer_q + (size_t)DM * DM, p.WT_PQ + (size_t)DM * DM, 2048, 2048, 1, smem, bid, nb); \
          transpose_job(p.pool_w, p.WTPOOL, 256, 256, 4, smem, bid, nb); __syncthreads(); }
        if (conv_first) LATE_PREP()
        for (int item = bid; item < 2048 + 528; item += nb) {
          if (item < 1024) hyena_item<0>(p, smem, item);
          else if (item < 2048) hyena_item<1>(p, smem, item - 1024);
          else gmlp_item(p, smem, (item - 2048) >> 3, (item - 2048) & 7);
        }
        if (!conv_first) LATE_PREP()
        }
        if constexpr (COOP) if (ph + 1 < ph_hi) xcd_barrier_impl(xb.bar, xb.x, xb.st, (int)tid_local(), (unsigned)nb);
      }
      if (PHON(4) && ph_lo <= 4 && 4 < ph_hi) { const int ph = 4; (void)ph;
        PH_IDS
        for (int rep_ = 0; rep_ < REP_GEMM; ++rep_) {
        gemm_phase(p.ABUF1, DM, p.WT_EVOUT, DM, TS, DM, DM, smem, bid, nb, [&](int row0, int col, f32x4 v) {
#pragma unroll
          for (int j = 0; j < 4; ++j) {
            const int row = row0 + j;
            const float base = row < TX ? p.x[(size_t)row * DM + col] : p.ctx[(size_t)(row - TX) * DM + col];
            const float g = p.MOD[(size_t)(row < TX ? 0 : 1) * 12288 + 2 * DM + col];
            p.XA[(size_t)row * DM + col] = base + g * v[j];
          }
        });
        }
        if constexpr (COOP) if (ph + 1 < ph_hi) xcd_barrier_impl(xb.bar, xb.x, xb.st, (int)tid_local(), (unsigned)nb);
      }
      if (PHON(5) && ph_lo <= 5 && 5 < ph_hi) { const int ph = 5; (void)ph;
        PH_IDS
        ph_norm(p.XA, p.XA + (size_t)TX * DM, TS, p.norm_ffn, p.MOD, p.MOD + 12288, 3, 4, p.ABUF0, bid, nb);
        if constexpr (COOP) if (ph + 1 < ph_hi) xcd_barrier_impl(xb.bar, xb.x, xb.st, (int)tid_local(), (unsigned)nb);
      }
      if (PHON(6) && ph_lo <= 6 && 6 < ph_hi) { const int ph = 6; (void)ph;
        ph_qscores(p, 0, TS, smem, bid, nb);
        if constexpr (COOP) if (ph + 1 < ph_hi) xcd_barrier_impl(xb.bar, xb.x, xb.st, (int)tid_local(), (unsigned)nb);
      }
      if (PHON(8) && ph_lo <= 8 && 8 < ph_hi) { const int ph = 8; (void)ph;
        PH_IDS
        ph_peer<0>(p, 0, TS, smem, bid, nb);
        if constexpr (COOP) if (ph + 1 < ph_hi) xcd_barrier_impl(xb.bar, xb.x, xb.st, (int)tid_local(), (unsigned)nb);
      }
      if (PHON(9) && ph_lo <= 9 && 9 < ph_hi) { const int ph = 9; (void)ph;
        PH_IDS
        for (int rep_ = 0; rep_ < REP_GEMM; ++rep_) {
        gemm_phase(p.ABUF1, DM, p.WT_ODIN, DM, TS, 3072, DM, smem, bid, nb, [&](int row0, int col, f32x4 v) {
#pragma unroll
          for (int j = 0; j < 4; ++j) p.PROJ1[(size_t)(row0 + j) * 3072 + col] = (col < 1024) ? gelu_f(v[j]) : v[j];
        });
        }
        if constexpr (COOP) if (ph + 1 < ph_hi) xcd_barrier_impl(xb.bar, xb.x, xb.st, (int)tid_local(), (unsigned)nb);
      }
      if (PHON(10) && ph_lo <= 10 && 10 < ph_hi) { const int ph = 10; (void)ph;
        PH_IDS
        for (int rep_ = 0; rep_ < REP_L1S; ++rep_) {
        for (int idx = bid * 256 + tid; idx < TS * 256; idx += nb * 256) {
          const int t = idx >> 8, c4 = (idx & 255) * 4;
          const int lo = t < TX ? 0 : TX, hi = t < TX ? TX : TS;
          float4 a = *(const float4*)(p.od_conv_b + c4);
#pragma unroll
          for (int k = 0; k < 4; ++k) {
            const int tt = t + k - 1;
            if (tt >= lo && tt < hi) {
              const float4 xv = *(const float4*)(p.PROJ1 + (size_t)tt * 3072 + 1024 + c4);
              const float4 wv = *(const float4*)(p.od_conv_w + k * 1024 + c4);
              a.x += wv.x * xv.x; a.y += wv.y * xv.y; a.z += wv.z * xv.z; a.w += wv.w * xv.w;
            }
          }
          *(float4*)(p.XR + (size_t)t * 1024 + c4) = a;
          *(u32x2*)(p.XRB + (size_t)t * 1024 + c4) = mk2(pack2(a.x, a.y), pack2(a.z, a.w));
        }
        for (int idx = bid * 256 + tid; idx < TX * 256; idx += nb * 256) {
          const int t = idx >> 8, c4 = (idx & 255) * 4;
          const int half = 1 << (c4 >> 8);
          const int lo = (t - half) < 0 ? 0 : (t - half);
          const int hi = (t + half) > TX ? TX : (t + half);
          float4 s = make_float4(0.f, 0.f, 0.f, 0.f);
          for (int q = lo; q < hi; ++q) {
            const float4 xv = *(const float4*)(p.PROJ1 + (size_t)q * 3072 + 2048 + c4);
            s.x += xv.x; s.y += xv.y; s.z += xv.z; s.w += xv.w;
          }
          const float inv = 1.f / (float)(hi - lo);
          const float4 x0 = *(const float4*)(p.PROJ1 + (size_t)t * 3072 + 2048 + c4);
          *(u32x2*)(p.PD + (size_t)t * 1024 + c4) = mk2(pack2(s.x * inv - x0.x, s.y * inv - x0.y), pack2(s.z * inv - x0.z, s.w * inv - x0.w));
        }
        }
        if constexpr (COOP) if (ph + 1 < ph_hi) xcd_barrier_impl(xb.bar, xb.x, xb.st, (int)tid_local(), (unsigned)nb);
      }
      if (PHON(11) && ph_lo <= 11 && 11 < ph_hi) { const int ph = 11; (void)ph;
        PH_IDS
        for (int rep_ = 0; rep_ < REP_L1S; ++rep_) {
        bf16_t* sA = (bf16_t*)smem;
        bf16_t* sB = sA + 128 * LDS_S;
        for (int id = bid; id < 2112 + 512; id += nb) {
          f32x4 acc[4][4];
          if (id < 2112) {
            const int mt = id % 66, g = id / 66, dir = g >> 4, hh = g & 15, h = hh >> 1, half = hh & 1;
            gemm_core(acc, p.XRB + (size_t)mt * 128 * 1024 + h * 128, 1024, p.WG + (size_t)(dir * 16 + hh) * 128 * 128, 128, 128, sA, sB);
#pragma unroll
            for (int gq = 0; gq < 2; ++gq) {
              const int c = h * 128 + half * 64 + (wc * 2 + gq) * 16 + (lane & 15);
              const float ba = p.lru_ba[dir * 1024 + c], bx = p.lru_bx[dir * 1024 + c];
              const float sp = log1pf(expf(-p.lru_lam[dir * 1024 + c]));
#pragma unroll
              for (int mi = 0; mi < 4; ++mi)
#pragma unroll
                for (int j = 0; j < 4; ++j) {
                  const int t = mt * 128 + wr * 64 + mi * 16 + (lane >> 4) * 4 + j;
                  const float r = sigmoid_f(acc[mi][2 * gq][j] + ba);
                  const float ii = sigmoid_f(acc[mi][2 * gq + 1][j] + bx);
                  const float la = -8.f * r * sp;
                  const float a = expf(la);
                  const float b = sqrtf(-expm1f(2.f * la)) * ii * p.XR[(size_t)t * 1024 + c];
                  p.ABA[((size_t)dir * TS + t) * 1024 + c] = a;
                  p.ABB[((size_t)dir * TS + t) * 1024 + c] = b;
                }
            }
          } else {
            const int id2 = id - 2112, mt = id2 & 63, rest = id2 >> 6, g = rest >> 1, nh = rest & 1;
            gemm_core(acc, p.PD + (size_t)mt * 128 * 1024 + g * 256, 1024, p.WTPOOL + (size_t)g * 256 * 256 + (size_t)nh * 128 * 256, 256, 256, sA, sB);
#pragma unroll
            for (int mi = 0; mi < 4; ++mi)
#pragma unroll
              for (int ni = 0; ni < 4; ++ni) {
                const int cc = g * 256 + nh * 128 + wc * 64 + ni * 16 + (lane & 15);
                const float pb = p.pool_b[cc], ps = p.pool_scale[cc];
#pragma unroll
                for (int j = 0; j < 4; ++j) {
                  const int t = mt * 128 + wr * 64 + mi * 16 + (lane >> 4) * 4 + j;
                  p.ABUF0[(size_t)t * DM + 1024 + cc] = f2bf((acc[mi][ni][j] + pb) * ps);
                }
              }
          }
        }
        }
        if constexpr (COOP) if (ph + 1 < ph_hi) xcd_barrier_impl(xb.bar, xb.x, xb.st, (int)tid_local(), (unsigned)nb);
      }
      if (PHON(12) && ph_lo <= 12 && 12 < ph_hi) { const int ph = 12; (void)ph;
        PH_IDS
        for (int rep_ = 0; rep_ < REP_L1S; ++rep_) {
        for (int item = bid; item < 2 * 132 * 4; item += nb) {
          const int dir = item / 528, rem = item % 528, k = rem >> 2, c = (rem & 3) * 256 + tid;
          const float* pa = p.ABA + (size_t)dir * TS * 1024 + c;
          const float* pb = p.ABB + (size_t)dir * TS * 1024 + c;
          float Pp = 1.f, H = 0.f;
#pragma unroll 8
          for (int s = 0; s < 64; ++s) {
            const int t = dir ? (k * 64 + 63 - s) : (k * 64 + s);
            const float a = pa[(size_t)t * 1024], b = pb[(size_t)t * 1024];
            H = a * H + b; Pp *= a;
          }
          p.AGG[(size_t)(dir * 132 + k) * 1024 + c] = make_float2(Pp, H);
        }
        }
        if constexpr (COOP) if (ph + 1 < ph_hi) xcd_barrier_impl(xb.bar, xb.x, xb.st, (int)tid_local(), (unsigned)nb);
      }
      if (PHON(13) && ph_lo <= 13 && 13 < ph_hi) { const int ph = 13; (void)ph;
        PH_IDS
        for (int rep_ = 0; rep_ < REP_L1S; ++rep_) {
        float* hf = (float*)smem;
        for (int item = bid; item < 1024; item += nb) {
          const int k = item >> 3, cb = item & 7, cl = tid & 127, c = cb * 128 + cl, dir = tid >> 7;
          const float2* ag = p.AGG + (size_t)dir * 132 * 1024 + c;
          const int npre = 4 + (dir ? (127 - k) : k);
          float h = 0.f;
#pragma unroll 8
          for (int v = 0; v < npre; ++v) {
            const int q = dir ? (v < 4 ? 131 - v : 131 - v) : (v < 4 ? 128 + v : v - 4);
            const float2 g = ag[(size_t)q * 1024];
            h = g.x * h + g.y;
          }
          const float* pa = p.ABA + (size_t)dir * TS * 1024 + c;
          const float* pb = p.ABB + (size_t)dir * TS * 1024 + c;
          if (dir == 0) {
#pragma unroll 8
            for (int s = 0; s < 64; ++s) {
              const int t = k * 64 + s;
              h = pa[(size_t)t * 1024] * h + pb[(size_t)t * 1024];
              hf[s * 128 + cl] = h;
            }
          }
          __syncthreads();
          if (dir == 1) {
#pragma unroll 8
            for (int s = 63; s >= 0; --s) {
              const int t = k * 64 + s;
              h = pa[(size_t)t * 1024] * h + pb[(size_t)t * 1024];
              const float y = p.PROJ1[(size_t)t * 3072 + c] * (hf[s * 128 + cl] + h);
              p.ABUF0[(size_t)t * DM + c] = f2bf(y);
            }
          }
          __syncthreads();
        }
        }
        if constexpr (COOP) if (ph + 1 < ph_hi) xcd_barrier_impl(xb.bar, xb.x, xb.st, (int)tid_local(), (unsigned)nb);
      }
      if (PHON(14) && ph_lo <= 14 && 14 < ph_hi) { const int ph = 14; (void)ph;
        PH_IDS
        gemm_phase(p.ABUF0, DM, p.WT_ODOUT, DM, TX, DM, DM, smem, bid, nb, [&](int row0, int col, f32x4 v) {
          const float g = p.MOD[(size_t)2 * 12288 + 2 * DM + col];
#pragma unroll
          for (int j = 0; j < 4; ++j) {
            float* d = p.XA + (size_t)(row0 + j) * DM + col;
            *d = *d + g * v[j];
          }
        });
        if constexpr (COOP) if (ph + 1 < ph_hi) xcd_barrier_impl(xb.bar, xb.x, xb.st, (int)tid_local(), (unsigned)nb);
      }
      if (PHON(15) && ph_lo <= 15 && 15 < ph_hi) { const int ph = 15; (void)ph;
        PH_IDS
        ph_norm(p.XA, p.XA + (size_t)TX * DM, TX, p.norm_ffn + DM, p.MOD + 2 * 12288, p.MOD + 3 * 12288, 3, 4, p.ABUF1, bid, nb);
        if constexpr (COOP) if (ph + 1 < ph_hi) xcd_barrier_impl(xb.bar, xb.x, xb.st, (int)tid_local(), (unsigned)nb);
      }
      if (PHON(16) && ph_lo <= 16 && 16 < ph_hi) { const int ph = 16; (void)ph;
        ph_qscores(p, 1, TX, smem, bid, nb);
        if constexpr (COOP) if (ph + 1 < ph_hi) xcd_barrier_impl(xb.bar, xb.x, xb.st, (int)tid_local(), (unsigned)nb);
      }
      if (PHON(18) && ph_lo <= 18 && 18 < ph_hi) { const int ph = 18; (void)ph;
        PH_IDS
        for (int rep_ = 0; rep_ < REP_P18; ++rep_) {
        ph_peer<1>(p, 1, TX, smem, bid, nb);
        }
        if constexpr (COOP) if (ph + 1 < ph_hi) xcd_barrier_impl(xb.bar, xb.x, xb.st, (int)tid_local(), (unsigned)nb);
      }
    }
  }
}

extern "C" void kernel_launch(void* const* d_in, const int* in_sizes, int n_in, void* d_out, int out_size, void* d_ws,
                              size_t ws_size, hipStream_t stream) {
  P p{};
  const float** pin = (const float**)&p;
  for (int i = 0; i < 40; ++i) pin[i] = (const float*)d_in[i];
  p.out = (float*)d_out;
  char* ws = (char*)d_ws;
  size_t off = 0;
  auto alloc = [&](size_t bytes) { char* r = ws + off; off += (bytes + 255) & ~(size_t)255; return r; };
  p.MOD = (float*)alloc(4 * 12288 * 4);
  p.H2B = (bf16_t*)alloc((size_t)TS * 64 * 2);
  p.W3T = (bf16_t*)alloc((size_t)4096 * 64 * 2);
  p.WT_EVIN = (bf16_t*)alloc((size_t)5120 * 2048 * 2);
  p.WT_EVOUT = (bf16_t*)alloc((size_t)2048 * 2048 * 2);
  p.WT_ODIN = (bf16_t*)alloc((size_t)3072 * 2048 * 2);
  p.WT_ODOUT = (bf16_t*)alloc((size_t)2048 * 2048 * 2);
  p.WT_PQ = (bf16_t*)alloc((size_t)2 * 2048 * 2048 * 2);
  p.WG = (bf16_t*)alloc((size_t)2 * 16 * 128 * 128 * 2);
  p.KEYB = (bf16_t*)alloc((size_t)2 * 16 * 128 * 128 * 2);
  p.GMWS = (bf16_t*)alloc((size_t)8 * 128 * 128 * 2);
  p.WTPOOL = (bf16_t*)alloc((size_t)4 * 256 * 256 * 2);
  p.UB = (unsigned char*)alloc((size_t)2 * 16384 * 2048);
  p.VB = (unsigned char*)alloc((size_t)2 * 16384 * 2048);
  p.SU = (float*)alloc((size_t)2 * 16384 * 4);
  p.SV = (float*)alloc((size_t)2 * 16384 * 4);
  p.ABUF0 = (bf16_t*)alloc((size_t)TS * DM * 2);
  p.ABUF1 = (bf16_t*)alloc((size_t)TS * DM * 2);
  {
    char* r1 = alloc((size_t)5120 * TS * 4);
    p.PROJT = (float*)r1;
    p.PROJ1 = (float*)r1;
    p.XR = (float*)(r1 + (size_t)TS * 3072 * 4);
    p.XRB = (bf16_t*)(r1 + (size_t)TS * 3072 * 4 + (size_t)TS * 1024 * 4);
    p.PD = (bf16_t*)(r1 + (size_t)TS * 3072 * 4 + (size_t)TS * 1024 * 4 + (size_t)TS * 1024 * 2);
  }
  {
    char* r2 = alloc((size_t)2 * 2 * TS * 1024 * 4);
    p.FILT = (bf16_t*)r2;
    p.Z1 = (float*)(r2 + (size_t)4096 * TS * 2);
    p.ABA = (float*)r2;
    p.ABB = (float*)(r2 + (size_t)2 * TS * 1024 * 4);
  }
  p.XA = (float*)alloc((size_t)TS * DM * 4);
  p.QB = (bf16_t*)alloc((size_t)TS * DM * 2);
  p.SC = (float*)alloc((size_t)TS * DM * 4);
  p.AGG = (float2*)alloc((size_t)2 * 132 * 1024 * 8);
  p.BAR = (unsigned*)alloc(XCD_BAR_WORDS * 4);
  if (off > ws_size) { fprintf(stderr, "workspace too small: need %zu have %zu\n", off, ws_size); return; }

#if ONE_LAUNCH
  static int grid_blocks = 0;
  if (!grid_blocks) {
    int dev = 0, cus = 0, per_cu = 0;
    hipGetDevice(&dev);
    hipDeviceGetAttribute(&cus, hipDeviceAttributeMultiprocessorCount, dev);
    hipOccupancyMaxActiveBlocksPerMultiprocessor(&per_cu, mega<true>, 256, 0);
    if (per_cu > 2) per_cu = 2;
    grid_blocks = cus * per_cu;
  }
  int lo = 0, hi = NPH;
  void* args[] = {&p, &lo, &hi};
  hipMemsetAsync(p.BAR, 0, XCD_BAR_WORDS * 4, stream);
  hipError_t e = hipLaunchCooperativeKernel((void*)mega<true>, dim3(grid_blocks), dim3(256), args, 0, stream);
  if (e != hipSuccess) fprintf(stderr, "cooperative launch failed: %s (grid %d)\n", hipGetErrorString(e), grid_blocks);
#else
  for (int ph = 0; ph < NPH; ++ph) mega<false><<<512, 256, 0, stream>>>(p, ph, ph + 1);
#endif
}
```

```cpp
#include <hip/hip_runtime.h>
#include <hip/hip_cooperative_groups.h>
#include <stdint.h>
#include <cstdio>
namespace cg = cooperative_groups;

#ifndef ONE_LAUNCH
#define ONE_LAUNCH 1
#endif

typedef unsigned short bf16_t;
using bf16x8 = __attribute__((ext_vector_type(8))) short;
using f32x4 = __attribute__((ext_vector_type(4))) float;
using u32x4 = __attribute__((ext_vector_type(4))) unsigned int;
using u32x2 = __attribute__((ext_vector_type(2))) unsigned int;
__device__ __forceinline__ u32x4 mk4(unsigned a, unsigned b, unsigned c, unsigned d) { u32x4 r; r.x = a; r.y = b; r.z = c; r.w = d; return r; }
__device__ __forceinline__ u32x2 mk2(unsigned a, unsigned b) { u32x2 r; r.x = a; r.y = b; return r; }

#define TS 8448
#define TX 8192
#define DM 2048
#define NPH 19
#ifndef ONLY_PH
#define ONLY_PH -1
#endif
#define PHON(k) (ONLY_PH < 0 || ONLY_PH == (k))
#ifndef REP_P0
#define REP_P0 1
#endif
#ifndef REP_GEMM
#define REP_GEMM 1
#endif
#ifndef REP_P3
#define REP_P3 1
#endif
#ifndef REP_P18
#define REP_P18 1
#endif
#ifndef REP_TOPK
#define REP_TOPK 1
#endif
#ifndef REP_L1S
#define REP_L1S 1
#endif

struct P {
  const float *x, *c, *ctx, *cctx, *ada_w, *ada_b, *norm_mix, *norm_ffn, *norm_final;
  const float *ev_w_in, *ev_conv_w, *ev_conv_b, *hy_w1, *hy_b1, *hy_w2, *hy_b2, *hy_w3, *hy_freq, *hy_deltas, *hy_bias;
  const float *gm_norm, *gm_ws, *gm_bs, *ev_w_out;
  const float *od_w_in, *od_conv_w, *od_conv_b, *lru_wa, *lru_ba, *lru_wx, *lru_bx, *lru_lam, *pool_w, *pool_b, *pool_scale, *od_w_out;
  const float *peer_q, *peer_keys, *peer_u, *peer_v;
  float* out;
  float* MOD;
  bf16_t* H2B;
  bf16_t* W3T;
  bf16_t* WT_EVIN;
  bf16_t* WT_EVOUT;
  bf16_t* WT_ODIN;
  bf16_t* WT_ODOUT;
  bf16_t* WT_PQ;
  bf16_t* WG;
  bf16_t* KEYB;
  bf16_t* GMWS;
  bf16_t* WTPOOL;
  unsigned char* UB;
  unsigned char* VB;
  float* SU;
  float* SV;
  bf16_t* ABUF0;
  bf16_t* ABUF1;
  float* PROJT;
  float* PROJ1;
  float* XR;
  bf16_t* XRB;
  bf16_t* PD;
  bf16_t* FILT;
  float* Z1;
  float* ABA;
  float* ABB;
  float* XA;
  bf16_t* QB;
  float* SC;
  float2* AGG;
  unsigned* BAR;
};

__device__ __forceinline__ int tid_local() { int t_ = (int)threadIdx.x; asm volatile("" : "+v"(t_)); return t_; }
__device__ __forceinline__ bf16_t f2bf(float f) {
  uint32_t u = __float_as_uint(f);
  u += 0x7FFFu + ((u >> 16) & 1u);
  return (bf16_t)(u >> 16);
}
__device__ __forceinline__ float bf2f(bf16_t b) { return __uint_as_float(((uint32_t)b) << 16); }
__device__ __forceinline__ uint32_t pack2(float a, float b) { return (uint32_t)f2bf(a) | ((uint32_t)f2bf(b) << 16); }
__device__ __forceinline__ float bflo(uint32_t u) { return __uint_as_float(u << 16); }
__device__ __forceinline__ float bfhi(uint32_t u) { return __uint_as_float(u & 0xFFFF0000u); }
__device__ __forceinline__ float gelu_f(float x) {
  float u = 0.7978845608028654f * (x + 0.044715f * x * x * x);
  return x / (1.f + __expf(-2.f * u));
}
__device__ __forceinline__ float sigmoid_f(float x) { return 1.f / (1.f + __expf(-x)); }
__device__ __forceinline__ float wave_sum(float v) {
#pragma unroll
  for (int o = 32; o >= 1; o >>= 1) v += __shfl_xor(v, o);
  return v;
}
__device__ __forceinline__ uint32_t wave_max_u32(uint32_t v) {
#pragma unroll
  for (int o = 32; o >= 1; o >>= 1) { uint32_t t = (uint32_t)__shfl_xor((int)v, o); v = v > t ? v : t; }
  return v;
}
__device__ __forceinline__ uint32_t fkey(float f) { uint32_t u = __float_as_uint(f); return (u & 0x80000000u) ? ~u : (u | 0x80000000u); }
__device__ __forceinline__ float funkey(uint32_t k) { uint32_t u = (k & 0x80000000u) ? (k & 0x7FFFFFFFu) : ~k; return __uint_as_float(u); }

#define LDS_S 72
template <int NI>
__device__ __forceinline__ void gemm_core_t(f32x4 (&acc)[4][NI], const bf16_t* __restrict__ A, int lda,
                                            const bf16_t* __restrict__ Bt, int ldb, int K, bf16_t* sA, bf16_t* sB) {
  const int tid = tid_local(), lane = tid & 63, wid = tid >> 6, wr = wid >> 1, wc = wid & 1;
  const int lr = tid >> 3, lc = (tid & 7) * 8;
#pragma unroll
  for (int i = 0; i < 4; ++i)
#pragma unroll
    for (int j = 0; j < NI; ++j) acc[i][j] = (f32x4){0.f, 0.f, 0.f, 0.f};
  u32x4 ra[4], rb[NI];
#pragma unroll
  for (int i = 0; i < 4; ++i) ra[i] = *(const u32x4*)(A + (size_t)(lr + 32 * i) * lda + lc);
#pragma unroll
  for (int i = 0; i < NI; ++i) rb[i] = *(const u32x4*)(Bt + (size_t)(lr + 32 * i) * ldb + lc);
  const int nk = K >> 6;
  for (int kt = 0; kt < nk; ++kt) {
    __syncthreads();
#pragma unroll
    for (int i = 0; i < 4; ++i) *(u32x4*)(sA + (lr + 32 * i) * LDS_S + lc) = ra[i];
#pragma unroll
    for (int i = 0; i < NI; ++i) *(u32x4*)(sB + (lr + 32 * i) * LDS_S + lc) = rb[i];
    __syncthreads();
    if (kt + 1 < nk) {
      const int ko = (kt + 1) * 64;
#pragma unroll
      for (int i = 0; i < 4; ++i) ra[i] = *(const u32x4*)(A + (size_t)(lr + 32 * i) * lda + ko + lc);
#pragma unroll
      for (int i = 0; i < NI; ++i) rb[i] = *(const u32x4*)(Bt + (size_t)(lr + 32 * i) * ldb + ko + lc);
    }
    __builtin_amdgcn_sched_barrier(0);
    bf16x8 af[2][4], bfr[2][NI];
#pragma unroll
    for (int ks = 0; ks < 2; ++ks) {
#pragma unroll
      for (int mi = 0; mi < 4; ++mi)
        af[ks][mi] = *(const bf16x8*)(sA + (wr * 64 + mi * 16 + (lane & 15)) * LDS_S + ks * 32 + (lane >> 4) * 8);
#pragma unroll
      for (int ni = 0; ni < NI; ++ni)
        bfr[ks][ni] = *(const bf16x8*)(sB + (wc * 16 * NI + ni * 16 + (lane & 15)) * LDS_S + ks * 32 + (lane >> 4) * 8);
    }
#pragma unroll
    for (int ks = 0; ks < 2; ++ks)
#pragma unroll
      for (int mi = 0; mi < 4; ++mi)
#pragma unroll
        for (int ni = 0; ni < NI; ++ni)
          acc[mi][ni] = __builtin_amdgcn_mfma_f32_16x16x32_bf16(af[ks][mi], bfr[ks][ni], acc[mi][ni], 0, 0, 0);
  }
}
__device__ __forceinline__ void gemm_core(f32x4 (&acc)[4][4], const bf16_t* __restrict__ A, int lda,
                                          const bf16_t* __restrict__ Bt, int ldb, int K, bf16_t* sA, bf16_t* sB) {
  gemm_core_t<4>(acc, A, lda, Bt, ldb, K, sA, sB);
}

template <class Epi>
__device__ __forceinline__ void gemm_phase(const bf16_t* A, int lda, const bf16_t* Bt, int ldb, int M, int N, int K,
                                           char* smem, int bid, int nb, Epi epi) {
  const int numM = M >> 7, numN = N >> 7;
  bf16_t* sA = (bf16_t*)smem;
  bf16_t* sB = sA + 128 * LDS_S;
  const int lane = tid_local() & 63, wid = tid_local() >> 6, wr = wid >> 1, wc = wid & 1;
  const int total = numM * numN;
  const int full = (total / nb) * nb;
  const int vb = ((nb & 7) == 0) ? (bid & 7) * (nb >> 3) + (bid >> 3) : bid;
  auto tile_of = [&](int id, int& mt, int& nt) {
    const int gsz = 8 * numN, g = id / gsz, fm = g * 8;
    const int rows = (numM - fm) < 8 ? (numM - fm) : 8;
    const int r = id - g * gsz;
    mt = fm + r % rows; nt = r / rows;
  };
  for (int id = vb; id < full; id += nb) {
    int mt, nt;
    tile_of(id, mt, nt);
    f32x4 acc[4][4];
    gemm_core_t<4>(acc, A + (size_t)mt * 128 * lda, lda, Bt + (size_t)nt * 128 * ldb, ldb, K, sA, sB);
#pragma unroll
    for (int mi = 0; mi < 4; ++mi)
#pragma unroll
      for (int ni = 0; ni < 4; ++ni)
        epi(mt * 128 + wr * 64 + mi * 16 + (lane >> 4) * 4, nt * 128 + wc * 64 + ni * 16 + (lane & 15), acc[mi][ni]);
  }
  for (int u = vb; u < (total - full) * 4; u += nb) {
    const int id = full + (u >> 2), qd = u & 3;
    int mt, nt;
    tile_of(id, mt, nt);
    f32x4 acc[4][1];
    gemm_core_t<1>(acc, A + (size_t)mt * 128 * lda, lda, Bt + (size_t)(nt * 128 + qd * 32) * ldb, ldb, K, sA, sB);
#pragma unroll
    for (int mi = 0; mi < 4; ++mi)
      epi(mt * 128 + wr * 64 + mi * 16 + (lane >> 4) * 4, nt * 128 + qd * 32 + wc * 16 + (lane & 15), acc[mi][0]);
  }
}

__device__ __forceinline__ void ph_ada(const P& p, char* smem, int bid, int nb, int layer) {
  float* sc = (float*)smem;
  float* sx = sc + 2048;
  float* red = sx + 2048;
  const int tid = tid_local();
  bool loaded = false;
  for (int item0 = bid; item0 < 384; item0 += nb) {
    const int item = item0 + layer * 384;
    if (!loaded) {
      for (int i = tid; i < 2048; i += 256) {
        float v = p.c[i]; sc[i] = v * sigmoid_f(v);
        float w = p.cctx[i]; sx[i] = w * sigmoid_f(w);
      }
      __syncthreads();
      loaded = true;
    }
    const int l = item / 384, cgp = item % 384;
    const int col = cgp * 32 + (tid & 31), kg = tid >> 5;
    const float* w = p.ada_w + (size_t)l * 2048 * 12288 + col;
    float a0 = 0.f, a1 = 0.f;
#pragma unroll 16
    for (int k = kg; k < 2048; k += 8) {
      float wv = w[(size_t)k * 12288];
      a0 += sc[k] * wv; a1 += sx[k] * wv;
    }
    red[(kg * 32 + (tid & 31)) * 2 + 0] = a0;
    red[(kg * 32 + (tid & 31)) * 2 + 1] = a1;
    __syncthreads();
    if (tid < 64) {
      const int cc = tid & 31, which = tid >> 5;
      float s = 0.f;
#pragma unroll
      for (int g = 0; g < 8; ++g) s += red[(g * 32 + cc) * 2 + which];
      const int colo = cgp * 32 + cc;
      p.MOD[(size_t)(l * 2 + which) * 12288 + colo] = s + p.ada_b[l * 12288 + colo];
    }
    __syncthreads();
  }
  __syncthreads();
}

__device__ __forceinline__ void ph_h2(const P& p, char* smem, int bid, int nb) {
  float* feats = (float*)smem;
  float* h1 = feats + 160;
  float* w1s = feats + 512;
  float* w2s = w1s + 33 * 64;
  const int tid = tid_local(), r = tid >> 6, j = tid & 63;
  if (bid < 2112) {
    for (int i = tid; i < 33 * 64; i += 256) w1s[i] = p.hy_w1[i];
    for (int i = tid; i < 64 * 64; i += 256) w2s[i] = p.hy_w2[i];
  }
  const float b1 = p.hy_b1[j], b2 = p.hy_b2[j], fr = p.hy_freq[j];
  __syncthreads();
  for (int item = bid; item < 2112; item += nb) {
    const int row = item * 4 + r;
    const int L = row < TX ? TX : 256;
    const int t = row < TX ? row : row - TX;
    if (j < 33) {
      const float tn = (float)t / (float)(L - 1);
      float f;
      if (j == 0) f = tn;
      else {
        const int bi = (j - 1) & 15;
        const float band = 1e-4f + (float)bi * ((15.f - 1e-4f) / 15.f);
        const float ang = (6.283185307179586f / (float)L) * (float)t * band;
        f = (j <= 16) ? cosf(ang) : -sinf(ang);
      }
      feats[r * 36 + j] = f;
    }
    __syncthreads();
    float a = b1;
#pragma unroll
    for (int i = 0; i < 33; ++i) a += feats[r * 36 + i] * w1s[i * 64 + j];
    h1[r * 64 + j] = sinf(fr * a);
    __syncthreads();
    float a2 = b2;
#pragma unroll 16
    for (int i = 0; i < 64; ++i) a2 += h1[r * 64 + i] * w2s[i * 64 + j];
    p.H2B[(size_t)row * 64 + j] = f2bf(sinf(fr * a2));
  }
  __syncthreads();
}

using f32x2 = __attribute__((ext_vector_type(2))) float;
#ifndef FP6_ORDER
#define FP6_ORDER 1
#endif
using v16f = __attribute__((ext_vector_type(16))) float;
using v32f = __attribute__((ext_vector_type(32))) float;
using v6u = __attribute__((ext_vector_type(6))) unsigned int;
#define ROWB 1536
__device__ __forceinline__ void ph_tables(const P& p, int bid, int nb) {
  const int lane = tid_local() & 63, w = tid_local() >> 6;
  for (int r = bid * 4 + w; r < 65536; r += nb * 4) {
    const int tb = r >> 15, row = r & 32767;
    const float* src = (tb ? p.peer_v : p.peer_u) + (size_t)row * 2048 + lane * 32;
    unsigned char* dst = (tb ? p.VB : p.UB) + (size_t)row * ROWB;
    f32x4 v[8];
    float amax = 0.f;
#pragma unroll
    for (int q = 0; q < 8; ++q) {
      v[q] = *(const f32x4*)(src + q * 4);
      amax = fmaxf(amax, fmaxf(fmaxf(fabsf(v[q].x), fabsf(v[q].y)), fmaxf(fabsf(v[q].z), fabsf(v[q].w))));
    }
#pragma unroll
    for (int o = 32; o >= 1; o >>= 1) amax = fmaxf(amax, __shfl_xor(amax, o));
    const float sc = (amax > 0.f) ? exp2f(floorf(log2f(7.5f / amax))) : 1.f;
    v16f a, b;
#pragma unroll
    for (int k = 0; k < 16; ++k) {
#if FP6_ORDER == 0
      const int ia = k, ib = 16 + k;
#else
      const int ia = 2 * k, ib = 2 * k + 1;
#endif
      a[k] = v[ia >> 2][ia & 3] * sc;
      b[k] = v[ib >> 2][ib & 3] * sc;
    }
    const v6u pk = __builtin_amdgcn_cvt_scalef32_2xpk16_fp6_f32(a, b, 1.0f);
#pragma unroll
    for (int jc = 0; jc < 3; ++jc) *(u32x2*)(dst + jc * 512 + lane * 8) = mk2(pk[2 * jc], pk[2 * jc + 1]);
    if (lane == 0) (tb ? p.SV : p.SU)[row] = 1.f / sc;
  }
}

__device__ __forceinline__ void transpose_job(const float* src, bf16_t* dst, int K, int N, int batch, char* smem, int bid, int nb) {
  float* s = (float*)smem;
  const int tid = tid_local();
  const int tK = K >> 6, tN = N >> 6, per = tK * tN, total = batch * per;
  for (int item = bid; item < total; item += nb) {
    const int b = item / per, rem = item % per, tk = rem / tN, tn = rem % tN;
    const float* sp = src + (size_t)b * K * N + (size_t)(tk * 64) * N + tn * 64;
#pragma unroll
    for (int i = 0; i < 4; ++i) {
      const int row = (tid >> 4) + 16 * i, c4 = (tid & 15) * 4;
      float4 v = *(const float4*)(sp + (size_t)row * N + c4);
      s[row * 65 + c4 + 0] = v.x; s[row * 65 + c4 + 1] = v.y; s[row * 65 + c4 + 2] = v.z; s[row * 65 + c4 + 3] = v.w;
    }
    __syncthreads();
    const int n = tid >> 2, kq = tid & 3;
    uint32_t w[8];
#pragma unroll
    for (int e = 0; e < 8; ++e) w[e] = pack2(s[(kq * 16 + 2 * e) * 65 + n], s[(kq * 16 + 2 * e + 1) * 65 + n]);
    bf16_t* d = dst + (size_t)b * N * K + (size_t)(tn * 64 + n) * K + tk * 64 + kq * 16;
    *(u32x4*)d = mk4(w[0], w[1], w[2], w[3]);
    *(u32x4*)(d + 8) = mk4(w[4], w[5], w[6], w[7]);
    __syncthreads();
  }
}

__device__ __forceinline__ void ph_small_convert(const P& p, int bid, int nb) {
  const int gt = bid * 256 + tid_local(), gs = nb * 256;
  for (int i = gt; i < 2 * 16 * 128 * 128; i += gs) {
    const int k = i & 127, n = (i >> 7) & 127, hh = (i >> 14) & 15, dir = i >> 18;
    const int wc = n >> 6, ni = (n >> 4) & 3, l = n & 15;
    const int type = ni & 1, cl = (wc * 2 + (ni >> 1)) * 16 + l;
    const int h = hh >> 1, half = hh & 1, j = half * 64 + cl;
    const float* src = type ? p.lru_wx : p.lru_wa;
    p.WG[i] = f2bf(src[((size_t)(dir * 8 + h) * 128 + k) * 128 + j]);
  }
  for (int i = gt; i < 2 * 16 * 128 * 128; i += gs) p.KEYB[i] = f2bf(p.peer_keys[i]);
  for (int i = gt; i < 8 * 128 * 128; i += gs) p.GMWS[i] = f2bf(p.gm_ws[i]);
}

__device__ __forceinline__ void ph_norm(const float* srcx, const float* srcc, int nrows, const float* gnorm, const float* modx,
                        const float* modc, int shIdx, int scIdx, bf16_t* dst, int bid, int nb) {
  const int lane = tid_local() & 63, w = tid_local() >> 6;
  for (int row = bid * 4 + w; row < nrows; row += nb * 4) {
    const float* s = row < TX ? srcx + (size_t)row * DM : srcc + (size_t)(row - TX) * DM;
    const float* md = row < TX ? modx : modc;
    float4 v[8];
    float ss = 0.f;
#pragma unroll
    for (int i = 0; i < 8; ++i) {
      v[i] = ((const float4*)s)[i * 64 + lane];
      ss += v[i].x * v[i].x + v[i].y * v[i].y + v[i].z * v[i].z + v[i].w * v[i].w;
    }
    ss = wave_sum(ss);
    const float rstd = rsqrtf(ss * (1.f / DM) + 1e-6f);
#pragma unroll
    for (int i = 0; i < 8; ++i) {
      const int d = (i * 64 + lane) * 4;
      const float4 g = *(const float4*)(gnorm + d);
      const float4 sc = *(const float4*)(md + scIdx * DM + d);
      const float4 sh = *(const float4*)(md + shIdx * DM + d);
      const float y0 = v[i].x * rstd * g.x * (1.f + sc.x) + sh.x;
      const float y1 = v[i].y * rstd * g.y * (1.f + sc.y) + sh.y;
      const float y2 = v[i].z * rstd * g.z * (1.f + sc.z) + sh.z;
      const float y3 = v[i].w * rstd * g.w * (1.f + sc.w) + sh.w;
      *(u32x2*)(dst + (size_t)row * DM + d) = mk2(pack2(y0, y1), pack2(y2, y3));
    }
  }
}

__device__ __forceinline__ float conv3_at(const P& p, int part, int ch, int toff, int L, int s) {
  const int c = part * 1024 + ch;
  const float* row = p.PROJT + (size_t)c * TS + toff;
  float v = p.ev_conv_b[c] + p.ev_conv_w[3072 + c] * row[s];
  if (s > 0) v += p.ev_conv_w[c] * row[s - 1];
  if (s < L - 1) v += p.ev_conv_w[2 * 3072 + c] * row[s + 1];
  return v;
}

__device__ __forceinline__ float4 conv3_vec4(const P& p, int part, int ch, int toff, int L, int s0) {
  const int c = part * 1024 + ch;
  const float* row = p.PROJT + (size_t)c * TS + toff;
  const float4 m = *(const float4*)(row + s0);
  const float l = (s0 > 0) ? row[s0 - 1] : 0.f;
  const float r = (s0 + 4 < L) ? row[s0 + 4] : 0.f;
  const float b = p.ev_conv_b[c], w0 = p.ev_conv_w[c], w1 = p.ev_conv_w[3072 + c], w2 = p.ev_conv_w[2 * 3072 + c];
  float4 o;
  o.x = b + w0 * l + w1 * m.x + w2 * m.y;
  o.y = b + w0 * m.x + w1 * m.y + w2 * m.z;
  o.z = b + w0 * m.y + w1 * m.z + w2 * m.w;
  o.w = b + w0 * m.z + w1 * m.w + w2 * r;
  return o;
}

#define C3_LOAD(M, Lf, Rt, part, s0) { const float* row_ = p.PROJT + (size_t)((part) * 1024 + ch) * TS + toff; \
    M = *(const f32x4*)(row_ + (s0)); Lf = ((s0) > 0) ? row_[(s0) - 1] : 0.f; Rt = ((s0) + 4 < L) ? row_[(s0) + 4] : 0.f; }
__device__ __forceinline__ f32x4 c3_eval(f32x4 m, float l, float r, float b, float w0, float w1, float w2) {
  f32x4 o;
  o.x = b + w0 * l + w1 * m.x + w2 * m.y;
  o.y = b + w0 * m.x + w1 * m.y + w2 * m.z;
  o.z = b + w0 * m.y + w1 * m.z + w2 * m.w;
  o.w = b + w0 * m.z + w1 * m.w + w2 * r;
  return o;
}

template <int SEQ>
__device__ __forceinline__ void hyena_item(const P& p, char* smem, int ch) {
  constexpr int L = SEQ ? 256 : TX;
  constexpr int toff = SEQ ? TX : 0;
  constexpr int nB = L >> 7;
  constexpr int NT = SEQ ? 1 : 4;
  bf16_t* KK = (bf16_t*)smem;
  float* ybuf = (float*)smem;
  bf16_t* UP = (bf16_t*)(smem + 34816);
  bf16_t* CP = (bf16_t*)(smem + 51712);
  float* red = (float*)(smem + 59904);
  const int tid = tid_local(), lane = tid & 63, w = tid >> 6;
  for (int n = 0; n < 2; ++n) {
    const bf16_t* ff = p.FILT + (size_t)(n * 1024 + ch) * TS + toff;
    const bf16_t* fb = p.FILT + (size_t)(2048 + n * 1024 + ch) * TS + toff;
    float sabs = 0.f;
    {
      constexpr int NKK = ((2 * L) / 8 + 255) / 256;
      u32x4 kv[NKK];
#pragma unroll
      for (int k = 0; k < NKK; ++k) {
        const int idx = (tid + 256 * k) * 8;
        kv[k] = mk4(0u, 0u, 0u, 0u);
        if (idx < 2 * L) kv[k] = (idx >= L) ? *(const u32x4*)(ff + (idx - L)) : *(const u32x4*)(fb + (L - 8 - idx));
      }
#pragma unroll
      for (int k = 0; k < NKK; ++k) {
        const int idx = (tid + 256 * k) * 8;
        if (idx < 2 * L) {
          u32x4 v = kv[k];
          if (idx < L) {
            const u32x4 r = v;
            v.x = (r.w >> 16) | (r.w << 16); v.y = (r.z >> 16) | (r.z << 16); v.z = (r.y >> 16) | (r.y << 16); v.w = (r.x >> 16) | (r.x << 16);
          }
          sabs += fabsf(bflo(v.x)) + fabsf(bfhi(v.x)) + fabsf(bflo(v.y)) + fabsf(bfhi(v.y)) + fabsf(bflo(v.z)) + fabsf(bfhi(v.z)) + fabsf(bflo(v.w)) + fabsf(bfhi(v.w));
          *(u32x4*)(KK + (idx >> 7) * 136 + (idx & 127)) = v;
        }
      }
    }
    sabs = wave_sum(sabs);
    if (lane == 0) red[w] = sabs;
    const float cb0 = p.ev_conv_b[ch], cw00 = p.ev_conv_w[ch], cw01 = p.ev_conv_w[3072 + ch], cw02 = p.ev_conv_w[2 * 3072 + ch];
    {
      constexpr int NUP = ((L + 256) / 4 + 255) / 256;
      if (n == 0) {
        constexpr int CH = SEQ ? 1 : 3;
#pragma unroll 1
        for (int k0 = 0; k0 < NUP; k0 += CH) {
          f32x4 cm[CH]; float cl[CH], cr[CH];
#pragma unroll
          for (int k = 0; k < CH; ++k) {
            const int s0 = (tid + 256 * (k0 + k)) * 4 - 128;
            cm[k] = (f32x4){0.f, 0.f, 0.f, 0.f}; cl[k] = 0.f; cr[k] = 0.f;
            if (s0 >= 0 && s0 < L) C3_LOAD(cm[k], cl[k], cr[k], 0, s0)
          }
#pragma unroll
          for (int k = 0; k < CH; ++k) {
            const int iv = tid + 256 * (k0 + k), s0 = iv * 4 - 128;
            if (iv < (L + 256) / 4) {
              f32x4 u = (f32x4){0.f, 0.f, 0.f, 0.f};
              if (s0 >= 0 && s0 < L) u = c3_eval(cm[k], cl[k], cr[k], cb0, cw00, cw01, cw02);
              *(u32x2*)(UP + iv * 4) = mk2(pack2(u.x, u.y), pack2(u.z, u.w));
            }
          }
        }
      } else {
        f32x4 zv[NUP];
#pragma unroll
        for (int k = 0; k < NUP; ++k) {
          const int s0 = (tid + 256 * k) * 4 - 128;
          zv[k] = (f32x4){0.f, 0.f, 0.f, 0.f};
          if (s0 >= 0 && s0 < L) zv[k] = *(const f32x4*)(p.Z1 + (size_t)ch * TS + toff + s0);
        }
#pragma unroll
        for (int k = 0; k < NUP; ++k) {
          const int iv = tid + 256 * k;
          if (iv < (L + 256) / 4) *(u32x2*)(UP + iv * 4) = mk2(pack2(zv[k].x, zv[k].y), pack2(zv[k].z, zv[k].w));
        }
      }
    }
    __syncthreads();
    const float invS = 1.f / (red[0] + red[1] + red[2] + red[3]);

    f32x4 acc[2][NT];
#pragma unroll
    for (int a = 0; a < 2; ++a)
#pragma unroll
      for (int b = 0; b < NT; ++b) acc[a][b] = (f32x4){0.f, 0.f, 0.f, 0.f};

    const unsigned hy_cp_off = (unsigned)(unsigned long long)((__attribute__((address_space(3))) char*)CP) +
                               (unsigned)(((7 - (2 * w + 1)) * 256 + 120 + 8 * (lane >> 4) - 8 * (lane & 15)) * 2);
    const unsigned hy_kk_off = (unsigned)(unsigned long long)((__attribute__((address_space(3))) char*)KK) +
                               (unsigned)((((lane & 15) + nB) * 136 + 8 * (lane >> 4)) * 2);
    auto build_window = [&](int c, int buf) {
      const int sg = tid >> 5, y0 = (tid & 31) * 8;
      uint32_t wv[4] = {0u, 0u, 0u, 0u};
      if (y0 < 248) {
        const int base = (c + 1) * 128 - 1 - y0 - sg + 128;
#pragma unroll
        for (int e = 0; e < 4; ++e) wv[e] = (uint32_t)UP[base - 2 * e] | ((uint32_t)UP[base - 2 * e - 1] << 16);
      }
      *(u32x4*)(CP + buf * 2048 + sg * 256 + y0) = mk4(wv[0], wv[1], wv[2], wv[3]);
    };
    bf16x8 a0s0, a1s0, b0s0, b1s0, b2s0, b3s0, a0s1, a1s1, b0s1, b1s1, b2s1, b3s1;
    build_window(0, 0);
    __syncthreads();
    for (int c = 0; c <= nB; ++c) {
      const int buf = c & 1;
      if (c < nB) build_window(c + 1, buf ^ 1);
      if constexpr (SEQ == 0) {
        const unsigned aB = hy_cp_off + (unsigned)buf * 4096u;
        const unsigned bB = hy_kk_off - (unsigned)c * 272u;
#define HY_LOADS(a0, a1, b0, b1, b2, b3, JS) \
        asm volatile("ds_read_b128 %0, %6 offset:%8\n\tds_read_b128 %1, %6 offset:%9\n\t" \
                     "ds_read_b128 %2, %7 offset:%10\n\tds_read_b128 %3, %7 offset:%11\n\t" \
                     "ds_read_b128 %4, %7 offset:%12\n\tds_read_b128 %5, %7 offset:%13" \
                     : "=&v"(a0), "=&v"(a1), "=&v"(b0), "=&v"(b1), "=&v"(b2), "=&v"(b3) \
                     : "v"(aB), "v"(bB), "i"(512 + 64 * (JS)), "i"(64 * (JS)), "i"(64 * (JS)), "i"(4352 + 64 * (JS)), \
                       "i"(8704 + 64 * (JS)), "i"(13056 + 64 * (JS)) : "memory")
#define HY_WAIT(N, a0, a1, b0, b1, b2, b3) \
        asm volatile("s_waitcnt lgkmcnt(" #N ")" : "+v"(a0), "+v"(a1), "+v"(b0), "+v"(b1), "+v"(b2), "+v"(b3))
#define HY_MMA(a0, a1, b0, b1, b2, b3) { \
          acc[0][0] = __builtin_amdgcn_mfma_f32_16x16x32_bf16(a0, b0, acc[0][0], 0, 0, 0); \
          acc[1][0] = __builtin_amdgcn_mfma_f32_16x16x32_bf16(a1, b0, acc[1][0], 0, 0, 0); \
          acc[0][1] = __builtin_amdgcn_mfma_f32_16x16x32_bf16(a0, b1, acc[0][1], 0, 0, 0); \
          acc[1][1] = __builtin_amdgcn_mfma_f32_16x16x32_bf16(a1, b1, acc[1][1], 0, 0, 0); \
          acc[0][2] = __builtin_amdgcn_mfma_f32_16x16x32_bf16(a0, b2, acc[0][2], 0, 0, 0); \
          acc[1][2] = __builtin_amdgcn_mfma_f32_16x16x32_bf16(a1, b2, acc[1][2], 0, 0, 0); \
          acc[0][3] = __builtin_amdgcn_mfma_f32_16x16x32_bf16(a0, b3, acc[0][3], 0, 0, 0); \
          acc[1][3] = __builtin_amdgcn_mfma_f32_16x16x32_bf16(a1, b3, acc[1][3], 0, 0, 0); }
#define HY_LOADA0(a0, a1) \
        asm volatile("ds_read_b128 %0, %2 offset:512\n\tds_read_b128 %1, %2" : "=&v"(a0), "=&v"(a1) : "v"(aB) : "memory")
#define HY_LOADB0(b0, b1, b2, b3, ADDR) \
        asm volatile("ds_read_b128 %0, %4\n\tds_read_b128 %1, %4 offset:4352\n\t" \
                     "ds_read_b128 %2, %4 offset:8704\n\tds_read_b128 %3, %4 offset:13056" \
                     : "=&v"(b0), "=&v"(b1), "=&v"(b2), "=&v"(b3) : "v"(ADDR) : "memory")
        if (c == 0) HY_LOADB0(b0s0, b1s0, b2s0, b3s0, bB);
        HY_LOADA0(a0s0, a1s0);
        HY_LOADS(a0s1, a1s1, b0s1, b1s1, b2s1, b3s1, 1);
        HY_WAIT(6, a0s0, a1s0, b0s0, b1s0, b2s0, b3s0);
        HY_MMA(a0s0, a1s0, b0s0, b1s0, b2s0, b3s0)
        HY_LOADS(a0s0, a1s0, b0s0, b1s0, b2s0, b3s0, 2);
        HY_WAIT(6, a0s1, a1s1, b0s1, b1s1, b2s1, b3s1);
        HY_MMA(a0s1, a1s1, b0s1, b1s1, b2s1, b3s1)
        HY_LOADS(a0s1, a1s1, b0s1, b1s1, b2s1, b3s1, 3);
        HY_WAIT(6, a0s0, a1s0, b0s0, b1s0, b2s0, b3s0);
        HY_MMA(a0s0, a1s0, b0s0, b1s0, b2s0, b3s0)
        HY_WAIT(0, a0s1, a1s1, b0s1, b1s1, b2s1, b3s1);
        if (c < nB) { const unsigned bBn = bB - 272u; HY_LOADB0(b0s0, b1s0, b2s0, b3s0, bBn); }
        HY_MMA(a0s1, a1s1, b0s1, b1s1, b2s1, b3s1)
      } else {
      const bf16_t* cp = CP + buf * 2048;
      bf16x8 aF[2][2], bF[2][NT];
      const bf16_t* kbase[NT];
#pragma unroll
      for (int nt = 0; nt < NT; ++nt) {
        int e = nt * 16 + (lane & 15);
        if (e > nB - 1) e = nB - 1;
        kbase[nt] = KK + (e - c + nB) * 136 + 8 * (lane >> 4);
      }
      const bf16_t* abase = cp + 120 + 8 * (lane >> 4) - 8 * (lane & 15);
#pragma unroll
      for (int mi = 0; mi < 2; ++mi) aF[0][mi] = *(const bf16x8*)(abase + (7 - (2 * w + mi)) * 256);
#pragma unroll
      for (int nt = 0; nt < NT; ++nt) bF[0][nt] = *(const bf16x8*)(kbase[nt]);
#pragma unroll
      for (int js = 0; js < 4; ++js) {
        if (js < 3) {
#pragma unroll
          for (int mi = 0; mi < 2; ++mi) aF[(js + 1) & 1][mi] = *(const bf16x8*)(abase + (7 - (2 * w + mi)) * 256 + 32 * (js + 1));
#pragma unroll
          for (int nt = 0; nt < NT; ++nt) bF[(js + 1) & 1][nt] = *(const bf16x8*)(kbase[nt] + 32 * (js + 1));
        }
#pragma unroll
        for (int nt = 0; nt < NT; ++nt)
#pragma unroll
          for (int mi = 0; mi < 2; ++mi)
            acc[mi][nt] = __builtin_amdgcn_mfma_f32_16x16x32_bf16(aF[js & 1][mi], bF[js & 1][nt], acc[mi][nt], 0, 0, 0);
      }
      }
      __syncthreads();
    }
#pragma unroll
    for (int mi = 0; mi < 2; ++mi)
#pragma unroll
      for (int nt = 0; nt < NT; ++nt) {
        const int e = nt * 16 + (lane & 15);
        if (e < nB) {
#pragma unroll
          for (int j = 0; j < 4; ++j) {
            const int rho = (lane >> 4) * 4 + j;
            const int tau = (2 * w + mi) + 8 * rho;
            ybuf[e * 128 + tau] = acc[mi][nt][j] * invS;
          }
        }
      }
    __syncthreads();
    const float bias = p.hy_bias[n * 1024 + ch];
    {
      constexpr int NE = (L / 4 + 255) / 256;
      const int pa = (n == 0) ? 1 : 2;
      const float pb = p.ev_conv_b[pa * 1024 + ch], pw0 = p.ev_conv_w[pa * 1024 + ch], pw1 = p.ev_conv_w[3072 + pa * 1024 + ch], pw2 = p.ev_conv_w[2 * 3072 + pa * 1024 + ch];
      constexpr int CE = SEQ ? 1 : 4;
#pragma unroll 1
      for (int k0 = 0; k0 < NE; k0 += CE) {
        f32x4 am[CE], bm[CE];
        float al[CE], ar[CE], bl[CE], br[CE];
#pragma unroll
        for (int k = 0; k < CE; ++k) {
          const int t0 = (tid + 256 * (k0 + k)) * 4;
          am[k] = (f32x4){0.f, 0.f, 0.f, 0.f}; bm[k] = am[k]; al[k] = 0.f; ar[k] = 0.f; bl[k] = 0.f; br[k] = 0.f;
          if (t0 < L) {
            C3_LOAD(am[k], al[k], ar[k], pa, t0)
            if (n == 0) C3_LOAD(bm[k], bl[k], br[k], 0, t0)
            else bm[k] = *(const f32x4*)(p.Z1 + (size_t)ch * TS + toff + t0);
          }
        }
#pragma unroll
        for (int k = 0; k < CE; ++k) {
          const int t0 = (tid + 256 * (k0 + k)) * 4;
          if (t0 < L) {
            const f32x4 y = *(const f32x4*)(ybuf + t0);
            const f32x4 xm = c3_eval(am[k], al[k], ar[k], pb, pw0, pw1, pw2);
            if (n == 0) {
              const f32x4 v = c3_eval(bm[k], bl[k], br[k], cb0, cw00, cw01, cw02);
              f32x4 z;
              z.x = xm.x * (y.x + bias * v.x); z.y = xm.y * (y.y + bias * v.y); z.z = xm.z * (y.z + bias * v.z); z.w = xm.w * (y.w + bias * v.w);
              *(f32x4*)(p.Z1 + (size_t)ch * TS + toff + t0) = z;
            } else {
              const f32x4 z1 = bm[k];
              bf16_t* o = p.ABUF1 + (size_t)(toff + t0) * DM + ch;
              o[0] = f2bf(xm.x * (y.x + bias * z1.x));
              o[DM] = f2bf(xm.y * (y.y + bias * z1.y));
              o[2 * DM] = f2bf(xm.z * (y.z + bias * z1.z));
              o[3 * DM] = f2bf(xm.w * (y.w + bias * z1.w));
            }
          }
        }
      }
    }
    __threadfence_block();
    __syncthreads();
  }
}

__device__ __forceinline__ void gmlp_item(const P& p, char* smem, int n, int h) {
  bf16_t* Bt = (bf16_t*)smem;
  float* rs = (float*)(smem + 34816);
  const int tid = tid_local(), lane = tid & 63, w = tid >> 6;
  const float* VG = p.PROJT + (size_t)4096 * TS + n * 128;
  {
    const int c8 = tid >> 5, q4 = (tid & 31) * 4;
    float4 s4 = make_float4(0.f, 0.f, 0.f, 0.f);
#pragma unroll 16
    for (int c = c8; c < 1024; c += 8) {
      const float4 v = *(const float4*)(VG + (size_t)c * TS + q4);
      s4.x += v.x * v.x; s4.y += v.y * v.y; s4.z += v.z * v.z; s4.w += v.w * v.w;
    }
    float* rs8 = rs + 128;
    *(float4*)(rs8 + c8 * 128 + q4) = s4;
  }
  __syncthreads();
  if (tid < 128) {
    float a = 0.f;
#pragma unroll
    for (int g = 0; g < 8; ++g) a += rs[128 + g * 128 + tid];
    rs[tid] = rsqrtf(a * (1.f / 1024.f) + 1e-6f);
  }
  __syncthreads();
  {
    const int c = tid >> 1, q0 = (tid & 1) * 64;
    const float g = p.gm_norm[h * 128 + c];
    const float* src = VG + (size_t)(h * 128 + c) * TS + q0;
#pragma unroll 4
    for (int i = 0; i < 16; ++i) {
      const float4 v = *(const float4*)(src + 4 * i);
      const int q = q0 + 4 * i;
      *(u32x2*)(Bt + c * 136 + q) = mk2(pack2(v.x * rs[q] * g, v.y * rs[q + 1] * g), pack2(v.z * rs[q + 2] * g, v.w * rs[q + 3] * g));
    }
  }
  __syncthreads();
  f32x4 acc[2][8];
#pragma unroll
  for (int a = 0; a < 2; ++a)
#pragma unroll
    for (int b = 0; b < 8; ++b) acc[a][b] = (f32x4){0.f, 0.f, 0.f, 0.f};
  const bf16_t* Aw = p.GMWS + (size_t)h * 128 * 128;
  bf16x8 afA[4][2];
#pragma unroll
  for (int ks = 0; ks < 4; ++ks)
#pragma unroll
    for (int mi = 0; mi < 2; ++mi)
      afA[ks][mi] = *(const bf16x8*)(Aw + (32 * w + 16 * mi + (lane & 15)) * 128 + ks * 32 + (lane >> 4) * 8);
#pragma unroll
  for (int ks = 0; ks < 4; ++ks) {
    bf16x8 bB[8];
#pragma unroll
    for (int ni = 0; ni < 8; ++ni) bB[ni] = *(const bf16x8*)(Bt + (ni * 16 + (lane & 15)) * 136 + ks * 32 + (lane >> 4) * 8);
#pragma unroll
    for (int ni = 0; ni < 8; ++ni)
#pragma unroll
      for (int mi = 0; mi < 2; ++mi)
        acc[mi][ni] = __builtin_amdgcn_mfma_f32_16x16x32_bf16(afA[ks][mi], bB[ni], acc[mi][ni], 0, 0, 0);
  }
#pragma unroll
  for (int mi = 0; mi < 2; ++mi)
#pragma unroll
    for (int ni = 0; ni < 8; ++ni) {
      const int c = ni * 16 + (lane & 15);
      const int p0 = 32 * w + 16 * mi + (lane >> 4) * 4;
      const float4 u = *(const float4*)(p.PROJT + (size_t)(3072 + h * 128 + c) * TS + n * 128 + p0);
      const float uu[4] = {u.x, u.y, u.z, u.w};
#pragma unroll
      for (int j = 0; j < 4; ++j) {
        const int pp = p0 + j;
        const float s = acc[mi][ni][j] + p.gm_bs[h * 128 + pp];
        p.ABUF1[(size_t)(n * 128 + pp) * DM + 1024 + h * 128 + c] = f2bf(uu[j] * s);
      }
    }
  __syncthreads();
}

#define BF8(dst, o, q) dst[o + 0] = bflo(q.x); dst[o + 1] = bfhi(q.x); dst[o + 2] = bflo(q.y); dst[o + 3] = bfhi(q.y); \
                       dst[o + 4] = bflo(q.z); dst[o + 5] = bfhi(q.z); dst[o + 6] = bflo(q.w); dst[o + 7] = bfhi(q.w);
template <int LAST>
__device__ __forceinline__ void ph_peer(const P& p, int layer, int ntok, char* smem, int bid, int nb) {
  const int tid = tid_local();
  const int lane = tid & 63, w = tid >> 6;
  int* sExp = (int*)smem + w * 32;
  float* sGate = (float*)(smem + 512) + w * 32;
  uint32_t* LL = (uint32_t*)(smem + 1024) + w * 128;
  float* sPart = (float*)(smem + 4096);
  float* sRed = (float*)(smem + 4096 + 32768);
  const unsigned char* UBl = p.UB + (size_t)layer * 16384 * ROWB;
  const unsigned char* VBl = p.VB + (size_t)layer * 16384 * ROWB;
  const float* SUl = p.SU + layer * 16384;
  const float* SVl = p.SV + layer * 16384;
  const bf16_t* HP = LAST ? p.ABUF1 : p.ABUF0;
  int pi_ = 0, pj_ = 0;
  {
    int rem = lane;
    bool found = false;
#pragma unroll
    for (int ii = 0; ii < 16; ++ii) {
      const int nn = 16 / (ii + 1);
      if (!found && rem < nn) { pi_ = ii; pj_ = rem; found = true; }
      if (!found) rem -= nn;
    }
  }
  const bool pvalid_ = lane < 50;
  float scv[8];
  if (bid < ntok) {
    const float* sp = p.SC + (size_t)bid * DM + w * 512 + lane;
#pragma unroll
    for (int k = 0; k < 8; ++k) scv[k] = sp[k * 64];
  }
  unsigned* tok_ctr = p.BAR + (layer ? 64 : 0);
  volatile int* sTok = (volatile int*)(smem + 3840);
  for (int t = bid; t < ntok; ) {
    if (tid == 0) sTok[0] = nb + (int)__hip_atomic_fetch_add(tok_ctr, 1u, __ATOMIC_RELAXED, __HIP_MEMORY_SCOPE_AGENT);
    for (int rep_ = 0; rep_ < REP_TOPK; ++rep_) {
      uint32_t key[4][2], prefix[4];
      int need[4];
#pragma unroll
      for (int g = 0; g < 4; ++g) {
        key[g][0] = (((fkey(scv[g * 2 + 0]) + 0x2000u) >> 14) << 7) | (uint32_t)lane;
        key[g][1] = (((fkey(scv[g * 2 + 1]) + 0x2000u) >> 14) << 7) | (uint32_t)(lane + 64);
        prefix[g] = 0u; need[g] = 16;
      }
#pragma unroll 4
      for (int bit = 24; bit >= 0; --bit) {
        const uint32_t mh = ~((1u << bit) - 1u);
#pragma unroll
        for (int g = 0; g < 4; ++g) {
          const uint32_t cand = prefix[g] | (1u << bit);
          const int c = __popcll(__ballot((key[g][0] & mh) == cand)) + __popcll(__ballot((key[g][1] & mh) == cand));
          const bool ge_ = c >= need[g];
          prefix[g] = ge_ ? cand : prefix[g];
          need[g] = ge_ ? need[g] : need[g] - c;
        }
      }
#pragma unroll
      for (int g = 0; g < 4; ++g) {
        const bool q0 = key[g][0] >= prefix[g], q1 = key[g][1] >= prefix[g];
        const unsigned long long b0 = __ballot(q0), b1 = __ballot(q1);
        const int r0 = __builtin_amdgcn_mbcnt_hi((unsigned)(b0 >> 32), __builtin_amdgcn_mbcnt_lo((unsigned)b0, 0u));
        const int r1 = __popcll(b0) + __builtin_amdgcn_mbcnt_hi((unsigned)(b1 >> 32), __builtin_amdgcn_mbcnt_lo((unsigned)b1, 0u));
        uint32_t* Ls = LL + (g >> 1) * 48 + (g & 1) * 16;
        if (q0) Ls[r0 & 15] = key[g][0];
        if (q1) Ls[r1 & 15] = key[g][1];
      }
      {
        uint32_t* Lg = LL + (lane >> 5) * 48 + ((lane >> 4) & 1) * 16;
        const uint32_t my = Lg[lane & 15];
        int rk = 0;
#pragma unroll
        for (int k = 0; k < 16; ++k) rk += (Lg[k] > my) ? 1 : 0;
        Lg[rk] = my;
      }
      uint32_t pk[2], cpre[2];
      int cneed[2];
#pragma unroll
      for (int hh = 0; hh < 2; ++hh) {
        const float s0 = funkey((LL[hh * 48 + pi_] >> 7) << 14);
        const float s1 = funkey((LL[hh * 48 + 16 + pj_] >> 7) << 14);
        pk[hh] = pvalid_ ? ((((fkey(s0 + s1) + 0x2000u) >> 14) << 8) | (uint32_t)(pi_ * 16 + pj_)) : 0u;
        cpre[hh] = 0u; cneed[hh] = 16;
      }
#pragma unroll 4
      for (int bit = 25; bit >= 0; --bit) {
        const uint32_t mh = ~((1u << bit) - 1u);
#pragma unroll
        for (int hh = 0; hh < 2; ++hh) {
          const uint32_t cand = cpre[hh] | (1u << bit);
          const int c = __popcll(__ballot((pk[hh] & mh) == cand));
          const bool ge_ = c >= cneed[hh];
          cpre[hh] = ge_ ? cand : cpre[hh];
          cneed[hh] = ge_ ? cneed[hh] : cneed[hh] - c;
        }
      }
#pragma unroll
      for (int hh = 0; hh < 2; ++hh) {
        uint32_t* L0 = LL + hh * 48;
        uint32_t* L1 = L0 + 16;
        uint32_t* L2 = L0 + 32;
        {
          const bool q = pk[hh] >= cpre[hh] && pk[hh] != 0u;
          const unsigned long long bq = __ballot(q);
          const int r = __builtin_amdgcn_mbcnt_hi((unsigned)(bq >> 32), __builtin_amdgcn_mbcnt_lo((unsigned)bq, 0u));
          if (q) L2[r & 15] = pk[hh];
        }
        const uint32_t mine = L2[lane & 15];
        const int cidx = (int)(mine & 255u);
        const float cv = funkey((mine >> 8) << 14);
        const int ia = (int)(L0[(cidx >> 4) & 15] & 127u);
        const int ib = (int)(L1[cidx & 15] & 127u);
        float mx = cv;
#pragma unroll
        for (int o = 8; o >= 1; o >>= 1) mx = fmaxf(mx, __shfl_xor(mx, o));
        const float ev = __expf(cv - mx);
        float sum = ev;
#pragma unroll
        for (int o = 8; o >= 1; o >>= 1) sum += __shfl_xor(sum, o);
        if (lane < 16) {
          sExp[hh * 16 + lane] = ia * 128 + ib;
          sGate[hh * 16 + lane] = ev / sum;
        }
      }
    }
    __syncthreads();
    const int tn = sTok[0];
    if (tn < ntok) {
      const float* sp = p.SC + (size_t)tn * DM + w * 512 + lane;
#pragma unroll
      for (int k = 0; k < 8; ++k) scv[k] = sp[k * 64];
    }
    u32x4 xq[4];
    {
      const u32x4* xr = (const u32x4*)(HP + (size_t)t * DM) + lane * 4;
#pragma unroll
      for (int q = 0; q < 4; ++q) xq[q] = xr[q];
    }
    float acc[32];
#pragma unroll
    for (int i = 0; i < 32; ++i) acc[i] = 0.f;
    u32x2 ub[2][3], vb[2][3];
    int ex[2], exn[2];
#pragma unroll
    for (int e = 0; e < 2; ++e) {
      exn[e] = __builtin_amdgcn_readfirstlane(sExp[e]);
      const u32x2* ur = (const u32x2*)(UBl + (size_t)exn[e] * ROWB) + lane;
#pragma unroll
      for (int jc = 0; jc < 3; ++jc) ub[e][jc] = ur[jc * 64];
    }
#pragma unroll 1
    for (int eb = 0; eb < 32; eb += 2) {
      float d[2];
#pragma unroll
      for (int e = 0; e < 2; ++e) {
        ex[e] = exn[e];
        v6u pk;
        pk[0] = ub[e][0].x; pk[1] = ub[e][0].y; pk[2] = ub[e][1].x; pk[3] = ub[e][1].y; pk[4] = ub[e][2].x; pk[5] = ub[e][2].y;
        const v32f uu = __builtin_amdgcn_cvt_scalef32_pk32_f32_fp6(pk, 1.0f);
        float sdot = 0.f;
#pragma unroll
        for (int q = 0; q < 4; ++q) {
          sdot += bflo(xq[q].x) * uu[q * 8 + 0] + bfhi(xq[q].x) * uu[q * 8 + 1] + bflo(xq[q].y) * uu[q * 8 + 2] + bfhi(xq[q].y) * uu[q * 8 + 3] +
                  bflo(xq[q].z) * uu[q * 8 + 4] + bfhi(xq[q].z) * uu[q * 8 + 5] + bflo(xq[q].w) * uu[q * 8 + 6] + bfhi(xq[q].w) * uu[q * 8 + 7];
        }
        d[e] = sdot;
        __builtin_amdgcn_sched_barrier(0);
      }
#pragma unroll
      for (int e = 0; e < 2; ++e) {
        const u32x2* vr = (const u32x2*)(VBl + (size_t)ex[e] * ROWB) + lane;
#pragma unroll
        for (int jc = 0; jc < 3; ++jc) vb[e][jc] = vr[jc * 64];
      }
      if (eb + 2 < 32) {
#pragma unroll
        for (int e = 0; e < 2; ++e) {
          exn[e] = __builtin_amdgcn_readfirstlane(sExp[eb + 2 + e]);
          const u32x2* ur = (const u32x2*)(UBl + (size_t)exn[e] * ROWB) + lane;
#pragma unroll
          for (int jc = 0; jc < 3; ++jc) ub[e][jc] = ur[jc * 64];
        }
      }
#pragma unroll
      for (int o = 32; o >= 1; o >>= 1) {
#pragma unroll
        for (int e = 0; e < 2; ++e) d[e] += __shfl_xor(d[e], o);
      }
#pragma unroll
      for (int e = 0; e < 2; ++e) {
        const float wg = sGate[eb + e] * gelu_f(d[e] * SUl[ex[e]]) * SVl[ex[e]];
        v6u pk;
        pk[0] = vb[e][0].x; pk[1] = vb[e][0].y; pk[2] = vb[e][1].x; pk[3] = vb[e][1].y; pk[4] = vb[e][2].x; pk[5] = vb[e][2].y;
        const v32f vv = __builtin_amdgcn_cvt_scalef32_pk32_f32_fp6(pk, 1.0f);
#pragma unroll
        for (int k = 0; k < 32; ++k) acc[k] += wg * vv[k];
        __builtin_amdgcn_sched_barrier(0);
      }
    }
    {
      float* dst = sPart + w * 2048 + lane * 32;
#pragma unroll
      for (int q = 0; q < 8; ++q) *(float4*)(dst + q * 4) = make_float4(acc[q * 4 + 0], acc[q * 4 + 1], acc[q * 4 + 2], acc[q * 4 + 3]);
    }
    __syncthreads();
    const int d0 = tid * 8;
    float r[8];
    {
      float4 a = *(const float4*)(sPart + d0), b = *(const float4*)(sPart + d0 + 4);
#pragma unroll
      for (int ww = 1; ww < 4; ++ww) {
        const float4 a2 = *(const float4*)(sPart + ww * 2048 + d0), b2 = *(const float4*)(sPart + ww * 2048 + d0 + 4);
        a.x += a2.x; a.y += a2.y; a.z += a2.z; a.w += a2.w; b.x += b2.x; b.y += b2.y; b.z += b2.z; b.w += b2.w;
      }
      r[0] = a.x; r[1] = a.y; r[2] = a.z; r[3] = a.w; r[4] = b.x; r[5] = b.y; r[6] = b.z; r[7] = b.w;
    }
    const int which = (t < TX) ? 0 : 1;
    const float* md = p.MOD + (size_t)(layer * 2 + which) * 12288;
    float* xrow = p.XA + (size_t)t * DM;
    float ss = 0.f;
#pragma unroll
    for (int hq = 0; hq < 2; ++hq) {
      const float4 xv = *(const float4*)(xrow + d0 + hq * 4);
      const float4 g2 = *(const float4*)(md + 5 * DM + d0 + hq * 4);
      float4 o;
      o.x = xv.x + g2.x * r[hq * 4 + 0]; o.y = xv.y + g2.y * r[hq * 4 + 1];
      o.z = xv.z + g2.z * r[hq * 4 + 2]; o.w = xv.w + g2.w * r[hq * 4 + 3];
      r[hq * 4 + 0] = o.x; r[hq * 4 + 1] = o.y; r[hq * 4 + 2] = o.z; r[hq * 4 + 3] = o.w;
      ss += o.x * o.x + o.y * o.y + o.z * o.z + o.w * o.w;
      if (!LAST) *(float4*)(xrow + d0 + hq * 4) = o;
    }
    ss = wave_sum(ss);
    if (lane == 0) sRed[w] = ss;
    __syncthreads();
    const float rstd = rsqrtf((sRed[0] + sRed[1] + sRed[2] + sRed[3]) * (1.f / DM) + 1e-6f);
    if (LAST) {
      float* orow = p.out + (size_t)t * DM;
#pragma unroll
      for (int hq = 0; hq < 2; ++hq) {
        const float4 g = *(const float4*)(p.norm_final + d0 + hq * 4);
        float4 o;
        o.x = r[hq * 4 + 0] * rstd * g.x; o.y = r[hq * 4 + 1] * rstd * g.y; o.z = r[hq * 4 + 2] * rstd * g.z; o.w = r[hq * 4 + 3] * rstd * g.w;
        *(float4*)(orow + d0 + hq * 4) = o;
      }
    } else {
      const float* md1 = p.MOD + (size_t)(2 + which) * 12288;
      const float* gn = p.norm_mix + DM;
      uint32_t o[4];
#pragma unroll
      for (int hq = 0; hq < 2; ++hq) {
        const float4 g = *(const float4*)(gn + d0 + hq * 4);
        const float4 sh = *(const float4*)(md1 + 0 * DM + d0 + hq * 4);
        const float4 sc = *(const float4*)(md1 + 1 * DM + d0 + hq * 4);
        const float y0 = r[hq * 4 + 0] * rstd * g.x * (1.f + sc.x) + sh.x;
        const float y1 = r[hq * 4 + 1] * rstd * g.y * (1.f + sc.y) + sh.y;
        const float y2 = r[hq * 4 + 2] * rstd * g.z * (1.f + sc.z) + sh.z;
        const float y3 = r[hq * 4 + 3] * rstd * g.w * (1.f + sc.w) + sh.w;
        o[hq * 2 + 0] = pack2(y0, y1); o[hq * 2 + 1] = pack2(y2, y3);
      }
      *(u32x4*)(p.ABUF1 + (size_t)t * DM + d0) = mk4(o[0], o[1], o[2], o[3]);
    }
    __syncthreads();
    t = tn;
  }
}

__device__ __forceinline__ void ph_scores(const P& p, int ph, char* smem, int bid, int nb) {
  const int tid = tid_local(), lane = tid & 63, wid = tid >> 6, wr = wid >> 1, wc = wid & 1;
        const int layer = (ph == 7) ? 0 : 1;
        const int numM = (ph == 7) ? 66 : 64;
        bf16_t* sA = (bf16_t*)smem;
        bf16_t* sB = sA + 128 * LDS_S;
        for (int id = bid; id < numM * 16; id += nb) {
          const int mt = id % numM, hs = id / numM;
          f32x4 acc[4][4];
          gemm_core(acc, p.QB + (size_t)mt * 128 * DM + hs * 128, DM, p.KEYB + (size_t)(layer * 16 + hs) * 128 * 128, 128, 128, sA, sB);
#pragma unroll
          for (int mi = 0; mi < 4; ++mi)
#pragma unroll
            for (int ni = 0; ni < 4; ++ni)
#pragma unroll
              for (int j = 0; j < 4; ++j) {
                const int row = mt * 128 + wr * 64 + mi * 16 + (lane >> 4) * 4 + j;
                const int col = wc * 64 + ni * 16 + (lane & 15);
                p.SC[(size_t)row * DM + hs * 128 + col] = acc[mi][ni][j];
              }
        }
}

__device__ __forceinline__ void ph_qscores(const P& p, int layer, int M, char* smem, int bid, int nb) {
  const int tid = tid_local(), lane = tid & 63, wid = tid >> 6, wr = wid >> 1, wc = wid & 1;
  bf16_t* sA = (bf16_t*)smem;
  bf16_t* sB = sA + 128 * LDS_S;
  bf16_t* sQ = (bf16_t*)smem;
  const bf16_t* A = layer ? p.ABUF1 : p.ABUF0;
  const bf16_t* W = p.WT_PQ + (size_t)layer * DM * DM;
  const int numM = M >> 7, numN = 16, total = numM * numN;
  const int vb = ((nb & 7) == 0) ? (bid & 7) * (nb >> 3) + (bid >> 3) : bid;
  for (int id = vb; id < total; id += nb) {
    const int gsz = 8 * numN, g = id / gsz, fm = g * 8;
    const int rows = (numM - fm) < 8 ? (numM - fm) : 8;
    const int r = id - g * gsz;
    const int mt = fm + r % rows, nt = r / rows;
    f32x4 acc[4][4];
    gemm_core_t<4>(acc, A + (size_t)mt * 128 * DM, DM, W + (size_t)nt * 128 * DM, DM, DM, sA, sB);
    __syncthreads();
#pragma unroll
    for (int mi = 0; mi < 4; ++mi)
#pragma unroll
      for (int ni = 0; ni < 4; ++ni)
#pragma unroll
        for (int j = 0; j < 4; ++j)
          sQ[(wr * 64 + mi * 16 + (lane >> 4) * 4 + j) * 136 + wc * 64 + ni * 16 + (lane & 15)] = f2bf(acc[mi][ni][j]);
    __syncthreads();
    const bf16_t* Kb = p.KEYB + (size_t)(layer * 16 + nt) * 128 * 128;
    f32x4 acc2[4][4];
#pragma unroll
    for (int mi = 0; mi < 4; ++mi)
#pragma unroll
      for (int ni = 0; ni < 4; ++ni) acc2[mi][ni] = (f32x4){0.f, 0.f, 0.f, 0.f};
#pragma unroll
    for (int ks = 0; ks < 4; ++ks) {
      bf16x8 af[4], bk[4];
#pragma unroll
      for (int mi = 0; mi < 4; ++mi) af[mi] = *(const bf16x8*)(sQ + (wr * 64 + mi * 16 + (lane & 15)) * 136 + ks * 32 + (lane >> 4) * 8);
#pragma unroll
      for (int ni = 0; ni < 4; ++ni) bk[ni] = *(const bf16x8*)(Kb + (wc * 64 + ni * 16 + (lane & 15)) * 128 + ks * 32 + (lane >> 4) * 8);
#pragma unroll
      for (int mi = 0; mi < 4; ++mi)
#pragma unroll
        for (int ni = 0; ni < 4; ++ni)
          acc2[mi][ni] = __builtin_amdgcn_mfma_f32_16x16x32_bf16(af[mi], bk[ni], acc2[mi][ni], 0, 0, 0);
    }
#pragma unroll
    for (int mi = 0; mi < 4; ++mi)
#pragma unroll
      for (int ni = 0; ni < 4; ++ni)
#pragma unroll
        for (int j = 0; j < 4; ++j)
          p.SC[(size_t)(mt * 128 + wr * 64 + mi * 16 + (lane >> 4) * 4 + j) * DM + nt * 128 + wc * 64 + ni * 16 + (lane & 15)] = acc2[mi][ni][j];
  }
}

#define XB_TMO      128
#define XB_XCNT(j)  (256  + 64 * (j))
#define XB_XSUB(j)  (1280 + 64 * (j))
#define XB_XGEN(j)  (2304 + 64 * (j))
#define XB_TOP      3328
#define XB_TOPGEN   3392
#define XCD_BAR_WORDS 3456
#define XB_SPIN_CAP (1u << 22)
#define LAS __attribute__((address_space(3)))
__device__ __forceinline__ unsigned xb_ld(unsigned* p)              { return __hip_atomic_load(p, __ATOMIC_RELAXED, __HIP_MEMORY_SCOPE_AGENT); }
__device__ __forceinline__ unsigned xb_add(unsigned* p, unsigned v) { return __hip_atomic_fetch_add(p, v, __ATOMIC_RELAXED, __HIP_MEMORY_SCOPE_AGENT); }
__device__ __forceinline__ unsigned xb_xcc_id() { return (unsigned)__builtin_amdgcn_s_getreg((3 << 11) | 20) & 0xFu; }
#define XB_SPIN(cond, bar) do { unsigned _sp = 0; while (cond) { __builtin_amdgcn_s_sleep(1); \
    if ((++_sp & 255u) == 0u) { if (xb_ld(&(bar)[XB_TMO])) break; if (_sp > XB_SPIN_CAP) { atomicAdd(&(bar)[XB_TMO], 1u); break; } } } } while (0)
struct XcdBarrier { unsigned* bar; unsigned x; volatile LAS unsigned* st; };
__device__ __forceinline__ XcdBarrier xcd_barrier_post(unsigned* bar, volatile LAS unsigned* st) {
  XcdBarrier b; b.bar = bar; b.x = xb_xcc_id(); b.st = st;
  if (tid_local() == 0) (void)xb_add(&bar[XB_XCNT(b.x)], 1u);
  return b;
}
__device__ __forceinline__ void xcd_barrier_complete(unsigned* bar, unsigned x, unsigned& nloc, unsigned& nx, unsigned G) {
  unsigned sum, cnt, mine, sp = 0u;
  for (;;) {
    sum = 0u; cnt = 0u; mine = 0u;
#pragma unroll
    for (unsigned j = 0; j < 16; ++j) { const unsigned c = xb_ld(&bar[XB_XCNT(j)]); sum += c; cnt += (c > 0u) ? 1u : 0u; mine = (j == x) ? c : mine; }
    if (sum == G) break;
    __builtin_amdgcn_s_sleep(1);
    if ((++sp & 255u) == 0u) { if (xb_ld(&bar[XB_TMO])) break; if (sp > XB_SPIN_CAP) { atomicAdd(&bar[XB_TMO], 1u); break; } }
  }
  nloc = mine > 0u ? mine : 1u; nx = cnt > 0u ? cnt : 1u;
}
__device__ __forceinline__ void xcd_barrier_impl(unsigned* bar, unsigned x, volatile LAS unsigned* st, int tid_, unsigned G_) {
  asm volatile("s_waitcnt vmcnt(0)" ::: "memory");
  __syncthreads();
  if (tid_ == 0) {
    __builtin_amdgcn_s_waitcnt(0);
    const unsigned nloc = st[0], nx = st[1];
    const unsigned old = xb_add(&bar[XB_XSUB(x)], 1u);
    const unsigned gen = old / nloc;
    if (old + 1u == (gen + 1u) * nloc) {
      __builtin_amdgcn_fence(__ATOMIC_RELEASE, "agent");
      asm volatile("s_waitcnt vmcnt(0)" ::: "memory");
      const unsigned og = xb_add(&bar[XB_TOP], 1u);
      const unsigned tg = og / nx;
      if (og + 1u == (tg + 1u) * nx) xb_add(&bar[XB_TOPGEN], 1u);
      else XB_SPIN(xb_ld(&bar[XB_TOPGEN]) == tg, bar);
      __builtin_amdgcn_fence(__ATOMIC_ACQUIRE, "agent");
      xb_add(&bar[XB_XGEN(x)], 1u);
      asm volatile("s_waitcnt vmcnt(0)" ::: "memory");
    } else {
      XB_SPIN(xb_ld(&bar[XB_XGEN(x)]) == gen, bar);
      __builtin_amdgcn_fence(__ATOMIC_ACQUIRE, "agent");
      asm volatile("s_waitcnt vmcnt(0)" ::: "memory");
    }
  }
  __syncthreads();
}

template <bool COOP>
__global__ void __launch_bounds__(256, 2) mega(P p, int ph_lo, int ph_hi) {
  __shared__ __attribute__((aligned(16))) char smem[61424];
  const int bid = blockIdx.x, nb = gridDim.x;
  const int tid0 = tid_local();
#define PH_IDS int tid = tid_local(); const int lane = tid & 63, wid = tid >> 6, wr = wid >> 1, wc = wid & 1; (void)lane; (void)wr; (void)wc;
  if constexpr (COOP) { if (ph_hi < 0) cg::this_grid().sync(); }
  __shared__ uint4 xb_words;
  XcdBarrier xb;
  xb.bar = p.BAR; xb.x = 0u; xb.st = (volatile LAS unsigned*)&xb_words;
  if constexpr (COOP) {
    if (tid0 == 0) { xb.st[0] = 0u; xb.st[1] = 0u; }
    __syncthreads();
    xb = xcd_barrier_post(p.BAR, (volatile LAS unsigned*)&xb_words);
    if (tid0 == 0) {
      unsigned nloc = 1u, nx = 1u;
      xcd_barrier_complete(p.BAR, xb.x, nloc, nx, (unsigned)nb);
      xb.st[0] = nloc; xb.st[1] = nx;
    }
    __syncthreads();
  }
  {
    {
      if (PHON(0) && ph_lo <= 0 && 0 < ph_hi) { const int ph = 0; (void)ph;
        PH_IDS
        for (int rep_ = 0; rep_ < REP_P0; ++rep_) {
        ph_ada(p, smem, bid, nb, 0);
        ph_h2(p, smem, bid, nb);
        transpose_job(p.hy_w3, p.W3T, 64, 4096, 1, smem, bid, nb);
        transpose_job(p.ev_w_in, p.WT_EVIN, 2048, 5120, 1, smem, bid, nb);
        transpose_job(p.ev_w_out, p.WT_EVOUT, 2048, 2048, 1, smem, bid, nb);
        transpose_job(p.peer_q, p.WT_PQ, 2048, 2048, 1, smem, bid, nb);
        ph_small_convert(p, bid, nb);
        }
        if constexpr (COOP) if (ph + 1 < ph_hi) xcd_barrier_impl(xb.bar, xb.x, xb.st, (int)tid_local(), (unsigned)nb);
      }
      if (PHON(1) && ph_lo <= 1 && 1 < ph_hi) { const int ph = 1; (void)ph;
        PH_IDS
        for (int rep_ = 0; rep_ < REP_GEMM; ++rep_) {
        ph_norm(p.x, p.ctx, TS, p.norm_mix, p.MOD, p.MOD + 12288, 0, 1, p.ABUF0, bid, nb);
        gemm_phase(p.H2B, 64, p.W3T, 64, TS, 4096, 64, smem, bid, nb, [&](int row0, int col, f32x4 v) {
          const float ad = fabsf(p.hy_deltas[col]);
          float o[4];
#pragma unroll
          for (int j = 0; j < 4; ++j) {
            const int row = row0 + j;
            const float tn = row < TX ? (float)row * (1.f / 8191.f) : (float)(row - TX) * (1.f / 255.f);
            o[j] = v[j] * __expf(-tn * ad);
          }
          *(u32x2*)(p.FILT + (size_t)col * TS + row0) = mk2(pack2(o[0], o[1]), pack2(o[2], o[3]));
        });
        }
        if constexpr (COOP) if (ph + 1 < ph_hi) xcd_barrier_impl(xb.bar, xb.x, xb.st, (int)tid_local(), (unsigned)nb);
      }
      if (PHON(2) && ph_lo <= 2 && 2 < ph_hi) { const int ph = 2; (void)ph;
        PH_IDS
        for (int rep_ = 0; rep_ < REP_GEMM; ++rep_) {
        gemm_phase(p.ABUF0, DM, p.WT_EVIN, DM, TS, 5120, DM, smem, bid, nb, [&](int row0, int col, f32x4 v) {
          float4 o;
          if (col < 3072) { o.x = v[0]; o.y = v[1]; o.z = v[2]; o.w = v[3]; }
          else { o.x = gelu_f(v[0]); o.y = gelu_f(v[1]); o.z = gelu_f(v[2]); o.w = gelu_f(v[3]); }
          *(float4*)(p.PROJT + (size_t)col * TS + row0) = o;
        });
        }
        if constexpr (COOP) if (ph + 1 < ph_hi) xcd_barrier_impl(xb.bar, xb.x, xb.st, (int)tid_local(), (unsigned)nb);
      }
      if (PHON(3) && ph_lo <= 3 && 3 < ph_hi) { const int ph = 3; (void)ph;
        PH_IDS
        for (int rep_ = 0; rep_ < REP_P3; ++rep_) {
        const bool conv_first = ((bid / (nb >> 1)) & 1) != 0;
#define LATE_PREP() { ph_tables(p, bid, nb); __syncthreads(); ph_ada(p, smem, bid, nb, 1); \
          transpose_job(p.od_w_in, p.WT_ODIN, 2048, 3072, 1, smem, bid, nb); \
          transpose_job(p.od_w_out, p.WT_ODOUT, 2048, 2048, 1, smem, bid, nb); \
          transpose_job(p.peer_q + (size_t)DM * DM, p.WT_PQ + (size_t)DM * DM, 2048, 2048, 1, smem, bid, nb); \
          transpose_job(p.pool_w, p.WTPOOL, 256, 256, 4, smem, bid, nb); __syncthreads(); }
        if (conv_first) LATE_PREP()
        for (int item = bid; item < 2048 + 528; item += nb) {
          if (item < 1024) hyena_item<0>(p, smem, item);
          else if (item < 2048) hyena_item<1>(p, smem, item - 1024);
          else gmlp_item(p, smem, (item - 2048) >> 3, (item - 2048) & 7);
        }
        if (!conv_first) LATE_PREP()
        }
        if constexpr (COOP) if (ph + 1 < ph_hi) xcd_barrier_impl(xb.bar, xb.x, xb.st, (int)tid_local(), (unsigned)nb);
      }
      if (PHON(4) && ph_lo <= 4 && 4 < ph_hi) { const int ph = 4; (void)ph;
        PH_IDS
        for (int rep_ = 0; rep_ < REP_GEMM; ++rep_) {
        gemm_phase(p.ABUF1, DM, p.WT_EVOUT, DM, TS, DM, DM, smem, bid, nb, [&](int row0, int col, f32x4 v) {
#pragma unroll
          for (int j = 0; j < 4; ++j) {
            const int row = row0 + j;
            const float base = row < TX ? p.x[(size_t)row * DM + col] : p.ctx[(size_t)(row - TX) * DM + col];
            const float g = p.MOD[(size_t)(row < TX ? 0 : 1) * 12288 + 2 * DM + col];
            p.XA[(size_t)row * DM + col] = base + g * v[j];
          }
        });
        }
        if constexpr (COOP) if (ph + 1 < ph_hi) xcd_barrier_impl(xb.bar, xb.x, xb.st, (int)tid_local(), (unsigned)nb);
      }
      if (PHON(5) && ph_lo <= 5 && 5 < ph_hi) { const int ph = 5; (void)ph;
        PH_IDS
        ph_norm(p.XA, p.XA + (size_t)TX * DM, TS, p.norm_ffn, p.MOD, p.MOD + 12288, 3, 4, p.ABUF0, bid, nb);
        if constexpr (COOP) if (ph + 1 < ph_hi) xcd_barrier_impl(xb.bar, xb.x, xb.st, (int)tid_local(), (unsigned)nb);
      }
      if (PHON(6) && ph_lo <= 6 && 6 < ph_hi) { const int ph = 6; (void)ph;
        ph_qscores(p, 0, TS, smem, bid, nb);
        if constexpr (COOP) if (ph + 1 < ph_hi) xcd_barrier_impl(xb.bar, xb.x, xb.st, (int)tid_local(), (unsigned)nb);
      }
      if (PHON(8) && ph_lo <= 8 && 8 < ph_hi) { const int ph = 8; (void)ph;
        PH_IDS
        ph_peer<0>(p, 0, TS, smem, bid, nb);
        if constexpr (COOP) if (ph + 1 < ph_hi) xcd_barrier_impl(xb.bar, xb.x, xb.st, (int)tid_local(), (unsigned)nb);
      }
      if (PHON(9) && ph_lo <= 9 && 9 < ph_hi) { const int ph = 9; (void)ph;
        PH_IDS
        for (int rep_ = 0; rep_ < REP_GEMM; ++rep_) {
        gemm_phase(p.ABUF1, DM, p.WT_ODIN, DM, TS, 3072, DM, smem, bid, nb, [&](int row0, int col, f32x4 v) {
#pragma unroll
          for (int j = 0; j < 4; ++j) p.PROJ1[(size_t)(row0 + j) * 3072 + col] = (col < 1024) ? gelu_f(v[j]) : v[j];
        });
        }
        if constexpr (COOP) if (ph + 1 < ph_hi) xcd_barrier_impl(xb.bar, xb.x, xb.st, (int)tid_local(), (unsigned)nb);
      }
      if (PHON(10) && ph_lo <= 10 && 10 < ph_hi) { const int ph = 10; (void)ph;
        PH_IDS
        for (int rep_ = 0; rep_ < REP_L1S; ++rep_) {
        for (int idx = bid * 256 + tid; idx < TS * 256; idx += nb * 256) {
          const int t = idx >> 8, c4 = (idx & 255) * 4;
          const int lo = t < TX ? 0 : TX, hi = t < TX ? TX : TS;
          float4 a = *(const float4*)(p.od_conv_b + c4);
#pragma unroll
          for (int k = 0; k < 4; ++k) {
            const int tt = t + k - 1;
            if (tt >= lo && tt < hi) {
              const float4 xv = *(const float4*)(p.PROJ1 + (size_t)tt * 3072 + 1024 + c4);
              const float4 wv = *(const float4*)(p.od_conv_w + k * 1024 + c4);
              a.x += wv.x * xv.x; a.y += wv.y * xv.y; a.z += wv.z * xv.z; a.w += wv.w * xv.w;
            }
          }
          *(float4*)(p.XR + (size_t)t * 1024 + c4) = a;
          *(u32x2*)(p.XRB + (size_t)t * 1024 + c4) = mk2(pack2(a.x, a.y), pack2(a.z, a.w));
        }
        for (int idx = bid * 256 + tid; idx < TX * 256; idx += nb * 256) {
          const int t = idx >> 8, c4 = (idx & 255) * 4;
          const int half = 1 << (c4 >> 8);
          const int lo = (t - half) < 0 ? 0 : (t - half);
          const int hi = (t + half) > TX ? TX : (t + half);
          float4 s = make_float4(0.f, 0.f, 0.f, 0.f);
          for (int q = lo; q < hi; ++q) {
            const float4 xv = *(const float4*)(p.PROJ1 + (size_t)q * 3072 + 2048 + c4);
            s.x += xv.x; s.y += xv.y; s.z += xv.z; s.w += xv.w;
          }
          const float inv = 1.f / (float)(hi - lo);
          const float4 x0 = *(const float4*)(p.PROJ1 + (size_t)t * 3072 + 2048 + c4);
          *(u32x2*)(p.PD + (size_t)t * 1024 + c4) = mk2(pack2(s.x * inv - x0.x, s.y * inv - x0.y), pack2(s.z * inv - x0.z, s.w * inv - x0.w));
        }
        }
        if constexpr (COOP) if (ph + 1 < ph_hi) xcd_barrier_impl(xb.bar, xb.x, xb.st, (int)tid_local(), (unsigned)nb);
      }
      if (PHON(11) && ph_lo <= 11 && 11 < ph_hi) { const int ph = 11; (void)ph;
        PH_IDS
        for (int rep_ = 0; rep_ < REP_L1S; ++rep_) {
        bf16_t* sA = (bf16_t*)smem;
        bf16_t* sB = sA + 128 * LDS_S;
        for (int id = bid; id < 2112 + 512; id += nb) {
          f32x4 acc[4][4];
          if (id < 2112) {
            const int mt = id % 66, g = id / 66, dir = g >> 4, hh = g & 15, h = hh >> 1, half = hh & 1;
            gemm_core(acc, p.XRB + (size_t)mt * 128 * 1024 + h * 128, 1024, p.WG + (size_t)(dir * 16 + hh) * 128 * 128, 128, 128, sA, sB);
#pragma unroll
            for (int gq = 0; gq < 2; ++gq) {
              const int c = h * 128 + half * 64 + (wc * 2 + gq) * 16 + (lane & 15);
              const float ba = p.lru_ba[dir * 1024 + c], bx = p.lru_bx[dir * 1024 + c];
              const float sp = log1pf(expf(-p.lru_lam[dir * 1024 + c]));
#pragma unroll
              for (int mi = 0; mi < 4; ++mi)
#pragma unroll
                for (int j = 0; j < 4; ++j) {
                  const int t = mt * 128 + wr * 64 + mi * 16 + (lane >> 4) * 4 + j;
                  const float r = sigmoid_f(acc[mi][2 * gq][j] + ba);
                  const float ii = sigmoid_f(acc[mi][2 * gq + 1][j] + bx);
                  const float la = -8.f * r * sp;
                  const float a = expf(la);
                  const float b = sqrtf(-expm1f(2.f * la)) * ii * p.XR[(size_t)t * 1024 + c];
                  p.ABA[((size_t)dir * TS + t) * 1024 + c] = a;
                  p.ABB[((size_t)dir * TS + t) * 1024 + c] = b;
                }
            }
          } else {
            const int id2 = id - 2112, mt = id2 & 63, rest = id2 >> 6, g = rest >> 1, nh = rest & 1;
            gemm_core(acc, p.PD + (size_t)mt * 128 * 1024 + g * 256, 1024, p.WTPOOL + (size_t)g * 256 * 256 + (size_t)nh * 128 * 256, 256, 256, sA, sB);
#pragma unroll
            for (int mi = 0; mi < 4; ++mi)
#pragma unroll
              for (int ni = 0; ni < 4; ++ni) {
                const int cc = g * 256 + nh * 128 + wc * 64 + ni * 16 + (lane & 15);
                const float pb = p.pool_b[cc], ps = p.pool_scale[cc];
#pragma unroll
                for (int j = 0; j < 4; ++j) {
                  const int t = mt * 128 + wr * 64 + mi * 16 + (lane >> 4) * 4 + j;
                  p.ABUF0[(size_t)t * DM + 1024 + cc] = f2bf((acc[mi][ni][j] + pb) * ps);
                }
              }
          }
        }
        }
        if constexpr (COOP) if (ph + 1 < ph_hi) xcd_barrier_impl(xb.bar, xb.x, xb.st, (int)tid_local(), (unsigned)nb);
      }
      if (PHON(12) && ph_lo <= 12 && 12 < ph_hi) { const int ph = 12; (void)ph;
        PH_IDS
        for (int rep_ = 0; rep_ < REP_L1S; ++rep_) {
        for (int item = bid; item < 2 * 132 * 4; item += nb) {
          const int dir = item / 528, rem = item % 528, k = rem >> 2, c = (rem & 3) * 256 + tid;
          const float* pa = p.ABA + (size_t)dir * TS * 1024 + c;
          const float* pb = p.ABB + (size_t)dir * TS * 1024 + c;
          float Pp = 1.f, H = 0.f;
#pragma unroll 8
          for (int s = 0; s < 64; ++s) {
            const int t = dir ? (k * 64 + 63 - s) : (k * 64 + s);
            const float a = pa[(size_t)t * 1024], b = pb[(size_t)t * 1024];
            H = a * H + b; Pp *= a;
          }
          p.AGG[(size_t)(dir * 132 + k) * 1024 + c] = make_float2(Pp, H);
        }
        }
        if constexpr (COOP) if (ph + 1 < ph_hi) xcd_barrier_impl(xb.bar, xb.x, xb.st, (int)tid_local(), (unsigned)nb);
      }
      if (PHON(13) && ph_lo <= 13 && 13 < ph_hi) { const int ph = 13; (void)ph;
        PH_IDS
        for (int rep_ = 0; rep_ < REP_L1S; ++rep_) {
        float* hf = (float*)smem;
        for (int item = bid; item < 1024; item += nb) {
          const int k = item >> 3, cb = item & 7, cl = tid & 127, c = cb * 128 + cl, dir = tid >> 7;
          const float2* ag = p.AGG + (size_t)dir * 132 * 1024 + c;
          const int npre = 4 + (dir ? (127 - k) : k);
          float h = 0.f;
#pragma unroll 8
          for (int v = 0; v < npre; ++v) {
            const int q = dir ? (v < 4 ? 131 - v : 131 - v) : (v < 4 ? 128 + v : v - 4);
            const float2 g = ag[(size_t)q * 1024];
            h = g.x * h + g.y;
          }
          const float* pa = p.ABA + (size_t)dir * TS * 1024 + c;
          const float* pb = p.ABB + (size_t)dir * TS * 1024 + c;
          if (dir == 0) {
#pragma unroll 8
            for (int s = 0; s < 64; ++s) {
              const int t = k * 64 + s;
              h = pa[(size_t)t * 1024] * h + pb[(size_t)t * 1024];
              hf[s * 128 + cl] = h;
            }
          }
          __syncthreads();
          if (dir == 1) {
#pragma unroll 8
            for (int s = 63; s >= 0; --s) {
              const int t = k * 64 + s;
              h = pa[(size_t)t * 1024] * h + pb[(size_t)t * 1024];
              const float y = p.PROJ1[(size_t)t * 3072 + c] * (hf[s * 128 + cl] + h);
              p.ABUF0[(size_t)t * DM + c] = f2bf(y);
            }
          }
          __syncthreads();
        }
        }
        if constexpr (COOP) if (ph + 1 < ph_hi) xcd_barrier_impl(xb.bar, xb.x, xb.st, (int)tid_local(), (unsigned)nb);
      }
      if (PHON(14) && ph_lo <= 14 && 14 < ph_hi) { const int ph = 14; (void)ph;
        PH_IDS
        gemm_phase(p.ABUF0, DM, p.WT_ODOUT, DM, TX, DM, DM, smem, bid, nb, [&](int row0, int col, f32x4 v) {
          const float g = p.MOD[(size_t)2 * 12288 + 2 * DM + col];
#pragma unroll
          for (int j = 0; j < 4; ++j) {
            float* d = p.XA + (size_t)(row0 + j) * DM + col;
            *d = *d + g * v[j];
          }
        });
        if constexpr (COOP) if (ph + 1 < ph_hi) xcd_barrier_impl(xb.bar, xb.x, xb.st, (int)tid_local(), (unsigned)nb);
      }
      if (PHON(15) && ph_lo <= 15 && 15 < ph_hi) { const int ph = 15; (void)ph;
        PH_IDS
        ph_norm(p.XA, p.XA + (size_t)TX * DM, TX, p.norm_ffn + DM, p.MOD + 2 * 12288, p.MOD + 3 * 12288, 3, 4, p.ABUF1, bid, nb);
        if constexpr (COOP) if (ph + 1 < ph_hi) xcd_barrier_impl(xb.bar, xb.x, xb.st, (int)tid_local(), (unsigned)nb);
      }
      if (PHON(16) && ph_lo <= 16 && 16 < ph_hi) { const int ph = 16; (void)ph;
        ph_qscores(p, 1, TX, smem, bid, nb);
        if constexpr (COOP) if (ph + 1 < ph_hi) xcd_barrier_impl(xb.bar, xb.x, xb.st, (int)tid_local(), (unsigned)nb);
      }
      if (PHON(18) && ph_lo <= 18 && 18 < ph_hi) { const int ph = 18; (void)ph;
        PH_IDS
        for (int rep_ = 0; rep_ < REP_P18; ++rep_) {
        ph_peer<1>(p, 1, TX, smem, bid, nb);
        }
        if constexpr (COOP) if (ph + 1 < ph_hi) xcd_barrier_impl(xb.bar, xb.x, xb.st, (int)tid_local(), (unsigned)nb);
      }
    }
  }
}

extern "C" void kernel_launch(void* const* d_in, const int* in_sizes, int n_in, void* d_out, int out_size, void* d_ws,
                              size_t ws_size, hipStream_t stream) {
  P p{};
  const float** pin = (const float**)&p;
  for (int i = 0; i < 40; ++i) pin[i] = (const float*)d_in[i];
  p.out = (float*)d_out;
  char* ws = (char*)d_ws;
  size_t off = 0;
  auto alloc = [&](size_t bytes) { char* r = ws + off; off += (bytes + 255) & ~(size_t)255; return r; };
  p.MOD = (float*)alloc(4 * 12288 * 4);
  p.H2B = (bf16_t*)alloc((size_t)TS * 64 * 2);
  p.W3T = (bf16_t*)alloc((size_t)4096 * 64 * 2);
  p.WT_EVIN = (bf16_t*)alloc((size_t)5120 * 2048 * 2);
  p.WT_EVOUT = (bf16_t*)alloc((size_t)2048 * 2048 * 2);
  p.WT_ODIN = (bf16_t*)alloc((size_t)3072 * 2048 * 2);
  p.WT_ODOUT = (bf16_t*)alloc((size_t)2048 * 2048 * 2);
  p.WT_PQ = (bf16_t*)alloc((size_t)2 * 2048 * 2048 * 2);
  p.WG = (bf16_t*)alloc((size_t)2 * 16 * 128 * 128 * 2);
  p.KEYB = (bf16_t*)alloc((size_t)2 * 16 * 128 * 128 * 2);
  p.GMWS = (bf16_t*)alloc((size_t)8 * 128 * 128 * 2);
  p.WTPOOL = (bf16_t*)alloc((size_t)4 * 256 * 256 * 2);
  p.UB = (unsigned char*)alloc((size_t)2 * 16384 * 2048);
  p.VB = (unsigned char*)alloc((size_t)2 * 16384 * 2048);
  p.SU = (float*)alloc((size_t)2 * 16384 * 4);
  p.SV = (float*)alloc((size_t)2 * 16384 * 4);
  p.ABUF0 = (bf16_t*)alloc((size_t)TS * DM * 2);
  p.ABUF1 = (bf16_t*)alloc((size_t)TS * DM * 2);
  {
    char* r1 = alloc((size_t)5120 * TS * 4);
    p.PROJT = (float*)r1;
    p.PROJ1 = (float*)r1;
    p.XR = (float*)(r1 + (size_t)TS * 3072 * 4);
    p.XRB = (bf16_t*)(r1 + (size_t)TS * 3072 * 4 + (size_t)TS * 1024 * 4);
    p.PD = (bf16_t*)(r1 + (size_t)TS * 3072 * 4 + (size_t)TS * 1024 * 4 + (size_t)TS * 1024 * 2);
  }
  {
    char* r2 = alloc((size_t)2 * 2 * TS * 1024 * 4);
    p.FILT = (bf16_t*)r2;
    p.Z1 = (float*)(r2 + (size_t)4096 * TS * 2);
    p.ABA = (float*)r2;
    p.ABB = (float*)(r2 + (size_t)2 * TS * 1024 * 4);
  }
  p.XA = (float*)alloc((size_t)TS * DM * 4);
  p.QB = (bf16_t*)alloc((size_t)TS * DM * 2);
  p.SC = (float*)alloc((size_t)TS * DM * 4);
  p.AGG = (float2*)alloc((size_t)2 * 132 * 1024 * 8);
  p.BAR = (unsigned*)alloc(XCD_BAR_WORDS * 4);
  if (off > ws_size) { fprintf(stderr, "workspace too small: need %zu have %zu\n", off, ws_size); return; }

#if ONE_LAUNCH
  static int grid_blocks = 0;
  if (!grid_blocks) {
    int dev = 0, cus = 0, per_cu = 0;
    hipGetDevice(&dev);
    hipDeviceGetAttribute(&cus, hipDeviceAttributeMultiprocessorCount, dev);
    hipOccupancyMaxActiveBlocksPerMultiprocessor(&per_cu, mega<true>, 256, 0);
    if (per_cu > 2) per_cu = 2;
    grid_blocks = cus * per_cu;
  }
  int lo = 0, hi = NPH;
  void* args[] = {&p, &lo, &hi};
  hipMemsetAsync(p.BAR, 0, XCD_BAR_WORDS * 4, stream);
  hipError_t e = hipLaunchCooperativeKernel((void*)mega<true>, dim3(grid_blocks), dim3(256), args, 0, stream);
  if (e != hipSuccess) fprintf(stderr, "cooperative launch failed: %s (grid %d)\n", hipGetErrorString(e), grid_blocks);
#else
  for (int ph = 0; ph < NPH; ++ph) mega<false><<<512, 256, 0, stream>>>(p, ph, ph + 1);
#endif
}
```
